# Optimizing an MI355X kernel written in HIP

```python
import math
import jax, jax.numpy as jnp
from jax import lax
import numpy as np

D_MODEL = 1024
BATCH = 16
SEQ = 2048
DEPTH = 2

HEAD_DIM = 64
SCALE = HEAD_DIM ** -0.5
NSA_HEADS = 8
NSA_GROUPS = 2
NSA_HPG = NSA_HEADS // NSA_GROUPS
CMP_LEN = 32
CMP_STRIDE = 16
CMP_HIDDEN = 128
SEL_BLOCK = 64
SEL_TOPN = 8
WINDOW = 256
WIN_QBLOCK = 128
MOBA_HEADS = 4
MOBA_BLOCK = 256
MOBA_TOPK = 3
MEM_LEN = 256
MEM_HEADS = 4
GATHER_QCHUNK = 32
N_BRANCHES = 3
D_FF = -(-8 * D_MODEL // (3 * 256)) * 256
REL_BUCKETS = 32
REL_MAX_DIST = 128
N_BIAS_HEADS = NSA_HEADS + MOBA_HEADS
RMS_EPS = 1e-6
NEG_INF = -1e30
FORCE_SCORE = 1e4

NSA_Q_W = NSA_HEADS * HEAD_DIM
NSA_KV_W = NSA_GROUPS * HEAD_DIM
NSA_GATE_W = NSA_HEADS * 3
MOBA_W = MOBA_HEADS * HEAD_DIM
MEM_W = MEM_HEADS * HEAD_DIM
SPLIT_SIZES = (NSA_Q_W,) + (NSA_KV_W,) * 6 + (NSA_GATE_W,) + (MOBA_W,) * 3 + (MEM_W,) + (D_MODEL,) * N_BRANCHES
IN_WIDTH = sum(SPLIT_SIZES)

kernel_name = 'hybrid_nsa_moba_memory_block'


def rms_norm(x, g):
    xf = x.astype(jnp.float32)
    y = xf * lax.rsqrt(jnp.mean(xf * xf, axis=-1, keepdims=True) + RMS_EPS)
    return (y * g.astype(jnp.float32)).astype(x.dtype)


def t5_bucket(dist):
    dist = jnp.maximum(dist, 0)
    max_exact = REL_BUCKETS // 2
    logd = jnp.log(jnp.maximum(dist, 1).astype(jnp.float32) / max_exact) / math.log(REL_MAX_DIST / max_exact)
    large = jnp.minimum(max_exact + (logd * (REL_BUCKETS - max_exact)).astype(jnp.int32), REL_BUCKETS - 1)
    return jnp.where(dist < max_exact, dist, large)


def masked_softmax(logits, mask):
    p = jax.nn.softmax(jnp.where(mask, logits, NEG_INF), axis=-1)
    return p * jnp.any(mask, axis=-1, keepdims=True)


def split_columns(t):
    points, acc = [], 0
    for size in SPLIT_SIZES[:-1]:
        acc += size
        points.append(acc)
    return jnp.split(t, points, axis=-1)


def to_heads(t, n_heads):
    b, s, _ = t.shape
    return t.reshape(b, s, n_heads, HEAD_DIM).transpose(0, 2, 1, 3)


def nsa_compressed(q, k, v, pos_k, w1_k, w2_k, pos_v, w1_v, w2_v, bias_tab):
    b, g, hpg, s, dh = q.shape
    n_cmp = (s - CMP_LEN) // CMP_STRIDE + 1
    idx = jnp.arange(n_cmp)[:, None] * CMP_STRIDE + jnp.arange(CMP_LEN)[None, :]

    def compress(t, pos, w1, w2):
        blocks = (t[:, :, idx] + pos).reshape(b, g, n_cmp, CMP_LEN * dh)
        return jax.nn.gelu(blocks @ w1) @ w2

    kc = compress(k, pos_k, w1_k, w2_k)
    vc = compress(v, pos_v, w1_v, w2_v)
    t = jnp.arange(s)
    dist = t[:, None] - (jnp.arange(n_cmp) * CMP_STRIDE + CMP_LEN - 1)[None, :]
    bias = bias_tab[t5_bucket(dist)].reshape(s, n_cmp, g, hpg).transpose(2, 3, 0, 1)
    logits = jnp.einsum('bghtd,bgcd->bghtc', q, kc).astype(jnp.float32) * SCALE + bias
    p = masked_softmax(logits, dist >= 0)
    o = jnp.einsum('bghtc,bgcd->bghtd', p.astype(vc.dtype), vc)
    return o, p


def nsa_selected(q, k, v, p_cmp, bias_tab):
    b, g, hpg, s, dh = q.shape
    n_blk = s // SEL_BLOCK
    n_cmp = p_cmp.shape[-1]
    cs = jnp.arange(n_cmp) * CMP_STRIDE
    ss = jnp.arange(n_blk) * SEL_BLOCK
    overlap = jnp.clip(jnp.minimum(cs[:, None] + CMP_LEN, ss[None, :] + SEL_BLOCK)
                       - jnp.maximum(cs[:, None], ss[None, :]), 0).astype(jnp.float32) / CMP_LEN
    imp = jnp.einsum('bghtc,cn->bgtn', p_cmp, overlap)
    t = jnp.arange(s)
    cur = (t // SEL_BLOCK)[:, None]
    blk = jnp.arange(n_blk)[None, :]
    forced = (blk == 0) | (blk == cur) | (blk == cur - 1)
    score = jnp.where(forced, FORCE_SCORE, jnp.where(blk <= cur, imp, NEG_INF))
    n_top = min(SEL_TOPN, n_blk)
    top_val, top_idx = lax.top_k(score, n_top)
    top_ok = top_val > NEG_INF / 2

    k_blk = k.reshape(b, g, n_blk, SEL_BLOCK, dh)
    v_blk = v.reshape(b, g, n_blk, SEL_BLOCK, dh)
    tab_g = bias_tab.reshape(REL_BUCKETS, g, hpg)
    qc_len = GATHER_QCHUNK
    n_chunks = s // qc_len
    bi = jnp.arange(b)[:, None, None, None]
    gi = jnp.arange(g)[None, :, None, None]
    n_keys = n_top * SEL_BLOCK

    def chunk(args):
        qc, ic, okc, t0 = args
        kg = k_blk[bi, gi, ic].reshape(b, g, qc_len, n_keys, dh)
        vg = v_blk[bi, gi, ic].reshape(b, g, qc_len, n_keys, dh)
        kpos = (ic[..., None] * SEL_BLOCK + jnp.arange(SEL_BLOCK)).reshape(b, g, qc_len, n_keys)
        dist = (t0 + jnp.arange(qc_len))[None, None, :, None] - kpos
        mask = (dist >= 0) & jnp.repeat(okc, SEL_BLOCK, axis=-1)
        bias = jnp.moveaxis(tab_g[t5_bucket(dist), gi], -1, 2)
        logits = jnp.einsum('bghqd,bgqkd->bghqk', qc, kg).astype(jnp.float32) * SCALE + bias
        p = masked_softmax(logits, mask[:, :, None])
        return jnp.einsum('bghqk,bgqkd->bghqd', p.astype(vg.dtype), vg)

    qs = jnp.moveaxis(q.reshape(b, g, hpg, n_chunks, qc_len, dh), 3, 0)
    idx_s = jnp.moveaxis(top_idx.reshape(b, g, n_chunks, qc_len, n_top), 2, 0)
    ok_s = jnp.moveaxis(top_ok.reshape(b, g, n_chunks, qc_len, n_top), 2, 0)
    t0s = jnp.arange(n_chunks, dtype=jnp.int32) * qc_len
    out = lax.map(chunk, (qs, idx_s, ok_s, t0s))
    return jnp.moveaxis(out, 0, 3).reshape(b, g, hpg, s, dh)


def nsa_window(q, k, v, bias_tab):
    b, g, hpg, s, dh = q.shape
    n_qb = s // WIN_QBLOCK
    span = WIN_QBLOCK + WINDOW
    kp = jnp.pad(k, ((0, 0), (0, 0), (WINDOW, 0), (0, 0)))
    vp = jnp.pad(v, ((0, 0), (0, 0), (WINDOW, 0), (0, 0)))
    idx = jnp.arange(n_qb)[:, None] * WIN_QBLOCK + jnp.arange(span)[None, :]
    kb = kp[:, :, idx]
    vb = vp[:, :, idx]
    qb = q.reshape(b, g, hpg, n_qb, WIN_QBLOCK, dh)
    dist = jnp.arange(WIN_QBLOCK)[:, None] - jnp.arange(span)[None, :] + WINDOW
    mask = ((dist >= 0) & (dist < WINDOW))[None] & ((idx - WINDOW) >= 0)[:, None, :]
    bias = bias_tab[t5_bucket(dist)].reshape(WIN_QBLOCK, span, g, hpg).transpose(2, 3, 0, 1)
    logits = jnp.einsum('bghnqd,bgnkd->bghnqk', qb, kb).astype(jnp.float32) * SCALE + bias[:, :, None]
    p = masked_softmax(logits, mask)
    o = jnp.einsum('bghnqk,bgnkd->bghnqd', p.astype(vb.dtype), vb)
    return o.reshape(b, g, hpg, s, dh)


def moba_attention(q, k, v, bias_tab):
    b, h, s, dh = q.shape
    n_blk = -(-s // MOBA_BLOCK)
    pad = n_blk * MOBA_BLOCK - s
    kp = jnp.pad(k, ((0, 0), (0, 0), (0, pad), (0, 0)))
    vp = jnp.pad(v, ((0, 0), (0, 0), (0, pad), (0, 0)))
    k_blk = kp.reshape(b, h, n_blk, MOBA_BLOCK, dh)
    v_blk = vp.reshape(b, h, n_blk, MOBA_BLOCK, dh)
    n_top = min(MOBA_TOPK, n_blk - 1)
    qc_len = GATHER_QCHUNK
    n_chunks = s // qc_len
    bi = jnp.arange(b)[:, None, None, None]
    hi = jnp.arange(h)[None, :, None, None]
    n_keys = n_top * MOBA_BLOCK

    def chunk(args):
        qc, t0 = args[0], args[1]
        tq = t0 + jnp.arange(qc_len)
        own = t0 // MOBA_BLOCK
        k_own = lax.dynamic_slice_in_dim(kp, own * MOBA_BLOCK, MOBA_BLOCK, axis=2)
        v_own = lax.dynamic_slice_in_dim(vp, own * MOBA_BLOCK, MOBA_BLOCK, axis=2)
        dist_own = tq[:, None] - (own * MOBA_BLOCK + jnp.arange(MOBA_BLOCK))[None, :]
        logits = (jnp.einsum('bhqd,bhkd->bhqk', qc, k_own).astype(jnp.float32) * SCALE
                  + bias_tab[t5_bucket(dist_own)].transpose(2, 0, 1))
        mask = jnp.broadcast_to(dist_own >= 0, logits.shape)
        if n_top > 0:
            ic, okc = args[2], args[3]
            kg = k_blk[bi, hi, ic].reshape(b, h, qc_len, n_keys, dh)
            vg = v_blk[bi, hi, ic].reshape(b, h, qc_len, n_keys, dh)
            kpos = (ic[..., None] * MOBA_BLOCK + jnp.arange(MOBA_BLOCK)).reshape(b, h, qc_len, n_keys)
            dist = tq[None, None, :, None] - kpos
            sel_logits = (jnp.einsum('bhqd,bhqkd->bhqk', qc, kg).astype(jnp.float32) * SCALE
                          + bias_tab[t5_bucket(dist), hi])
            logits = jnp.concatenate([sel_logits, logits], axis=-1)
            mask = jnp.concatenate([jnp.repeat(okc, MOBA_BLOCK, axis=-1), mask], axis=-1)
        p = masked_softmax(logits, mask).astype(v.dtype)
        o = jnp.einsum('bhqk,bhkd->bhqd', p[..., n_keys:], v_own)
        if n_top > 0:
            o = o + jnp.einsum('bhqk,bhqkd->bhqd', p[..., :n_keys], vg)
        return o

    qs = jnp.moveaxis(q.reshape(b, h, n_chunks, qc_len, dh), 2, 0)
    t0s = jnp.arange(n_chunks, dtype=jnp.int32) * qc_len
    if n_top > 0:
        k_mean = jnp.mean(k_blk, axis=3)
        gate = jnp.einsum('bhtd,bhnd->bhtn', q, k_mean).astype(jnp.float32)
        past = jnp.arange(n_blk)[None, :] < (jnp.arange(s) // MOBA_BLOCK)[:, None]
        top_val, top_idx = lax.top_k(jnp.where(past, gate, NEG_INF), n_top)
        top_ok = top_val > NEG_INF / 2
        idx_s = jnp.moveaxis(top_idx.reshape(b, h, n_chunks, qc_len, n_top), 2, 0)
        ok_s = jnp.moveaxis(top_ok.reshape(b, h, n_chunks, qc_len, n_top), 2, 0)
        out = lax.map(chunk, (qs, t0s, idx_s, ok_s))
    else:
        out = lax.map(chunk, (qs, t0s))
    return jnp.moveaxis(out, 0, 2).reshape(b, h, s, dh)


def memory_attention(q, mk, mv):
    logits = jnp.einsum('bhtd,bhmd->bhtm', q, mk).astype(jnp.float32) * SCALE
    p = jax.nn.softmax(logits, axis=-1).astype(mv.dtype)
    return jnp.einsum('bhtm,bhmd->bhtd', p, mv)


def merge_heads(o):
    b, h, s, dh = o.shape
    return o.transpose(0, 2, 1, 3).reshape(b, s, h * dh)


def hybrid_mixer(h, mem_n, rel_bias, w_in, cmp_pos_k, cmp_w1_k, cmp_w2_k, cmp_pos_v, cmp_w1_v, cmp_w2_v,
                 w_mem_kv, w_nsa_o, w_moba_o, w_mem_o, w_mix_out):
    b, s, _ = h.shape
    (q_n, k_c, v_c, k_s, v_s, k_w, v_w, g_n, q_m, k_m, v_m, q_x,
     gate_nsa, gate_moba, gate_mem) = split_columns(h @ w_in)

    tab_nsa = rel_bias[:, :NSA_HEADS]
    qn = to_heads(q_n, NSA_HEADS).reshape(b, NSA_GROUPS, NSA_HPG, s, HEAD_DIM)
    o_c, p_c = nsa_compressed(qn, to_heads(k_c, NSA_GROUPS), to_heads(v_c, NSA_GROUPS),
                              cmp_pos_k, cmp_w1_k, cmp_w2_k, cmp_pos_v, cmp_w1_v, cmp_w2_v, tab_nsa)
    o_s = nsa_selected(qn, to_heads(k_s, NSA_GROUPS), to_heads(v_s, NSA_GROUPS), p_c, tab_nsa)
    o_w = nsa_window(qn, to_heads(k_w, NSA_GROUPS), to_heads(v_w, NSA_GROUPS), tab_nsa)
    gb = jax.nn.sigmoid(g_n).reshape(b, s, NSA_GROUPS, NSA_HPG, 3).transpose(0, 2, 3, 1, 4)
    o_nsa = gb[..., 0:1] * o_c + gb[..., 1:2] * o_s + gb[..., 2:3] * o_w
    y_nsa = merge_heads(o_nsa.reshape(b, NSA_HEADS, s, HEAD_DIM)) @ w_nsa_o

    o_m = moba_attention(to_heads(q_m, MOBA_HEADS), to_heads(k_m, MOBA_HEADS), to_heads(v_m, MOBA_HEADS),
                         rel_bias[:, NSA_HEADS:])
    y_moba = merge_heads(o_m) @ w_moba_o

    mk, mv = jnp.split(mem_n @ w_mem_kv, 2, axis=-1)
    o_x = memory_attention(to_heads(q_x, MEM_HEADS), to_heads(mk, MEM_HEADS), to_heads(mv, MEM_HEADS))
    y_mem = merge_heads(o_x) @ w_mem_o

    merged = (jax.nn.sigmoid(gate_nsa) * y_nsa + jax.nn.sigmoid(gate_moba) * y_moba
              + jax.nn.sigmoid(gate_mem) * y_mem)
    return merged @ w_mix_out


def setup_inputs(seed: int = 0) -> dict:
    key = jax.random.key(seed)
    ks = jax.random.split(key, 24)

    def nrm(k, shape, scale):
        return jax.random.normal(k, shape, jnp.float32) * scale

    def gain(k):
        return 1.0 + 0.05 * jax.random.normal(k, (DEPTH, D_MODEL), jnp.float32)

    return {
        'x': nrm(ks[0], (BATCH, SEQ, D_MODEL), 1.0),
        'mem': nrm(ks[1], (BATCH, MEM_LEN, D_MODEL), 1.0),
        'rel_bias': nrm(ks[2], (REL_BUCKETS, N_BIAS_HEADS), 0.1),
        'pre_mix_g': gain(ks[3]),
        'mem_norm_g': gain(ks[4]),
        'post_mix_g': gain(ks[5]),
        'w_in': nrm(ks[6], (DEPTH, D_MODEL, IN_WIDTH), D_MODEL ** -0.5),
        'cmp_pos_k': nrm(ks[7], (DEPTH, CMP_LEN, HEAD_DIM), 0.02),
        'cmp_w1_k': nrm(ks[8], (DEPTH, CMP_LEN * HEAD_DIM, CMP_HIDDEN), (CMP_LEN * HEAD_DIM) ** -0.5),
        'cmp_w2_k': nrm(ks[9], (DEPTH, CMP_HIDDEN, HEAD_DIM), CMP_HIDDEN ** -0.5),
        'cmp_pos_v': nrm(ks[10], (DEPTH, CMP_LEN, HEAD_DIM), 0.02),
        'cmp_w1_v': nrm(ks[11], (DEPTH, CMP_LEN * HEAD_DIM, CMP_HIDDEN), (CMP_LEN * HEAD_DIM) ** -0.5),
        'cmp_w2_v': nrm(ks[12], (DEPTH, CMP_HIDDEN, HEAD_DIM), CMP_HIDDEN ** -0.5),
        'w_mem_kv': nrm(ks[13], (DEPTH, D_MODEL, 2 * MEM_W), D_MODEL ** -0.5),
        'w_nsa_o': nrm(ks[14], (DEPTH, NSA_Q_W, D_MODEL), NSA_Q_W ** -0.5),
        'w_moba_o': nrm(ks[15], (DEPTH, MOBA_W, D_MODEL), MOBA_W ** -0.5),
        'w_mem_o': nrm(ks[16], (DEPTH, MEM_W, D_MODEL), MEM_W ** -0.5),
        'w_mix_out': nrm(ks[17], (DEPTH, D_MODEL, D_MODEL), D_MODEL ** -0.5),
        'pre_ffn_g': gain(ks[18]),
        'post_ffn_g': gain(ks[19]),
        'w_ffn_gate': nrm(ks[20], (DEPTH, D_MODEL, D_FF), D_MODEL ** -0.5),
        'w_ffn_up': nrm(ks[21], (DEPTH, D_MODEL, D_FF), D_MODEL ** -0.5),
        'w_ffn_down': nrm(ks[22], (DEPTH, D_FF, D_MODEL), D_FF ** -0.5),
    }


def reference(x, mem, rel_bias, pre_mix_g, mem_norm_g, post_mix_g, w_in,
              cmp_pos_k, cmp_w1_k, cmp_w2_k, cmp_pos_v, cmp_w1_v, cmp_w2_v,
              w_mem_kv, w_nsa_o, w_moba_o, w_mem_o, w_mix_out,
              pre_ffn_g, post_ffn_g, w_ffn_gate, w_ffn_up, w_ffn_down):
    for l in range(DEPTH):
        h = rms_norm(x, pre_mix_g[l])
        mem_n = rms_norm(mem, mem_norm_g[l])
        y = hybrid_mixer(h, mem_n, rel_bias, w_in[l], cmp_pos_k[l], cmp_w1_k[l], cmp_w2_k[l],
                         cmp_pos_v[l], cmp_w1_v[l], cmp_w2_v[l], w_mem_kv[l],
                         w_nsa_o[l], w_moba_o[l], w_mem_o[l], w_mix_out[l])
        x = x + rms_norm(y, post_mix_g[l])
        h = rms_norm(x, pre_ffn_g[l])
        f = (jax.nn.silu(h @ w_ffn_gate[l]) * (h @ w_ffn_up[l])) @ w_ffn_down[l]
        x = x + rms_norm(f, post_ffn_g[l])
    return x
```

```cpp
#include <hip/hip_runtime.h>
#include <cstdio>
#include <cstdint>

#define LAS __attribute__((address_space(3)))
#define GAS __attribute__((address_space(1)))
typedef unsigned short bf16;
typedef short bf16x8 __attribute__((ext_vector_type(8)));
typedef short s16x4 __attribute__((ext_vector_type(4)));
typedef float f32x2 __attribute__((ext_vector_type(2)));
typedef float f32x4 __attribute__((ext_vector_type(4)));
typedef float f32x16 __attribute__((ext_vector_type(16)));
typedef unsigned u32x2 __attribute__((ext_vector_type(2)));
typedef unsigned u32x4 __attribute__((ext_vector_type(4)));

constexpr int BATCH = 16, SEQ = 2048, DM = 1024, NTOK = BATCH * SEQ;
constexpr int NPA = 2560;
constexpr int NGT = 3072;
constexpr int NIN = NPA + NGT;
constexpr int INW = 5400;
constexpr int DFF = 2816, NGU = 2 * DFF;
constexpr int MEML = 256, NMEM = BATCH * MEML;
constexpr int PA_QN = 0, PA_KC = 512, PA_VC = 640, PA_KS = 768, PA_VS = 896, PA_KW = 1024, PA_VW = 1152;
constexpr int PA_QM = 1280, PA_KM = 1536, PA_VM = 1792, PA_QX = 2048, PA_GN = 2304;
constexpr float RMS_EPS = 1e-6f;
constexpr float LOG2E = 1.4426950408889634f;
constexpr float C2 = 0.125f * LOG2E;
constexpr float NEGB = -1e30f;

constexpr size_t MiB = 1u << 20;
constexpr size_t WS_CTL = 0, CTL_ZERO_BYTES = 1 * MiB;
constexpr size_t WS_W = 1 * MiB;
constexpr size_t WL_STRIDE = 35 * MiB;
constexpr size_t WL_IN = 0, WL_GU = 11 * MiB, WL_DN = 22 * MiB, WL_BR = 28 * MiB, WL_MIX = 30 * MiB, WL_MKV = 32 * MiB, WL_W1K = 33 * MiB, WL_W1V = 33 * MiB + 512 * 1024;
constexpr size_t WL_SM = 34 * MiB;
constexpr size_t WL_W2K = WL_SM, WL_W2V = WL_SM + 16384, WL_POSK = WL_SM + 32768, WL_POSV = WL_SM + 32768 + 512;
constexpr size_t WS_MEMKV = 71 * MiB;
constexpr size_t WS_KC = 79 * MiB, WS_VC = 79 * MiB + 512 * 1024;
constexpr size_t WS_KMEAN = 80 * MiB;
constexpr size_t WS_H = 81 * MiB;
constexpr size_t WS_PA = 145 * MiB;
constexpr size_t WS_GT = 305 * MiB;
constexpr size_t WS_END = 497 * MiB;
static_assert(WL_DN + (size_t)DM * DFF * 2 <= WL_BR && WS_W + 2 * WL_STRIDE <= WS_MEMKV && WS_H + (size_t)NTOK * DM * 2 <= WS_PA && WS_PA + (size_t)NTOK * NPA * 2 <= WS_GT && WS_GT + (size_t)NTOK * NGT * 2 <= WS_END, "ws map");
constexpr int CW_TMO = 0, CW_BAR = 4096;

constexpr int RING_BYTES = 131072;
constexpr int MISC_OFF = 148480;
constexpr int LDS_BYTES = 149504;
constexpr int A_KV = 0, A_CMP = 32768, A_TAB = 65536, A_CTAB = 101376, A_IMP = 105600, A_SC = 139392, A_SEL = 147840, A_KMEAN = A_IMP, A_MG = A_IMP + 2048;
constexpr int TABN = 448, CTABN = 132;
static_assert(A_SEL + 256 <= MISC_OFF, "lds map");

__device__ __forceinline__ unsigned f2bf(float f) { unsigned u = __builtin_bit_cast(unsigned, f); return (u + 0x7fffu + ((u >> 16) & 1u)) >> 16; }
__device__ __forceinline__ unsigned pk2(float lo, float hi) { return f2bf(lo) | (f2bf(hi) << 16); }
__device__ __forceinline__ float bflo(unsigned w) { return __builtin_bit_cast(float, w << 16); }
__device__ __forceinline__ float bfhi(unsigned w) { return __builtin_bit_cast(float, w & 0xffff0000u); }
__device__ __forceinline__ float fast_sigmoid(float v) { return __builtin_amdgcn_rcpf(1.0f + __builtin_amdgcn_exp2f(-LOG2E * v)); }

namespace pg8 {
#define PG8_LAS __attribute__((address_space(3)))
typedef unsigned short bf16_t;
constexpr int BM = 256, BK = 64, HALF = 128, HTB = HALF * BK * 2  , STAGE_BYTES = 8 * HTB, NXCD = 8, WGM = 8;

__host__ __device__ __forceinline__ int lds_byte(int r, int c) { const int st = (r >> 4) * 2 + (c >> 5), rr = r & 15, cc = c & 31, ob = rr * 64 + cc * 2; return st * 1024 + (ob ^ (((ob >> 9) & 1) << 5)); }
__host__ __device__ __forceinline__ void stage_rc(int b, int& R, int& C) { const int st = b / 1024, sb = b % 1024, swz = sb ^ (((sb >> 9) & 1) << 5); R = (st >> 1) * 16 + swz / 64; C = (st & 1) * 32 + (swz % 64) / 2; }
__host__ __device__ __forceinline__ int perm32(int rho) { const int n = rho >> 4, i = rho & 15; return 8 * (i >> 2) + 4 * n + (i & 3); }

struct Unit { int pm, pn; };
struct Gemm { const bf16_t* A; const bf16_t* Bt; int M, N, K, lda, ldb; };

struct StaticOrder {
    int nM, nN, nwg, G, c;
    __host__ __device__ void init(int M, int N, int G_, int c_) { nM = M / BM; nN = N / BM; nwg = nM * nN; G = G_; c = c_; }
    __host__ __device__ bool next(int i, Unit& u) const {
        const long L = (long)i * G + c; if (L >= nwg) return false;
        int wgid = (int)L; { const int q = nwg / NXCD, r = nwg % NXCD, xcd = wgid % NXCD, off = wgid / NXCD; wgid = (xcd < r ? xcd * (q + 1) : r * (q + 1) + (xcd - r) * q) + off; }
        const int nig = WGM * nN, gid = wgid / nig, fm = gid * WGM, gsz = (nM - fm) < WGM ? (nM - fm) : WGM;
        u.pm = fm + ((wgid % nig) % gsz); u.pn = (wgid % nig) / gsz; return true;
    }
    __device__ __forceinline__ void a_ready(const Unit&) const {}
    __device__ __forceinline__ void done(const Unit&) const {}
};

__device__ __forceinline__ unsigned cvt_pk_bf16(float lo, float hi) { unsigned r; asm volatile("v_cvt_pk_bf16_f32 %0, %1, %2" : "=v"(r) : "v"(lo), "v"(hi)); return r; }
__device__ __forceinline__ u32x4 pack8(const f32x4& v0, const f32x4& v1) { u32x4 w; w.x = cvt_pk_bf16(v0[0], v0[1]); w.y = cvt_pk_bf16(v0[2], v0[3]); w.z = cvt_pk_bf16(v1[0], v1[1]); w.w = cvt_pk_bf16(v1[2], v1[3]); return w; }
__device__ __forceinline__ void unpack8(const u32x4& w, f32x4& v0, f32x4& v1) { v0 = (f32x4){bflo(w.x), bfhi(w.x), bflo(w.y), bfhi(w.y)}; v1 = (f32x4){bflo(w.z), bfhi(w.z), bflo(w.w), bfhi(w.w)}; }

struct EpiPlain {
    static constexpr bool PERM = true, AFTER_DRAIN = false;
    bf16_t* O; int ldc;
    __device__ __forceinline__ void operator()(const f32x4 (&acc)[2][2][4][2], const Unit& u, int wr, int wc, int fr, int fq) const {
        const int row0 = u.pm * BM + wr * 64 + fr, col0 = u.pn * BM + wc * 32 + 8 * fq;
#pragma unroll
        for (int ai = 0; ai < 2; ++ai)
#pragma unroll
            for (int m = 0; m < 4; ++m) { bf16_t* rowp = O + (size_t)(row0 + ai * HALF + m * 16) * ldc + col0;
#pragma unroll
                for (int bj = 0; bj < 2; ++bj) *(u32x4*)(rowp + bj * HALF) = pack8(acc[ai][bj][m][0], acc[ai][bj][m][1]); }
    }
};
struct EpiProj {
    static constexpr bool PERM = true, AFTER_DRAIN = false;
    bf16_t* PA; bf16_t* GT;
    __device__ __forceinline__ void operator()(const f32x4 (&acc)[2][2][4][2], const Unit& u, int wr, int wc, int fr, int fq) const {
        const int pn = u.pn; bf16_t* base; int ldc, colt; float sc = 1.f; bool sig = false;
        if (pn < 10) { base = PA; ldc = NPA; colt = pn * BM; if (pn < 2 || pn == 5 || pn == 8) sc = C2; if (pn == 9) sig = true; }
        else { base = GT; ldc = NGT; colt = (pn - 10) * BM; sig = true; }
        const int row0 = u.pm * BM + wr * 64 + fr, col0 = colt + wc * 32 + 8 * fq;
#pragma unroll
        for (int ai = 0; ai < 2; ++ai)
#pragma unroll
            for (int m = 0; m < 4; ++m) { bf16_t* rowp = base + (size_t)(row0 + ai * HALF + m * 16) * ldc + col0;
#pragma unroll
                for (int bj = 0; bj < 2; ++bj) { f32x4 v0 = acc[ai][bj][m][0] * sc, v1 = acc[ai][bj][m][1] * sc;
                    if (sig) {
#pragma unroll
                        for (int e = 0; e < 4; ++e) { v0[e] = fast_sigmoid(v0[e]); v1[e] = fast_sigmoid(v1[e]); } }
                    *(u32x4*)(rowp + bj * HALF) = pack8(v0, v1); } }
    }
};
struct EpiMerge {
    static constexpr bool PERM = true, AFTER_DRAIN = false;
    bf16_t* O; int ldc; const bf16_t* G; int ldg; int first;
    __device__ __forceinline__ void operator()(const f32x4 (&acc)[2][2][4][2], const Unit& u, int wr, int wc, int fr, int fq) const {
        const int row0 = u.pm * BM + wr * 64 + fr, col0 = u.pn * BM + wc * 32 + 8 * fq;
#pragma unroll
        for (int ai = 0; ai < 2; ++ai)
#pragma unroll
            for (int m = 0; m < 4; ++m) { const size_t r = (size_t)(row0 + ai * HALF + m * 16);
#pragma unroll
                for (int bj = 0; bj < 2; ++bj) { const u32x4 gw = *(const u32x4*)(G + r * ldg + col0 + bj * HALF); f32x4 g0, g1; unpack8(gw, g0, g1);
                    f32x4 v0 = acc[ai][bj][m][0] * g0, v1 = acc[ai][bj][m][1] * g1;
                    bf16_t* op = O + r * ldc + col0 + bj * HALF;
                    if (!first) { const u32x4 ow = *(const u32x4*)op; f32x4 o0, o1; unpack8(ow, o0, o1); v0 += o0; v1 += o1; }
                    *(u32x4*)op = pack8(v0, v1); } }
    }
};
struct EpiSwiGLU {
    static constexpr bool PERM = true, AFTER_DRAIN = false;
    bf16_t* U; int ldc;
    __device__ __forceinline__ void operator()(const f32x4 (&acc)[2][2][4][2], const Unit& u, int wr, int wc, int fr, int fq) const {
        const int row0 = u.pm * BM + wr * 64 + fr, col0 = u.pn * HALF + wc * 32 + 8 * fq;
#pragma unroll
        for (int ai = 0; ai < 2; ++ai)
#pragma unroll
            for (int m = 0; m < 4; ++m) { bf16_t* rowp = U + (size_t)(row0 + ai * HALF + m * 16) * ldc + col0;
                f32x4 v0, v1;
#pragma unroll
                for (int e = 0; e < 4; ++e) { const float g0 = acc[ai][0][m][0][e], g1 = acc[ai][0][m][1][e];
                    v0[e] = g0 * fast_sigmoid(g0) * acc[ai][1][m][0][e]; v1[e] = g1 * fast_sigmoid(g1) * acc[ai][1][m][1][e]; }
                *(u32x4*)rowp = pack8(v0, v1); }
    }
};

template <class Epi, class Sched, bool ALIGN_EPI = false, bool SP2 = false>
__device__ __forceinline__ void gemm_phase(PG8_LAS unsigned char* lds, const Gemm g, const Sched& S, const Epi& E) {
    int tid_ = threadIdx.x; asm volatile("" : "+v"(tid_));
    const int tid = tid_, wid = __builtin_amdgcn_readfirstlane(tid >> 6), lane = tid & 63, wr = wid >> 2, wc = wid & 3, fr = lane & 15, fq = lane >> 4;
    const int K = g.K, nt = K / BK;
    unsigned voffA[2], voffB[2];
#pragma unroll
    for (int i = 0; i < 2; ++i) { int R, C; stage_rc(tid * 16 + i * 8192, R, C); const int Rb = Epi::PERM ? ((R & ~31) + perm32(R & 31)) : R;
        voffA[i] = (unsigned)(R * g.lda + C) * 2u; voffB[i] = (unsigned)(Rb * g.ldb + C) * 2u; }
    const size_t kstep = (size_t)(BK * 2);
    const size_t hstepA = (size_t)HALF * g.lda * 2, hstepB = (size_t)HALF * g.ldb * 2;
    const size_t tstepA = 2 * hstepA, tstepB = 2 * hstepB;
    const unsigned ldsw = (unsigned)wid * 1024u;
    const int aoff = lds_byte(wr * 64 + fr, fq * 8), boff = lds_byte(wc * 32 + fr, fq * 8);
#define PG8_SA(b, h) (((b) * 2 + (h)) * HTB)
#define PG8_SB(b, h) ((4 + (b) * 2 + (h)) * HTB)
#define PG8_STAGE(bufoff, gbase, voff) do { _Pragma("unroll") for (int _i = 0; _i < 2; ++_i) \
        __builtin_amdgcn_global_load_lds((const unsigned*)((const char*)(gbase) + (voff)[_i]), (PG8_LAS unsigned*)(lds + (bufoff) + ldsw + _i * 8192), 16, 0, 0); } while (0)
#define PG8_LDA(dst, b, h) do { _Pragma("unroll") for (int m = 0; m < 4; ++m) _Pragma("unroll") for (int k = 0; k < 2; ++k) dst[m][k] = *(const PG8_LAS bf16x8*)(lds + PG8_SA(b, h) + aoff + m * 2048 + k * 1024); } while (0)
#define PG8_LDB(dst, b, h) do { _Pragma("unroll") for (int n = 0; n < 2; ++n) _Pragma("unroll") for (int k = 0; k < 2; ++k) dst[n][k] = *(const PG8_LAS bf16x8*)(lds + PG8_SB(b, h) + boff + n * 2048 + k * 1024); } while (0)
#define PG8_MMA(ai, bj, At, Bt) do { __builtin_amdgcn_s_setprio(1); _Pragma("unroll") for (int m = 0; m < 4; ++m) _Pragma("unroll") for (int n = 0; n < 2; ++n) _Pragma("unroll") for (int k = 0; k < 2; ++k) \
        acc[ai][bj][m][n] = __builtin_amdgcn_mfma_f32_16x16x32_bf16(Bt[n][k], At[m][k], acc[ai][bj][m][n], 0, 0, 0); __builtin_amdgcn_s_setprio(0); } while (0)
#define PG8_WAIT_V(n) asm volatile("s_waitcnt vmcnt(" #n ")" ::: "memory")
#define PG8_WAIT_L(n) asm volatile("s_waitcnt lgkmcnt(" #n ")" ::: "memory")
#define PG8_BAR __builtin_amdgcn_s_barrier()
#define PG8_SCHED __builtin_amdgcn_sched_barrier(0)
    Unit cur, nxt; int ui = 0;
    if (!S.next(0, cur)) return;
    f32x4 acc[2][2][4][2];
#pragma unroll
    for (int a = 0; a < 2; ++a)
#pragma unroll
        for (int b = 0; b < 2; ++b)
#pragma unroll
            for (int m = 0; m < 4; ++m)
#pragma unroll
                for (int n = 0; n < 2; ++n) acc[a][b][m][n] = (f32x4){0.f, 0.f, 0.f, 0.f};
    bf16x8 At[4][2], B0[2][2], B1[2][2];
    const char* cA = (const char*)g.A + (size_t)cur.pm * tstepA; const char* cB = (const char*)g.Bt + (size_t)cur.pn * tstepB;
    S.a_ready(cur);
    if constexpr (SP2) {
        PG8_STAGE(PG8_SB(0, 0), cB, voffB); PG8_STAGE(PG8_SB(0, 1), cB + hstepB, voffB); PG8_STAGE(PG8_SA(0, 0), cA, voffA); PG8_STAGE(PG8_SA(0, 1), cA + hstepA, voffA);
        if (wr == 1) PG8_BAR;
        PG8_WAIT_V(2); PG8_BAR;
        PG8_STAGE(PG8_SB(1, 0), cB + kstep, voffB); PG8_STAGE(PG8_SA(1, 0), cA + kstep, voffA); PG8_STAGE(PG8_SB(1, 1), cB + hstepB + kstep, voffB);
        PG8_WAIT_V(6); PG8_BAR;
    } else {
        PG8_STAGE(PG8_SB(0, 0), cB, voffB); PG8_STAGE(PG8_SA(0, 0), cA, voffA); PG8_STAGE(PG8_SB(0, 1), cB + hstepB, voffB); PG8_STAGE(PG8_SA(0, 1), cA + hstepA, voffA);
        if (wr == 1) PG8_BAR;
        PG8_WAIT_V(4); PG8_BAR;
        PG8_STAGE(PG8_SB(1, 0), cB + kstep, voffB); PG8_STAGE(PG8_SA(1, 0), cA + kstep, voffA); PG8_STAGE(PG8_SB(1, 1), cB + hstepB + kstep, voffB);
        PG8_WAIT_V(6); PG8_BAR;
    }
    for (;;) {
        const bool has_next = S.next(ui + 1, nxt);
        const char* nA = has_next ? (const char*)g.A + (size_t)nxt.pm * tstepA : cA; const char* nB = has_next ? (const char*)g.Bt + (size_t)nxt.pn * tstepB : cB;
        for (int t = 0; t < nt; t += 2) {
            const bool last = (t == nt - 2);
            const char* a1 = cA + (size_t)(t + 1) * kstep;
            const char* a2 = last ? nA : cA + (size_t)(t + 2) * kstep; const char* b2 = last ? nB : cB + (size_t)(t + 2) * kstep;
            const char* a3 = a2 + kstep; const char* b3 = b2 + kstep;
            if (last && has_next) S.a_ready(nxt);
            if constexpr (SP2) {
            PG8_LDB(B0, 0, 0); PG8_LDB(B1, 0, 1); PG8_SCHED; PG8_LDA(At, 0, 0); PG8_STAGE(PG8_SA(1, 1), a1 + hstepA, voffA);
            PG8_WAIT_V(8); PG8_WAIT_L(0); PG8_BAR; PG8_MMA(0, 0, At, B0); PG8_MMA(0, 1, At, B1); PG8_BAR; PG8_SCHED;
            PG8_LDA(At, 0, 1); PG8_STAGE(PG8_SB(0, 0), b2, voffB); PG8_STAGE(PG8_SB(0, 1), b2 + hstepB, voffB); PG8_STAGE(PG8_SA(0, 0), a2, voffA);
            PG8_WAIT_V(8); PG8_WAIT_L(0); PG8_BAR; PG8_MMA(1, 0, At, B0); PG8_MMA(1, 1, At, B1); PG8_BAR; PG8_SCHED;
            PG8_LDB(B0, 1, 0); PG8_LDB(B1, 1, 1); PG8_SCHED; PG8_LDA(At, 1, 0); PG8_STAGE(PG8_SA(0, 1), a2 + hstepA, voffA);
            PG8_WAIT_V(8); PG8_WAIT_L(0); PG8_BAR; PG8_MMA(0, 0, At, B0); PG8_MMA(0, 1, At, B1); PG8_BAR; PG8_SCHED;
            PG8_LDA(At, 1, 1); PG8_STAGE(PG8_SB(1, 0), b3, voffB); PG8_STAGE(PG8_SB(1, 1), b3 + hstepB, voffB); PG8_STAGE(PG8_SA(1, 0), a3, voffA);
            PG8_WAIT_V(8); PG8_WAIT_L(0); PG8_BAR; PG8_MMA(1, 0, At, B0); PG8_MMA(1, 1, At, B1); PG8_BAR; PG8_SCHED;
            } else {
            PG8_LDB(B0, 0, 0); PG8_SCHED; PG8_LDA(At, 0, 0); PG8_STAGE(PG8_SA(1, 1), a1 + hstepA, voffA);
            PG8_WAIT_L(8); PG8_BAR; PG8_WAIT_L(0); PG8_MMA(0, 0, At, B0); PG8_BAR; PG8_SCHED;
            PG8_LDB(B1, 0, 1); PG8_STAGE(PG8_SB(0, 0), b2, voffB);
            PG8_BAR; PG8_WAIT_L(0); PG8_MMA(0, 1, At, B1); PG8_BAR;
            PG8_LDA(At, 0, 1); PG8_STAGE(PG8_SA(0, 0), a2, voffA);
            PG8_BAR; PG8_WAIT_L(0); PG8_MMA(1, 0, At, B0); PG8_BAR; PG8_SCHED;
            PG8_STAGE(PG8_SB(0, 1), b2 + hstepB, voffB);
            PG8_WAIT_V(6); PG8_BAR; PG8_MMA(1, 1, At, B1); PG8_BAR;
            PG8_LDB(B0, 1, 0); PG8_SCHED; PG8_LDA(At, 1, 0); PG8_STAGE(PG8_SA(0, 1), a2 + hstepA, voffA);
            PG8_WAIT_L(8); PG8_BAR; PG8_WAIT_L(0); PG8_MMA(0, 0, At, B0); PG8_BAR; PG8_SCHED;
            PG8_LDB(B1, 1, 1); PG8_STAGE(PG8_SB(1, 0), b3, voffB);
            PG8_BAR; PG8_WAIT_L(0); PG8_MMA(0, 1, At, B1); PG8_BAR;
            PG8_LDA(At, 1, 1); PG8_STAGE(PG8_SA(1, 0), a3, voffA);
            PG8_BAR; PG8_WAIT_L(0); PG8_MMA(1, 0, At, B0); PG8_BAR; PG8_SCHED;
            PG8_STAGE(PG8_SB(1, 1), b3 + hstepB, voffB);
            PG8_WAIT_V(6); PG8_BAR; PG8_MMA(1, 1, At, B1); PG8_BAR;
            }
        }
        if constexpr (ALIGN_EPI) { if (wr == 0) PG8_BAR; }
        if constexpr (!Epi::AFTER_DRAIN) { E(acc, cur, wr, wc, fr, fq); S.done(cur); }
        if (!has_next) break;
#pragma unroll
        for (int a = 0; a < 2; ++a)
#pragma unroll
            for (int b = 0; b < 2; ++b)
#pragma unroll
                for (int m = 0; m < 4; ++m)
#pragma unroll
                    for (int n = 0; n < 2; ++n) acc[a][b][m][n] = (f32x4){0.f, 0.f, 0.f, 0.f};
        cur = nxt; cA = nA; cB = nB; ++ui;
        if constexpr (ALIGN_EPI) { if (wr == 1) PG8_BAR; }
    }
    PG8_WAIT_V(0);
    if constexpr (!ALIGN_EPI) { if (wr == 0) PG8_BAR; }
    PG8_BAR;
    if constexpr (Epi::AFTER_DRAIN) { E.fused(acc, cur, wr, wc, fr, fq, lds, wid, lane); S.done(cur); }
#undef PG8_SA
#undef PG8_SB
#undef PG8_STAGE
#undef PG8_LDA
#undef PG8_LDB
#undef PG8_MMA
#undef PG8_WAIT_V
#undef PG8_WAIT_L
#undef PG8_BAR
#undef PG8_SCHED
}

}

typedef GAS unsigned gu32;
#define RLX_AGENT __ATOMIC_RELAXED, __HIP_MEMORY_SCOPE_AGENT
#define XB_TMO      128
#define XB_XCNT(j)  (256  + 64 * (j))
#define XB_XSUB(j)  (1280 + 64 * (j))
#define XB_XGEN(j)  (2304 + 64 * (j))
#define XB_TOP      3328
#define XB_TOPGEN   3392
#define XCD_BAR_WORDS 3456
#define XB_SPIN_CAP (1u << 18)

__device__ __forceinline__ unsigned xb_ld(unsigned* p)              { return __hip_atomic_load(p, __ATOMIC_RELAXED, __HIP_MEMORY_SCOPE_AGENT); }
__device__ __forceinline__ unsigned xb_add(unsigned* p, unsigned v) { return __hip_atomic_fetch_add(p, v, __ATOMIC_RELAXED, __HIP_MEMORY_SCOPE_AGENT); }
__device__ __forceinline__ unsigned xb_xcc_id() { return (unsigned)__builtin_amdgcn_s_getreg((3 << 11) | 20) & 0xFu; }
#define XB_SPIN(cond, bar) do { unsigned _sp = 0; while (cond) { __builtin_amdgcn_s_sleep(1); \
    if ((++_sp & 255u) == 0u) { if (xb_ld(&(bar)[XB_TMO])) break; if (_sp > XB_SPIN_CAP) { atomicAdd(&(bar)[XB_TMO], 1u); break; } } } } while (0)

struct XcdBarrier {
    unsigned* bar; unsigned x;
    volatile LAS unsigned* st;
};

__device__ __forceinline__ XcdBarrier xcd_barrier_post(unsigned* bar, volatile LAS unsigned* st) {
    XcdBarrier b; b.bar = bar; b.x = xb_xcc_id(); b.st = st;
    if (threadIdx.x == 0) (void)xb_add(&bar[XB_XCNT(b.x)], 1u);
    return b;
}
__device__ __forceinline__ void xcd_barrier_complete(unsigned* bar, unsigned x, unsigned& nloc, unsigned& nx) {
    const unsigned G = gridDim.x * gridDim.y * gridDim.z;
    unsigned sum, cnt, mine, sp = 0u;
    for (;;) {
        sum = 0u; cnt = 0u; mine = 0u;
#pragma unroll
        for (unsigned j = 0; j < 16; ++j) { const unsigned c = xb_ld(&bar[XB_XCNT(j)]); sum += c; cnt += (c > 0u) ? 1u : 0u; mine = (j == x) ? c : mine; }
        if (sum == G) break;
        __builtin_amdgcn_s_sleep(1);
        if ((++sp & 255u) == 0u) { if (xb_ld(&bar[XB_TMO])) break; if (sp > XB_SPIN_CAP) { atomicAdd(&bar[XB_TMO], 1u); break; } }
    }
    nloc = mine > 0u ? mine : 1u; nx = cnt > 0u ? cnt : 1u;
}

__device__ __forceinline__ void xcd_barrier(const XcdBarrier& b) {
    asm volatile("s_waitcnt vmcnt(0)" ::: "memory");
    __syncthreads();
    if (threadIdx.x == 0) {
        unsigned* bar = b.bar;
        __builtin_amdgcn_s_waitcnt(0);
        unsigned nloc = b.st[0], nx = b.st[1];
        if (nloc == 0u) { xcd_barrier_complete(bar, b.x, nloc, nx); b.st[0] = nloc; b.st[1] = nx; }
        const unsigned old = xb_add(&bar[XB_XSUB(b.x)], 1u);
        const unsigned gen = old / nloc;
        if (old + 1u == (gen + 1u) * nloc) {
            __builtin_amdgcn_fence(__ATOMIC_RELEASE, "agent");
            asm volatile("s_waitcnt vmcnt(0)" ::: "memory");
            const unsigned og = xb_add(&bar[XB_TOP], 1u);
            const unsigned tg = og / nx;
            if (og + 1u == (tg + 1u) * nx) xb_add(&bar[XB_TOPGEN], 1u);
            else XB_SPIN(xb_ld(&bar[XB_TOPGEN]) == tg, bar);
            __builtin_amdgcn_fence(__ATOMIC_ACQUIRE, "agent");
            xb_add(&bar[XB_XGEN(b.x)], 1u);
            asm volatile("s_waitcnt vmcnt(0)" ::: "memory");
        } else {
            XB_SPIN(xb_ld(&bar[XB_XGEN(b.x)]) == gen, bar);
            __builtin_amdgcn_fence(__ATOMIC_ACQUIRE, "agent");
            asm volatile("s_waitcnt vmcnt(0)" ::: "memory");
        }
    }
    __syncthreads();
}

#define LDS_WAIT() asm volatile("s_waitcnt lgkmcnt(0)" ::: "memory")
#define VM_WAIT() asm volatile("s_waitcnt vmcnt(0)" ::: "memory")
#define MFMA32 __builtin_amdgcn_mfma_f32_32x32x16_bf16
__device__ __forceinline__ float wave_sum(float v) {
#pragma unroll
    for (int o = 1; o < 64; o <<= 1) v += __shfl_xor(v, o);
    return v;
}
__device__ __forceinline__ float swap_max(float m) { auto rr = __builtin_amdgcn_permlane32_swap(__float_as_uint(m), __float_as_uint(m), false, false); return fmaxf(__uint_as_float(rr[0]), __uint_as_float(rr[1])); }
__device__ __forceinline__ float swap_sum(float m) { auto rr = __builtin_amdgcn_permlane32_swap(__float_as_uint(m), __float_as_uint(m), false, false); return __uint_as_float(rr[0]) + __uint_as_float(rr[1]); }
__device__ __forceinline__ int crow(int r, int hi) { return (r & 3) + 8 * (r >> 2) + 4 * hi; }
__device__ __forceinline__ int t5_bucket(int dist) {
    if (dist < 16) return dist;
    int b = 16;
    b += (dist >= 19); b += (dist >= 21); b += (dist >= 24); b += (dist >= 27); b += (dist >= 31); b += (dist >= 35); b += (dist >= 40); b += (dist >= 46);
    b += (dist >= 52); b += (dist >= 59); b += (dist >= 67); b += (dist >= 77); b += (dist >= 87); b += (dist >= 99); b += (dist >= 113);
    return b;
}
__device__ __forceinline__ float gelu_tanh(float x) { const float u = 0.7978845608028654f * (x + 0.044715f * x * x * x); return x * __builtin_amdgcn_rcpf(1.0f + __builtin_amdgcn_exp2f(-2.0f * LOG2E * u)); }

__device__ __forceinline__ void tr_item(const float* W, int ldw, bf16* WT, int ldt, int kdst, LAS float* scr, int k0, int n0, int sc, int lane) {
#pragma unroll 8
    for (int i = 0; i < 32; ++i) { const int kk = 2 * i + (lane >> 5); scr[kk * 33 + (lane & 31)] = sc >= 0 ? W[(size_t)(k0 + kk) * ldw + sc] : 0.f; }
    LDS_WAIT(); asm volatile("" ::: "memory");
    const int c = lane & 7;
#pragma unroll
    for (int j = 0; j < 4; ++j) { const int n = (lane >> 3) + 8 * j; const LAS float* s = scr + (8 * c) * 33 + n;
        u32x4 o; o.x = pk2(s[0 * 33], s[1 * 33]); o.y = pk2(s[2 * 33], s[3 * 33]); o.z = pk2(s[4 * 33], s[5 * 33]); o.w = pk2(s[6 * 33], s[7 * 33]);
        *(u32x4*)(WT + (size_t)(n0 + n) * ldt + kdst + k0 + 8 * c) = o; }
    LDS_WAIT(); asm volatile("" ::: "memory");
}
__device__ __forceinline__ void tr_matrix(int kind, const float* W, const float* W2, int Ksrc, int ldw, int Ndst, bf16* WT, int ldt, int kdst, LAS float* scr, int gw, int NGW, int lane) {
    const int nblk = Ndst / 32, nitems = (Ksrc / 64) * nblk;
    for (int it = gw; it < nitems; it += NGW) {
        const int kb = it / nblk, nb = it % nblk, n0 = 32 * nb, n = n0 + (lane & 31);
        const float* src = W; int sc = n;
        if (kind == 1) { sc = n < 1280 ? n : (n < 2304 ? n + 24 : (n < 2328 ? n - 1024 : (n < 2560 ? -1 : n - 232))); }
        else if (kind == 2) { const int pn = n >> 8, w = n & 255; if (w < 128) sc = 128 * pn + w; else { sc = 128 * pn + w - 128; src = W2; } }
        tr_item(src, ldw, WT, ldt, kdst, scr, 64 * kb, n0, sc, lane);
    }
}

__device__ __forceinline__ void rms_row_bf16(const float* xrow, const float* g, bf16* orow, int lane) {
    const f32x4* xr = (const f32x4*)xrow + lane; const f32x4* gr = (const f32x4*)g + lane;
    f32x4 v[4]; float s = 0.f;
#pragma unroll
    for (int j = 0; j < 4; ++j) { v[j] = xr[64 * j]; s += (v[j].x * v[j].x + v[j].y * v[j].y) + (v[j].z * v[j].z + v[j].w * v[j].w); }
    const float r = rsqrtf(wave_sum(s) * (1.f / DM) + RMS_EPS);
    u32x2* o8 = (u32x2*)orow + lane;
#pragma unroll
    for (int j = 0; j < 4; ++j) { const f32x4 gv = gr[64 * j]; u32x2 w; w.x = pk2(v[j].x * r * gv.x, v[j].y * r * gv.y); w.y = pk2(v[j].z * r * gv.z, v[j].w * r * gv.w); o8[64 * j] = w; }
}
__device__ __forceinline__ void norm_res_norm(const bf16* srow, const float* gA, const float* xin, float* xout, const float* gB, bf16* hout, int lane) {
    const u32x2* sr = (const u32x2*)srow + lane; const f32x4* ga = (const f32x4*)gA + lane; const f32x4* xi = (const f32x4*)xin + lane; f32x4* xo = (f32x4*)xout + lane;
    f32x4 v[4]; float s = 0.f;
#pragma unroll
    for (int j = 0; j < 4; ++j) { const u32x2 w = sr[64 * j]; v[j] = (f32x4){bflo(w.x), bfhi(w.x), bflo(w.y), bfhi(w.y)}; s += (v[j].x * v[j].x + v[j].y * v[j].y) + (v[j].z * v[j].z + v[j].w * v[j].w); }
    const float rA = rsqrtf(wave_sum(s) * (1.f / DM) + RMS_EPS);
    float s2 = 0.f;
#pragma unroll
    for (int j = 0; j < 4; ++j) { const f32x4 x0 = xi[64 * j]; const f32x4 gv = ga[64 * j]; v[j] = x0 + v[j] * rA * gv; xo[64 * j] = v[j]; s2 += (v[j].x * v[j].x + v[j].y * v[j].y) + (v[j].z * v[j].z + v[j].w * v[j].w); }
    if (hout) {
        const float rB = rsqrtf(wave_sum(s2) * (1.f / DM) + RMS_EPS);
        const f32x4* gb = (const f32x4*)gB + lane; u32x2* o8 = (u32x2*)hout + lane;
#pragma unroll
        for (int j = 0; j < 4; ++j) { const f32x4 gv = gb[64 * j]; u32x2 w; w.x = pk2(v[j].x * rB * gv.x, v[j].y * rB * gv.y); w.y = pk2(v[j].z * rB * gv.z, v[j].w * rB * gv.w); o8[64 * j] = w; }
    }
}

__device__ __forceinline__ void compress_unit(int u, LAS unsigned char* lds, const bf16* PA, const unsigned char* wl, bf16* KC, bf16* VC, int tid) {
    const int lane = tid & 63, wid = __builtin_amdgcn_readfirstlane(tid >> 6), r32 = lane & 31, hi = lane >> 5;
    const int half = u & 1, kv = (u >> 1) & 1, g = (u >> 2) & 1, b = u >> 3;
    const bf16* w1t = (const bf16*)(wl + (kv ? WL_W1V : WL_W1K));
    const bf16* w2t = (const bf16*)(wl + (kv ? WL_W2V : WL_W2K));
    const float* posb = (const float*)(wl + (kv ? WL_POSV : WL_POSK));
    const bf16* Asrc = PA + (size_t)b * SEQ * NPA + (kv ? PA_VC : PA_KC) + g * 64;
    bf16* Out = (kv ? VC : KC) + (size_t)((b * 2 + g) * 128) * 64;
    LAS bf16* H1 = (LAS bf16*)lds;
    {
        const int ctile = wid & 1, ntile = wid >> 1;
        const int c = 64 * half + 32 * ctile + r32;
        const bf16* wrow = w1t + (size_t)(32 * ntile + r32) * 2048 + 8 * hi;
        f32x16 acc = {};
        for (int jj = 0; jj < 32; ++jj) {
            int tok = 16 * c + jj; tok = tok > SEQ - 1 ? SEQ - 1 : tok;
            const bf16* arow = Asrc + (size_t)tok * NPA + 8 * hi;
#pragma unroll
            for (int q = 0; q < 4; ++q) {
                const bf16x8 af = *(const bf16x8*)(wrow + jj * 64 + q * 16);
                const bf16x8 bfr = *(const bf16x8*)(arow + q * 16);
                acc = MFMA32(af, bfr, acc, 0, 0, 0);
            }
        }
#pragma unroll
        for (int k4 = 0; k4 < 4; ++k4) { const int n0 = 32 * ntile + 8 * k4 + 4 * hi; const f32x4 pb = *(const f32x4*)(posb + n0);
            u32x2 w; w.x = pk2(gelu_tanh(acc[4 * k4 + 0] + pb.x), gelu_tanh(acc[4 * k4 + 1] + pb.y)); w.y = pk2(gelu_tanh(acc[4 * k4 + 2] + pb.z), gelu_tanh(acc[4 * k4 + 3] + pb.w));
            *(LAS u32x2*)(H1 + (32 * ctile + r32) * 136 + n0) = w; }
    }
    __syncthreads();
    if (wid < 4) {
        const int ct2 = wid & 1, dt = wid >> 1;
        f32x16 a2 = {};
#pragma unroll
        for (int ks = 0; ks < 8; ++ks) {
            const bf16x8 af = *(const bf16x8*)(w2t + (size_t)(32 * dt + r32) * 128 + 16 * ks + 8 * hi);
            const bf16x8 bfr = *(const LAS bf16x8*)(H1 + (32 * ct2 + r32) * 136 + 16 * ks + 8 * hi);
            a2 = MFMA32(af, bfr, a2, 0, 0, 0);
        }
#pragma unroll
        for (int k4 = 0; k4 < 4; ++k4) { u32x2 w; w.x = pk2(a2[4 * k4 + 0], a2[4 * k4 + 1]); w.y = pk2(a2[4 * k4 + 2], a2[4 * k4 + 3]);
            *(u32x2*)(Out + (size_t)(64 * half + 32 * ct2 + r32) * 64 + 32 * dt + 8 * k4 + 4 * hi) = w; }
    }
    __syncthreads();
}
__device__ __forceinline__ void kmean_unit(int b, int n, LAS unsigned char* lds, const bf16* PA, float* KMEAN, int tid) {
    const int chunk = tid & 31, tg = tid >> 5;
    const bf16* src = PA + ((size_t)b * SEQ + 256 * n + 16 * tg) * NPA + PA_KM + 8 * chunk;
    f32x4 s0 = {0.f, 0.f, 0.f, 0.f}, s1 = {0.f, 0.f, 0.f, 0.f};
#pragma unroll 4
    for (int t = 0; t < 16; ++t) { const u32x4 w = *(const u32x4*)(src + (size_t)t * NPA); f32x4 a, c; pg8::unpack8(w, a, c); s0 += a; s1 += c; }
    LAS float* red = (LAS float*)lds;
    *(LAS f32x4*)(red + tg * 256 + 8 * chunk) = s0; *(LAS f32x4*)(red + tg * 256 + 8 * chunk + 4) = s1;
    __syncthreads();
    if (tid < 256) { float s = 0.f;
#pragma unroll
        for (int t = 0; t < 16; ++t) s += red[t * 256 + tid];
        KMEAN[((size_t)(b * 4 + (tid >> 6)) * 8 + n) * 64 + (tid & 63)] = s * (1.f / 256.f); }
    __syncthreads();
}

__device__ __forceinline__ void stage_kv(LAS unsigned char* buf, const bf16* kptr, const bf16* vptr, int pitch, int wid, int lane) {
    const bf16* ks = kptr + (size_t)lane * pitch + wid * 8;
    const bf16* vs = vptr + (size_t)(16 * (wid & 3) + (lane >> 2)) * pitch + (wid >> 2) * 32 + (lane & 3) * 8;
    __builtin_amdgcn_global_load_lds((const unsigned*)ks, (LAS unsigned*)(buf + wid * 1024), 16, 0, 0);
    __builtin_amdgcn_global_load_lds((const unsigned*)vs, (LAS unsigned*)(buf + 8192 + wid * 1024), 16, 0, 0);
}
__device__ __forceinline__ bf16x8 pack_p(const f32x16& p, int s) {
    u32x4 w; w.x = pg8::cvt_pk_bf16(p[8 * s + 0], p[8 * s + 1]); w.y = pg8::cvt_pk_bf16(p[8 * s + 2], p[8 * s + 3]); w.z = pg8::cvt_pk_bf16(p[8 * s + 4], p[8 * s + 5]); w.w = pg8::cvt_pk_bf16(p[8 * s + 6], p[8 * s + 7]);
    return __builtin_bit_cast(bf16x8, w);
}
__device__ __forceinline__ bf16x8 vfrag(const LAS unsigned char* p) {
    const s16x4 lo = __builtin_bit_cast(s16x4, __builtin_amdgcn_ds_read_tr16_b64_v4i16((LAS s16x4*)p));
    const s16x4 hi = __builtin_bit_cast(s16x4, __builtin_amdgcn_ds_read_tr16_b64_v4i16((LAS s16x4*)(p + 512)));
    return (bf16x8){lo[0], lo[1], lo[2], lo[3], hi[0], hi[1], hi[2], hi[3]};
}
struct WState { f32x16 o0, o1; float m, l; int first; };
__device__ __forceinline__ void ws_reset(WState& S) { S.o0 = f32x16{}; S.o1 = f32x16{}; S.m = 0.f; S.l = 0.f; S.first = 1; }
__device__ __forceinline__ void attn_tile(WState& S, const bf16x8 (&q)[4], const LAS unsigned char* buf, float cadd, bool near, const LAS float* nearp, int r32, int hi, int lane) {
    const float ci = cadd - S.m;
    f32x16 p0, p1;
#pragma unroll
    for (int r = 0; r < 16; ++r) { p0[r] = ci; p1[r] = ci; }
    const LAS unsigned char* kb = buf + hi * 1024 + r32 * 16;
#pragma unroll
    for (int ks = 0; ks < 4; ++ks) {
        const bf16x8 k0f = *(const LAS bf16x8*)(kb + ks * 2048), k1f = *(const LAS bf16x8*)(kb + ks * 2048 + 512);
        p0 = MFMA32(k0f, q[ks], p0, 0, 0, 0); p1 = MFMA32(k1f, q[ks], p1, 0, 0, 0);
    }
    if (near) {
#pragma unroll
        for (int r = 0; r < 16; ++r) { const int c = (r & 3) + 8 * (r >> 2); p0[r] += nearp[63 - c]; p1[r] += nearp[31 - c]; }
    }
    float rm = fmaxf(p0[0], p1[0]);
#pragma unroll
    for (int r = 1; r < 16; ++r) rm = fmaxf(rm, fmaxf(p0[r], p1[r]));
    rm = swap_max(rm);
    const float d = S.first ? rm : fmaxf(rm, 0.f);
    const float f = S.first ? 1.f : __builtin_amdgcn_exp2f(-d);
    S.m += d; S.first = 0;
    float ls = 0.f;
#pragma unroll
    for (int r = 0; r < 16; ++r) { p0[r] = __builtin_amdgcn_exp2f(p0[r] - d); p1[r] = __builtin_amdgcn_exp2f(p1[r] - d); ls += p0[r] + p1[r]; }
    S.l = S.l * f + ls;
    S.o0 *= f; S.o1 *= f;
    bf16x8 pa[4]; pa[0] = pack_p(p0, 0); pa[1] = pack_p(p0, 1); pa[2] = pack_p(p1, 0); pa[3] = pack_p(p1, 1);
    const LAS unsigned char* vb = buf + 8192 + ((lane >> 4) & 1) * 32 + (lane & 3) * 8 + (4 * hi + ((lane & 15) >> 2)) * 64;
#pragma unroll
    for (int s4 = 0; s4 < 4; ++s4) {
        const bf16x8 v0 = vfrag(vb + s4 * 1024), v1 = vfrag(vb + 4096 + s4 * 1024);
        S.o0 = MFMA32(v0, pa[s4], S.o0, 0, 0, 0); S.o1 = MFMA32(v1, pa[s4], S.o1, 0, 0, 0);
    }
}
__device__ __forceinline__ void store_ot(bf16* op  , const f32x16& o0, const f32x16& o1) {
#pragma unroll
    for (int k4 = 0; k4 < 4; ++k4) {
        u32x2 w0, w1; w0.x = pk2(o0[4 * k4 + 0], o0[4 * k4 + 1]); w0.y = pk2(o0[4 * k4 + 2], o0[4 * k4 + 3]); w1.x = pk2(o1[4 * k4 + 0], o1[4 * k4 + 1]); w1.y = pk2(o1[4 * k4 + 2], o1[4 * k4 + 3]);
        *(u32x2*)(op + 8 * k4) = w0; *(u32x2*)(op + 32 + 8 * k4) = w1;
    }
}
__device__ __forceinline__ void attn_tables(LAS unsigned char* lds, const float* rel_bias, int tid) {
    LAS float* tab = (LAS float*)(lds + A_TAB);
    for (int e = tid; e < 20 * TABN; e += 512) { const int t = e / TABN, i = e % TABN, dist = i - 96, head = t < 8 ? t : t - 8; const bool win = t >= 8 && t < 16;
        float v = NEGB; if (dist >= 0 && !(win && dist >= 256)) { const int bk = dist >= 128 ? 31 : t5_bucket(dist); v = rel_bias[bk * 12 + head] * LOG2E; }
        tab[e] = v; }
    LAS float* ct = (LAS float*)(lds + A_CTAB);
    for (int e = tid; e < 8 * CTABN; e += 512) { const int hd = e / CTABN, i = e % CTABN; float v = NEGB;
        if (i >= 1 && i <= 129) { const int dist = i - 1; const int bk = dist >= 128 ? 31 : t5_bucket(dist); v = rel_bias[bk * 12 + hd] * LOG2E; }
        ct[e] = v; }
    __syncthreads();
}

__device__ __forceinline__ void nsa_unit(int b, int g, int qb, LAS unsigned char* lds, const bf16* PA, const bf16* KC, const bf16* VC, bf16* OC, int tid) {
    const int lane = tid & 63, wid = __builtin_amdgcn_readfirstlane(tid >> 6), r32 = lane & 31, hi = lane >> 5;
    const int hh = wid & 3, wq = wid >> 2, head = g * 4 + hh, tq0 = 64 * qb + 32 * wq;
    const size_t row = (size_t)b * SEQ + tq0 + r32;
    bf16x8 q[4];
    { const bf16* qp = PA + row * NPA + PA_QN + head * 64 + 8 * hi;
#pragma unroll
      for (int ks = 0; ks < 4; ++ks) q[ks] = *(const bf16x8*)(qp + 16 * ks); }
    const bf16* gp = PA + row * NPA + PA_GN + head * 3;
    const float g0 = bflo(gp[0]), g1 = bflo(gp[1]), g2 = bflo(gp[2]);
    const bf16* Kc = KC + (size_t)((b * 2 + g) * 128) * 64; const bf16* Vc = VC + (size_t)((b * 2 + g) * 128) * 64;
    const bf16* Ks = PA + (size_t)b * SEQ * NPA + PA_KS + g * 64; const bf16* Vs = PA + (size_t)b * SEQ * NPA + PA_VS + g * 64;
    const bf16* Kw = PA + (size_t)b * SEQ * NPA + PA_KW + g * 64; const bf16* Vw = PA + (size_t)b * SEQ * NPA + PA_VW + g * 64;
    LAS unsigned char* kvb = lds + A_KV; LAS unsigned char* cmpb = lds + A_CMP;
    const int nsel = qb + 1, nwin = qb + 1 < 5 ? qb + 1 : 5, ns = nsel + nwin;
#define NSA_ISSUE(j) do { const int j_ = (j); const bool w_ = j_ >= nsel; const int n_ = w_ ? qb - (j_ - nsel) : qb - j_; \
        stage_kv(kvb + (j_ & 1) * 16384, (w_ ? Kw : Ks) + (size_t)(64 * n_) * NPA, (w_ ? Vw : Vs) + (size_t)(64 * n_) * NPA, NPA, wid, lane); } while (0)
    stage_kv(cmpb, Kc, Vc, 64, wid, lane); stage_kv(cmpb + 16384, Kc + 64 * 64, Vc + 64 * 64, 64, wid, lane);
    NSA_ISSUE(0);
    VM_WAIT(); __syncthreads();
    f32x16 ot0, ot1;
    {
        f32x16 sc[4];
#pragma unroll
        for (int ph = 0; ph < 4; ++ph) sc[ph] = f32x16{};
#pragma unroll
        for (int t = 0; t < 2; ++t) { const LAS unsigned char* kb = cmpb + t * 16384 + hi * 1024 + r32 * 16;
#pragma unroll
            for (int ks = 0; ks < 4; ++ks) { const bf16x8 k0f = *(const LAS bf16x8*)(kb + ks * 2048), k1f = *(const LAS bf16x8*)(kb + ks * 2048 + 512);
                sc[2 * t] = MFMA32(k0f, q[ks], sc[2 * t], 0, 0, 0); sc[2 * t + 1] = MFMA32(k1f, q[ks], sc[2 * t + 1], 0, 0, 0); } }
        __builtin_amdgcn_sched_barrier(0);
        const LAS float* ct = (const LAS float*)(lds + A_CTAB) + head * CTABN;
        const int E0 = tq0 + r32 - 31 - 64 * hi;
        float m = NEGB;
#pragma unroll
        for (int ph = 0; ph < 4; ++ph)
#pragma unroll
            for (int k4 = 0; k4 < 4; ++k4) { int base = E0 - 16 * (32 * ph + 8 * k4); asm volatile("" : "+v"(base));
#pragma unroll
                for (int i = 0; i < 4; ++i) { int dist = base - 16 * i; dist = dist < -1 ? -1 : (dist > 128 ? 128 : dist);
                    sc[ph][4 * k4 + i] += ct[dist + 1]; m = fmaxf(m, sc[ph][4 * k4 + i]); } }
        m = swap_max(m);
        const bool valid = m > -1e29f;
        float l = 0.f;
#pragma unroll
        for (int ph = 0; ph < 4; ++ph)
#pragma unroll
            for (int r = 0; r < 16; ++r) { const float e = valid ? __builtin_amdgcn_exp2f(sc[ph][r] - m) : 0.f; sc[ph][r] = e; l += e; }
        l = swap_sum(l);
        const float inv = valid ? 1.0f / l : 0.f;
#pragma unroll
        for (int ph = 0; ph < 4; ++ph) sc[ph] *= inv;
        {
            LAS float* impw = (LAS float*)(lds + A_IMP) + (hh * 64 + 32 * wq + r32) * 33;
            float prevhi = 0.f;
#pragma unroll
            for (int i = 0; i < 16; ++i) { const int ph = i >> 2, k = i & 3;
                const float av = sc[ph][4 * k] + sc[ph][4 * k + 1] + sc[ph][4 * k + 2] + 0.5f * sc[ph][4 * k + 3], bv = 0.5f * sc[ph][4 * k + 3];
                auto rr = __builtin_amdgcn_permlane32_swap(__float_as_uint(bv), __float_as_uint(bv), false, false);
                const float lo_i = __uint_as_float(rr[0]), hi_i = __uint_as_float(rr[1]);
                impw[2 * k + hi + 8 * ph] = av + (hi ? lo_i : prevhi); prevhi = hi_i; }
        }
        __builtin_amdgcn_sched_barrier(0);
        f32x16 o0 = f32x16{}, o1 = f32x16{};
#pragma unroll
        for (int ph = 0; ph < 4; ++ph)
#pragma unroll
            for (int s = 0; s < 2; ++s) { const bf16x8 pa = pack_p(sc[ph], s);
                const LAS unsigned char* vb = cmpb + (ph >> 1) * 16384 + 8192 + ((lane >> 4) & 1) * 32 + (lane & 3) * 8 + (4 * hi + ((lane & 15) >> 2)) * 64 + (2 * (ph & 1) + s) * 1024;
                const bf16x8 v0 = vfrag(vb), v1 = vfrag(vb + 4096);
                o0 = MFMA32(v0, pa, o0, 0, 0, 0); o1 = MFMA32(v1, pa, o1, 0, 0, 0); }
        ot0 = o0 * g0; ot1 = o1 * g0;
    }
    __syncthreads();
    {
        const LAS float* impb = (const LAS float*)(lds + A_IMP); LAS float* scb = (LAS float*)(lds + A_SC); LAS unsigned* selb = (LAS unsigned*)(lds + A_SEL);
#pragma unroll 1
        for (int it = 0; it < 4; ++it) { const int e = tid + 512 * it, tok = e >> 5, n = e & 31;
            float s = (impb[(0 * 64 + tok) * 33 + n] + impb[(1 * 64 + tok) * 33 + n]) + (impb[(2 * 64 + tok) * 33 + n] + impb[(3 * 64 + tok) * 33 + n]);
            const bool forced = (n == 0) | (n == qb) | (n == qb - 1);
            s = forced ? 1e4f : (n <= qb ? s : NEGB);
            scb[tok * 33 + n] = s;
            LDS_WAIT();
            int rank = 0;
#pragma unroll 8
            for (int mm = 0; mm < 32; ++mm) { const float sm = scb[tok * 33 + mm]; rank += ((sm > s) | ((sm == s) & (mm < n))) ? 1 : 0; }
            const bool sel = (rank < 8) && (s > -5e29f);
            const unsigned long long bal = __ballot(sel);
            if ((lane & 31) == 0) selb[tok] = (unsigned)(bal >> (lane & 32));
        }
    }
    __syncthreads();
    const unsigned mymask = ((const LAS unsigned*)(lds + A_SEL))[32 * wq + r32];
    const LAS float* tabC = (const LAS float*)(lds + A_TAB) + head * TABN; const LAS float* tabW = (const LAS float*)(lds + A_TAB) + (8 + head) * TABN;
    const float cfar = tabC[96 + 128];
    WState S; ws_reset(S);
#pragma unroll 1
    for (int j = 0; j < ns; ++j) {
        VM_WAIT(); __syncthreads();
        if (j + 1 < ns) NSA_ISSUE(j + 1);
        const bool win = j >= nsel;
        if (j == nsel) { const float lt = swap_sum(S.l); const float scl = g1 / lt; ot0 += S.o0 * scl; ot1 += S.o1 * scl; ws_reset(S); }
        const int n = win ? qb - (j - nsel) : qb - j;
        const int a = (tq0 - 64 * n) >> 5;
        const LAS unsigned char* buf = kvb + (j & 1) * 16384;
        const int D0 = tq0 + r32 - 64 * n - 4 * hi;
        if (!win) {
            const bool near = a < 6;
            const float cadd = (((mymask >> n) & 1u) ? 0.f : NEGB) + (near ? 0.f : cfar);
            attn_tile(S, q, buf, cadd, near, tabC + (D0 + 33), r32, hi, lane);
        } else if (a < 10) {
            const bool far = (a == 6) | (a == 7);
            attn_tile(S, q, buf, far ? cfar : 0.f, !far, tabW + (D0 + 33), r32, hi, lane);
        }
    }
    { const float lt = swap_sum(S.l); const float scl = g2 / lt; ot0 += S.o0 * scl; ot1 += S.o1 * scl; }
    store_ot(OC + row * DM + head * 64 + 4 * hi, ot0, ot1);
    __syncthreads();
#undef NSA_ISSUE
}

__device__ __forceinline__ void moba_unit(int b, int h, int ob, LAS unsigned char* lds, const bf16* PA, const float* KMEAN, bf16* OC, int tid) {
    const int lane = tid & 63, wid = __builtin_amdgcn_readfirstlane(tid >> 6), r32 = lane & 31, hi = lane >> 5;
    const int tq0 = 256 * ob + 32 * wid;
    const size_t row = (size_t)b * SEQ + tq0 + r32;
    bf16x8 q[4];
    { const bf16* qp = PA + row * NPA + PA_QM + h * 64 + 8 * hi;
#pragma unroll
      for (int ks = 0; ks < 4; ++ks) q[ks] = *(const bf16x8*)(qp + 16 * ks); }
    const bf16* Km = PA + (size_t)b * SEQ * NPA + PA_KM + h * 64; const bf16* Vm = PA + (size_t)b * SEQ * NPA + PA_VM + h * 64;
    LAS unsigned char* kvb = lds + A_KV;
    const int ns = 4 * (ob + 1);
#define MOBA_ISSUE(j) do { const int j_ = (j); const int n_ = ns - 1 - j_; stage_kv(kvb + (j_ & 1) * 16384, Km + (size_t)(64 * n_) * NPA, Vm + (size_t)(64 * n_) * NPA, NPA, wid, lane); } while (0)
    MOBA_ISSUE(0);
    LAS float* km = (LAS float*)(lds + A_KMEAN); LAS float* mg = (LAS float*)(lds + A_MG);
    km[tid] = KMEAN[(size_t)(b * 4 + h) * 512 + tid];
    __syncthreads();
    {
        const int tok = tid >> 1, hf = tid & 1; const bf16* qrow = PA + ((size_t)b * SEQ + 256 * ob + tok) * NPA + PA_QM + h * 64;
        f32x4 acc = {0.f, 0.f, 0.f, 0.f};
#pragma unroll 1
        for (int c8 = 0; c8 < 8; ++c8) { const u32x4 w = *(const u32x4*)(qrow + 8 * c8); f32x4 qa, qb_; pg8::unpack8(w, qa, qb_);
#pragma unroll
            for (int i = 0; i < 4; ++i) { const LAS float* kp = km + (4 * hf + i) * 64 + 8 * c8; const f32x4 ka = *(const LAS f32x4*)kp, kb = *(const LAS f32x4*)(kp + 4);
                acc[i] += (qa.x * ka.x + qa.y * ka.y) + (qa.z * ka.z + qa.w * ka.w) + (qb_.x * kb.x + qb_.y * kb.y) + (qb_.z * kb.z + qb_.w * kb.w); } }
        *(LAS f32x4*)(mg + tok * 8 + 4 * hf) = acc;
    }
    __syncthreads();
    unsigned mymask = 0u;
    { const LAS float* gp = mg + (32 * wid + r32) * 8; const f32x4 ga = *(const LAS f32x4*)gp, gb = *(const LAS f32x4*)(gp + 4);
      const float gt[8] = {ga.x, ga.y, ga.z, ga.w, gb.x, gb.y, gb.z, gb.w};
#pragma unroll
      for (int n = 0; n < 8; ++n) { int rank = 0;
#pragma unroll
          for (int mm = 0; mm < 8; ++mm) rank += ((mm < ob) & ((gt[mm] > gt[n]) | ((gt[mm] == gt[n]) & (mm < n)))) ? 1 : 0;
          if ((n < ob) & (rank < 3)) mymask |= 1u << n; } }
    const LAS float* tabM = (const LAS float*)(lds + A_TAB) + (16 + h) * TABN;
    const float cfar = tabM[96 + 128];
    WState S; ws_reset(S);
#pragma unroll 1
    for (int j = 0; j < ns; ++j) {
        VM_WAIT(); __syncthreads();
        if (j + 1 < ns) MOBA_ISSUE(j + 1);
        const int n = ns - 1 - j, blk = n >> 2;
        if (tq0 + 31 - 64 * n >= 0) {
            const int a = (tq0 - 64 * n) >> 5;
            const bool near = a < 6;
            float cadd = near ? 0.f : cfar;
            if (blk < ob) cadd += ((mymask >> blk) & 1u) ? 0.f : NEGB;
            const int D0 = tq0 + r32 - 64 * n - 4 * hi;
            attn_tile(S, q, kvb + (j & 1) * 16384, cadd, near, tabM + (D0 + 33), r32, hi, lane);
        }
    }
    { const float lt = swap_sum(S.l); const float scl = 1.0f / lt; S.o0 *= scl; S.o1 *= scl; }
    store_ot(OC + row * DM + 512 + h * 64 + 4 * hi, S.o0, S.o1);
    __syncthreads();
#undef MOBA_ISSUE
}

__device__ __forceinline__ void mem_unit(int b, int h, int tb, LAS unsigned char* lds, const bf16* PA, const bf16* MKV, bf16* OC, int tid) {
    const int lane = tid & 63, wid = __builtin_amdgcn_readfirstlane(tid >> 6), r32 = lane & 31, hi = lane >> 5;
    const int tq0 = 256 * tb + 32 * wid;
    const size_t row = (size_t)b * SEQ + tq0 + r32;
    bf16x8 q[4];
    { const bf16* qp = PA + row * NPA + PA_QX + h * 64 + 8 * hi;
#pragma unroll
      for (int ks = 0; ks < 4; ++ks) q[ks] = *(const bf16x8*)(qp + 16 * ks); }
    const bf16* Kx = MKV + (size_t)b * MEML * 512 + h * 64; const bf16* Vx = Kx + 256;
    LAS unsigned char* kvb = lds + A_KV;
    stage_kv(kvb, Kx, Vx, 512, wid, lane);
    WState S; ws_reset(S);
#pragma unroll 1
    for (int j = 0; j < 4; ++j) {
        VM_WAIT(); __syncthreads();
        if (j + 1 < 4) stage_kv(kvb + ((j + 1) & 1) * 16384, Kx + (size_t)(64 * (j + 1)) * 512, Vx + (size_t)(64 * (j + 1)) * 512, 512, wid, lane);
        attn_tile(S, q, kvb + (j & 1) * 16384, 0.f, false, (const LAS float*)(lds + A_TAB), r32, hi, lane);
    }
    { const float lt = swap_sum(S.l); const float scl = 1.0f / lt; S.o0 *= scl; S.o1 *= scl; }
    store_ot(OC + row * DM + 768 + h * 64 + 4 * hi, S.o0, S.o1);
    __syncthreads();
}

#ifndef MK_MULTI_LAUNCH
#define MK_MULTI_LAUNCH 0
#endif
constexpr int N_PHASES = 19;
struct Args { const float* in[23]; float* out; unsigned char* ws; int ph_lo, ph_hi; };

__global__ void __launch_bounds__(512, 2) fwd_kernel(Args args) {
    extern __shared__ __attribute__((aligned(16))) unsigned char lds_raw[];
    LAS unsigned char* lds = (LAS unsigned char*)lds_raw;
    volatile LAS unsigned* MISC = (volatile LAS unsigned*)(lds + MISC_OFF);
    const int tid = threadIdx.x, lane = tid & 63, wave = __builtin_amdgcn_readfirstlane(tid >> 6);
    const int G = gridDim.x, bx = blockIdx.x; const int vcu = (G % 8 == 0) ? (bx % 8) * (G / 8) + bx / 8 : bx;
    unsigned char* ws = args.ws; unsigned* ctl = (unsigned*)(ws + WS_CTL);
    for (int u = tid; u < (LDS_BYTES - MISC_OFF) / 4; u += 512) MISC[u] = 0u;
    __syncthreads();
    const int lo = args.ph_lo, hi = args.ph_hi;
    XcdBarrier bar; bar.bar = ctl + CW_BAR; bar.x = 0; bar.st = nullptr;
    if (hi - lo > 1) bar = xcd_barrier_post(ctl + CW_BAR, MISC + 8);
#ifndef ATT_EN
#define ATT_EN 7
#endif
#ifndef PHMASK
#define PHMASK 0x3ff
#endif
#define IN(k) (lo <= (k) && (k) < hi)
#define INJ(j) (((PHMASK >> ((j) + 1)) & 1) && IN(pb + (j)))
#define SEAM(k) do { if (IN(k) && IN((k) + 1)) xcd_barrier(bar); } while (0)
    const float* x_in = args.in[0]; const float* mem_in = args.in[1]; const float* rel_bias = args.in[2];
    const float* pre_mix_g = args.in[3]; const float* mem_norm_g = args.in[4]; const float* post_mix_g = args.in[5];
    const float* pre_ffn_g = args.in[18]; const float* post_ffn_g = args.in[19];
    float* xres = args.out;
    bf16* MEMN = (bf16*)args.out;
    bf16* H = (bf16*)(ws + WS_H); bf16* PA = (bf16*)(ws + WS_PA); bf16* GT = (bf16*)(ws + WS_GT);
    bf16* MERGED = PA; bf16* FB = PA; bf16* YB = GT; bf16* UB = GT;
    bf16* MEMKV = (bf16*)(ws + WS_MEMKV); bf16* KC = (bf16*)(ws + WS_KC); bf16* VC = (bf16*)(ws + WS_VC); float* KMEAN = (float*)(ws + WS_KMEAN);
    const int gw = vcu * 8 + wave, NGW = G * 8;

    if ((PHMASK & 1) && IN(0)) {
        LAS float* scr = (LAS float*)(lds + wave * 16384);
        if ((gw & 7) == 0 && (gw >> 3) < 8) {
            const int t = gw >> 3, l = t >> 2, kv = (t >> 1) & 1, nh = t & 1, n = 64 * nh + lane;
            const float* pos = args.in[kv ? 10 : 7] + (size_t)l * 2048; const float* w1 = args.in[kv ? 11 : 8] + (size_t)l * 2048 * 128;
            float acc = 0.f;
#pragma unroll 8
            for (int k = 0; k < 2048; ++k) acc += pos[k] * w1[(size_t)k * 128 + n];
            ((float*)(ws + WS_W + l * WL_STRIDE + (kv ? WL_POSV : WL_POSK)))[n] = acc;
        }
        for (int l = 0; l < 2; ++l) {
            unsigned char* wl = ws + WS_W + l * WL_STRIDE;
#pragma unroll 1
            for (int mi = 0; mi < 12; ++mi) {
                int kind = 0, Ksrc = 0, ldw = 0, Ndst = 0, ldt = 0, kdst = 0; const float* W = nullptr; const float* W2 = nullptr; bf16* WT = nullptr;
                switch (mi) {
                    case 0: kind = 1; W = args.in[6] + (size_t)l * 1024 * INW; Ksrc = 1024; ldw = INW; Ndst = NIN; WT = (bf16*)(wl + WL_IN); ldt = 1024; break;
                    case 1: kind = 2; W = args.in[20] + (size_t)l * 1024 * DFF; W2 = args.in[21] + (size_t)l * 1024 * DFF; Ksrc = 1024; ldw = DFF; Ndst = NGU; WT = (bf16*)(wl + WL_GU); ldt = 1024; break;
                    case 2: W = args.in[22] + (size_t)l * DFF * 1024; Ksrc = DFF; ldw = 1024; Ndst = 1024; WT = (bf16*)(wl + WL_DN); ldt = DFF; break;
                    case 3: W = args.in[14] + (size_t)l * 512 * 1024; Ksrc = 512; ldw = 1024; Ndst = 1024; WT = (bf16*)(wl + WL_BR); ldt = 1024; kdst = 0; break;
                    case 4: W = args.in[15] + (size_t)l * 256 * 1024; Ksrc = 256; ldw = 1024; Ndst = 1024; WT = (bf16*)(wl + WL_BR); ldt = 1024; kdst = 512; break;
                    case 5: W = args.in[16] + (size_t)l * 256 * 1024; Ksrc = 256; ldw = 1024; Ndst = 1024; WT = (bf16*)(wl + WL_BR); ldt = 1024; kdst = 768; break;
                    case 6: W = args.in[17] + (size_t)l * 1024 * 1024; Ksrc = 1024; ldw = 1024; Ndst = 1024; WT = (bf16*)(wl + WL_MIX); ldt = 1024; break;
                    case 7: W = args.in[13] + (size_t)l * 1024 * 512; Ksrc = 1024; ldw = 512; Ndst = 512; WT = (bf16*)(wl + WL_MKV); ldt = 1024; break;
                    case 8: W = args.in[8] + (size_t)l * 2048 * 128; Ksrc = 2048; ldw = 128; Ndst = 128; WT = (bf16*)(wl + WL_W1K); ldt = 2048; break;
                    case 9: W = args.in[11] + (size_t)l * 2048 * 128; Ksrc = 2048; ldw = 128; Ndst = 128; WT = (bf16*)(wl + WL_W1V); ldt = 2048; break;
                    case 10: W = args.in[9] + (size_t)l * 128 * 64; Ksrc = 128; ldw = 64; Ndst = 64; WT = (bf16*)(wl + WL_W2K); ldt = 128; break;
                    default: W = args.in[12] + (size_t)l * 128 * 64; Ksrc = 128; ldw = 64; Ndst = 64; WT = (bf16*)(wl + WL_W2V); ldt = 128; break;
                }
                tr_matrix(kind, W, W2, Ksrc, ldw, Ndst, WT, ldt, kdst, scr, gw, NGW, lane);
            }
        }
        for (int m = gw; m < 2 * NMEM; m += NGW) { const int l = m / NMEM, r = m % NMEM; rms_row_bf16(mem_in + (size_t)r * DM, mem_norm_g + l * DM, MEMN + (size_t)m * DM, lane); }
        for (int m = gw; m < NTOK; m += NGW) rms_row_bf16(x_in + (size_t)m * DM, pre_mix_g, H + (size_t)m * DM, lane);
    }
    SEAM(0);

#pragma unroll 1
    for (int l = 0; l < 2; ++l) {
        const int pb = 1 + 9 * l;
        unsigned char* wl = ws + WS_W + l * WL_STRIDE;
        if (INJ(0)) {
            { pg8::Gemm g{H, (const bf16*)(wl + WL_IN), NTOK, NIN, 1024, 1024, 1024}; pg8::StaticOrder S; S.init(NTOK, NIN, G, bx);
              pg8::EpiProj E{PA, GT}; pg8::gemm_phase<pg8::EpiProj, pg8::StaticOrder, true, true>(lds, g, S, E); }
            if (l == 0) {
#pragma unroll 1
                for (int l2 = 0; l2 < 2; ++l2) { pg8::Gemm g{MEMN + (size_t)l2 * NMEM * DM, (const bf16*)(ws + WS_W + l2 * WL_STRIDE + WL_MKV), NMEM, 512, 1024, 1024, 1024};
                    pg8::StaticOrder S; S.init(NMEM, 512, G, bx); pg8::EpiPlain E{MEMKV + (size_t)l2 * NMEM * 512, 512};
                    pg8::gemm_phase<pg8::EpiPlain, pg8::StaticOrder, true, true>(lds, g, S, E); }
            }
        }
        SEAM(pb + 0);
        if (INJ(1)) {
            int tid_p = tid; asm volatile("" : "+v"(tid_p));
            for (int u = bx; u < 256; u += G) {
                if (u < 128) compress_unit(u, lds, PA, wl, KC, VC, tid_p);
                else kmean_unit((u - 128) >> 3, (u - 128) & 7, lds, PA, KMEAN, tid_p);
            }
        }
        SEAM(pb + 1);
        if (INJ(2)) {
            int tid_p = tid; asm volatile("" : "+v"(tid_p));
            attn_tables(lds, rel_bias, tid_p);
            if (ATT_EN & 1)
#pragma unroll 1
            for (int P = vcu; P < 512; P += G) { const int bg = P >> 4, s = P & 15;
#pragma unroll 1
                for (int k = 0; k < 2; ++k) nsa_unit(bg >> 1, bg & 1, k ? 31 - s : s, lds, PA, KC, VC, H, tid_p); }
            if (ATT_EN & 2)
#pragma unroll 1
            for (int M = vcu; M < 256; M += G) { const int bh = M >> 2, s = M & 3;
#pragma unroll 1
                for (int k = 0; k < 2; ++k) moba_unit(bh >> 2, bh & 3, k ? 7 - s : s, lds, PA, KMEAN, H, tid_p); }
            if (ATT_EN & 4)
#pragma unroll 1
            for (int u = vcu; u < 512; u += G) { const int bh = u >> 3; mem_unit(bh >> 2, bh & 3, u & 7, lds, PA, MEMKV + (size_t)l * NMEM * 512, H, tid_p); }
        }
        SEAM(pb + 2);
        if (INJ(3)) {
#pragma unroll 1
            for (int br = 0; br < 3; ++br) { const int koff = br == 0 ? 0 : (br == 1 ? 512 : 768), K = br == 0 ? 512 : 256;
                pg8::Gemm g{H + koff, (const bf16*)(wl + WL_BR) + koff, NTOK, 1024, K, 1024, 1024}; pg8::StaticOrder S; S.init(NTOK, 1024, G, bx);
                pg8::EpiMerge E{MERGED, 1024, GT + br * 1024, NGT, br == 0 ? 1 : 0};
                pg8::gemm_phase<pg8::EpiMerge, pg8::StaticOrder, true, true>(lds, g, S, E);
                VM_WAIT(); __syncthreads(); }
        }
        SEAM(pb + 3);
        if (INJ(4)) {
            pg8::Gemm g{MERGED, (const bf16*)(wl + WL_MIX), NTOK, 1024, 1024, 1024, 1024}; pg8::StaticOrder S; S.init(NTOK, 1024, G, bx);
            pg8::EpiPlain E{YB, 1024}; pg8::gemm_phase<pg8::EpiPlain, pg8::StaticOrder, true, true>(lds, g, S, E);
        }
        SEAM(pb + 4);
        if (INJ(5)) {
            int lane_p = lane; asm volatile("" : "+v"(lane_p));
            const float* xin = l == 0 ? x_in : xres;
            for (int m = gw; m < NTOK; m += NGW) norm_res_norm(YB + (size_t)m * DM, post_mix_g + l * DM, xin + (size_t)m * DM, xres + (size_t)m * DM, pre_ffn_g + l * DM, H + (size_t)m * DM, lane_p);
        }
        SEAM(pb + 5);
        if (INJ(6)) {
            pg8::Gemm g{H, (const bf16*)(wl + WL_GU), NTOK, NGU, 1024, 1024, 1024}; pg8::StaticOrder S; S.init(NTOK, NGU, G, bx);
            pg8::EpiSwiGLU E{UB, DFF}; pg8::gemm_phase<pg8::EpiSwiGLU, pg8::StaticOrder, true, true>(lds, g, S, E);
        }
        SEAM(pb + 6);
        if (INJ(7)) {
            pg8::Gemm g{UB, (const bf16*)(wl + WL_DN), NTOK, 1024, DFF, DFF, DFF}; pg8::StaticOrder S; S.init(NTOK, 1024, G, bx);
            pg8::EpiPlain E{FB, 1024}; pg8::gemm_phase<pg8::EpiPlain, pg8::StaticOrder, true, true>(lds, g, S, E);
        }
        SEAM(pb + 7);
        if (INJ(8)) {
            int lane_p = lane; asm volatile("" : "+v"(lane_p));
            for (int m = gw; m < NTOK; m += NGW) norm_res_norm(FB + (size_t)m * DM, post_ffn_g + l * DM, xres + (size_t)m * DM, xres + (size_t)m * DM, pre_mix_g + DM, l == 0 ? H + (size_t)m * DM : (bf16*)nullptr, lane_p);
        }
        SEAM(pb + 8);
    }
#undef IN
#undef INJ
#undef SEAM
}

extern "C" void kernel_launch(void* const* d_in, const int* in_sizes, int n_in, void* d_out, int out_size, void* d_ws, size_t ws_size, hipStream_t stream) {
    static int grid = 0;
    if (grid == 0) {
        if (n_in != 23 || in_sizes[0] != NTOK * DM || out_size != NTOK * DM || ws_size < WS_END) { fprintf(stderr, "kernel_launch: unexpected shapes (n_in %d, in0 %d, out %d, ws %zu); nothing launched\n", n_in, n_in > 0 ? in_sizes[0] : -1, out_size, ws_size); grid = -1; return; }
        int dev = 0, cus = 0, per_cu = 0;
        if (hipGetDevice(&dev) != hipSuccess || hipDeviceGetAttribute(&cus, hipDeviceAttributeMultiprocessorCount, dev) != hipSuccess) { grid = -1; return; }
        if (hipFuncSetAttribute((const void*)fwd_kernel, hipFuncAttributeMaxDynamicSharedMemorySize, LDS_BYTES) != hipSuccess) { fprintf(stderr, "kernel_launch: hipFuncSetAttribute failed\n"); grid = -1; return; }
        if (hipOccupancyMaxActiveBlocksPerMultiprocessor(&per_cu, (const void*)fwd_kernel, 512, LDS_BYTES) != hipSuccess || per_cu < 1) fprintf(stderr, "kernel_launch: occupancy query reports %d\n", per_cu);
        (void)hipGetLastError();
        grid = cus;
    }
    if (grid < 0) return;
    if (hipMemsetAsync((char*)d_ws + WS_CTL, 0, CTL_ZERO_BYTES, stream) != hipSuccess) return;
    Args a{};
    for (int i = 0; i < 23; ++i) a.in[i] = (const float*)d_in[i];
    a.out = (float*)d_out; a.ws = (unsigned char*)d_ws;
#if MK_MULTI_LAUNCH
    for (int p = 0; p < N_PHASES; ++p) { a.ph_lo = p; a.ph_hi = p + 1; hipLaunchKernelGGL(fwd_kernel, dim3(grid), dim3(512), LDS_BYTES, stream, a); }
#else
    a.ph_lo = 0; a.ph_hi = N_PHASES;
    hipLaunchKernelGGL(fwd_kernel, dim3(grid), dim3(512), LDS_BYTES, stream, a);
#endif
    const hipError_t le = hipPeekAtLastError();
    if (le != hipSuccess) fprintf(stderr, "kernel_launch: launch failed: %s\n", hipGetErrorName(le));
}
```

```cpp
#include <hip/hip_runtime.h>
#include <cstdio>
#include <cstdint>

#define LAS __attribute__((address_space(3)))
#define GAS __attribute__((address_space(1)))
typedef unsigned short bf16;
typedef short bf16x8 __attribute__((ext_vector_type(8)));
typedef short s16x4 __attribute__((ext_vector_type(4)));
typedef float f32x2 __attribute__((ext_vector_type(2)));
typedef float f32x4 __attribute__((ext_vector_type(4)));
typedef float f32x16 __attribute__((ext_vector_type(16)));
typedef unsigned u32x2 __attribute__((ext_vector_type(2)));
typedef unsigned u32x4 __attribute__((ext_vector_type(4)));

constexpr int BATCH = 16, SEQ = 2048, DM = 1024, NTOK = BATCH * SEQ;
constexpr int NPA = 2560;
constexpr int NGT = 3072;
constexpr int NIN = NPA + NGT;
constexpr int INW = 5400;
constexpr int DFF = 2816, NGU = 2 * DFF;
constexpr int MEML = 256, NMEM = BATCH * MEML;
constexpr int PA_QN = 0, PA_KC = 512, PA_VC = 640, PA_KS = 768, PA_VS = 896, PA_KW = 1024, PA_VW = 1152;
constexpr int PA_QM = 1280, PA_KM = 1536, PA_VM = 1792, PA_QX = 2048, PA_GN = 2304;
constexpr float RMS_EPS = 1e-6f;
constexpr float LOG2E = 1.4426950408889634f;
constexpr float C2 = 0.125f * LOG2E;
constexpr float NEGB = -1e30f;

constexpr size_t MiB = 1u << 20;
constexpr size_t WS_CTL = 0, CTL_ZERO_BYTES = 1 * MiB;
constexpr size_t WS_W = 1 * MiB;
constexpr size_t WL_STRIDE = 35 * MiB;
constexpr size_t WL_IN = 0, WL_GU = 11 * MiB, WL_DN = 22 * MiB, WL_BR = 28 * MiB, WL_MIX = 30 * MiB, WL_MKV = 32 * MiB, WL_W1K = 33 * MiB, WL_W1V = 33 * MiB + 512 * 1024;
constexpr size_t WL_SM = 34 * MiB;
constexpr size_t WL_W2K = WL_SM, WL_W2V = WL_SM + 16384, WL_POSK = WL_SM + 32768, WL_POSV = WL_SM + 32768 + 512;
constexpr size_t WS_MEMKV = 71 * MiB;
constexpr size_t WS_KC = 79 * MiB, WS_VC = 79 * MiB + 512 * 1024;
constexpr size_t WS_KMEAN = 80 * MiB;
constexpr size_t WS_H = 81 * MiB;
constexpr size_t WS_PA = 145 * MiB;
constexpr size_t WS_GT = 305 * MiB;
constexpr size_t WS_END = 497 * MiB;
static_assert(WL_DN + (size_t)DM * DFF * 2 <= WL_BR && WS_W + 2 * WL_STRIDE <= WS_MEMKV && WS_H + (size_t)NTOK * DM * 2 <= WS_PA && WS_PA + (size_t)NTOK * NPA * 2 <= WS_GT && WS_GT + (size_t)NTOK * NGT * 2 <= WS_END, "ws map");
constexpr int CW_TMO = 0, CW_BAR = 4096;

constexpr int RING_BYTES = 131072;
constexpr int MISC_OFF = 148480;
constexpr int LDS_BYTES = 149504;
constexpr int A_KV = 0, A_CMP = 32768, A_TAB = 65536, A_CTAB = 101376, A_IMP = 105600, A_SC = 139392, A_SEL = 147840, A_KMEAN = A_IMP, A_MG = A_IMP + 2048;
constexpr int TABN = 448, CTABN = 132;
static_assert(A_SEL + 256 <= MISC_OFF, "lds map");

__device__ __forceinline__ unsigned f2bf(float f) { unsigned u = __builtin_bit_cast(unsigned, f); return (u + 0x7fffu + ((u >> 16) & 1u)) >> 16; }
__device__ __forceinline__ unsigned pk2(float lo, float hi) { return f2bf(lo) | (f2bf(hi) << 16); }
__device__ __forceinline__ float bflo(unsigned w) { return __builtin_bit_cast(float, w << 16); }
__device__ __forceinline__ float bfhi(unsigned w) { return __builtin_bit_cast(float, w & 0xffff0000u); }
__device__ __forceinline__ float fast_sigmoid(float v) { return __builtin_amdgcn_rcpf(1.0f + __builtin_amdgcn_exp2f(-LOG2E * v)); }

namespace pg8 {
#define PG8_LAS __attribute__((address_space(3)))
typedef unsigned short bf16_t;
constexpr int BM = 256, BK = 64, HALF = 128, HTB = HALF * BK * 2  , STAGE_BYTES = 8 * HTB, NXCD = 8, WGM = 8;

__host__ __device__ __forceinline__ int lds_byte(int r, int c) { const int st = (r >> 4) * 2 + (c >> 5), rr = r & 15, cc = c & 31, ob = rr * 64 + cc * 2; return st * 1024 + (ob ^ (((ob >> 9) & 1) << 5)); }
__host__ __device__ __forceinline__ void stage_rc(int b, int& R, int& C) { const int st = b / 1024, sb = b % 1024, swz = sb ^ (((sb >> 9) & 1) << 5); R = (st >> 1) * 16 + swz / 64; C = (st & 1) * 32 + (swz % 64) / 2; }
__host__ __device__ __forceinline__ int perm32(int rho) { const int n = rho >> 4, i = rho & 15; return 8 * (i >> 2) + 4 * n + (i & 3); }

struct Unit { int pm, pn; };
struct Gemm { const bf16_t* A; const bf16_t* Bt; int M, N, K, lda, ldb; };

struct StaticOrder {
    int nM, nN, nwg, G, c;
    __host__ __device__ void init(int M, int N, int G_, int c_) { nM = M / BM; nN = N / BM; nwg = nM * nN; G = G_; c = c_; }
    __host__ __device__ bool next(int i, Unit& u) const {
        const long L = (long)i * G + c; if (L >= nwg) return false;
        int wgid = (int)L; { const int q = nwg / NXCD, r = nwg % NXCD, xcd = wgid % NXCD, off = wgid / NXCD; wgid = (xcd < r ? xcd * (q + 1) : r * (q + 1) + (xcd - r) * q) + off; }
        const int nig = WGM * nN, gid = wgid / nig, fm = gid * WGM, gsz = (nM - fm) < WGM ? (nM - fm) : WGM;
        u.pm = fm + ((wgid % nig) % gsz); u.pn = (wgid % nig) / gsz; return true;
    }
    __device__ __forceinline__ void a_ready(const Unit&) const {}
    __device__ __forceinline__ void done(const Unit&) const {}
};

__device__ __forceinline__ unsigned cvt_pk_bf16(float lo, float hi) { unsigned r; asm volatile("v_cvt_pk_bf16_f32 %0, %1, %2" : "=v"(r) : "v"(lo), "v"(hi)); return r; }
__device__ __forceinline__ u32x4 pack8(const f32x4& v0, const f32x4& v1) { u32x4 w; w.x = cvt_pk_bf16(v0[0], v0[1]); w.y = cvt_pk_bf16(v0[2], v0[3]); w.z = cvt_pk_bf16(v1[0], v1[1]); w.w = cvt_pk_bf16(v1[2], v1[3]); return w; }
__device__ __forceinline__ void unpack8(const u32x4& w, f32x4& v0, f32x4& v1) { v0 = (f32x4){bflo(w.x), bfhi(w.x), bflo(w.y), bfhi(w.y)}; v1 = (f32x4){bflo(w.z), bfhi(w.z), bflo(w.w), bfhi(w.w)}; }

struct EpiPlain {
    static constexpr bool PERM = true, AFTER_DRAIN = false;
    bf16_t* O; int ldc;
    __device__ __forceinline__ void operator()(const f32x4 (&acc)[2][2][4][2], const Unit& u, int wr, int wc, int fr, int fq) const {
        const int row0 = u.pm * BM + wr * 64 + fr, col0 = u.pn * BM + wc * 32 + 8 * fq;
#pragma unroll
        for (int ai = 0; ai < 2; ++ai)
#pragma unroll
            for (int m = 0; m < 4; ++m) { bf16_t* rowp = O + (size_t)(row0 + ai * HALF + m * 16) * ldc + col0;
#pragma unroll
                for (int bj = 0; bj < 2; ++bj) *(u32x4*)(rowp + bj * HALF) = pack8(acc[ai][bj][m][0], acc[ai][bj][m][1]); }
    }
};
struct EpiProj {
    static constexpr bool PERM = true, AFTER_DRAIN = false;
    bf16_t* PA; bf16_t* GT;
    __device__ __forceinline__ void operator()(const f32x4 (&acc)[2][2][4][2], const Unit& u, int wr, int wc, int fr, int fq) const {
        const int pn = u.pn; bf16_t* base; int ldc, colt; float sc = 1.f; bool sig = false;
        if (pn < 10) { base = PA; ldc = NPA; colt = pn * BM; if (pn < 2 || pn == 5 || pn == 8) sc = C2; if (pn == 9) sig = true; }
        else { base = GT; ldc = NGT; colt = (pn - 10) * BM; sig = true; }
        const int row0 = u.pm * BM + wr * 64 + fr, col0 = colt + wc * 32 + 8 * fq;
#pragma unroll
        for (int ai = 0; ai < 2; ++ai)
#pragma unroll
            for (int m = 0; m < 4; ++m) { bf16_t* rowp = base + (size_t)(row0 + ai * HALF + m * 16) * ldc + col0;
#pragma unroll
                for (int bj = 0; bj < 2; ++bj) { f32x4 v0 = acc[ai][bj][m][0] * sc, v1 = acc[ai][bj][m][1] * sc;
                    if (sig) {
#pragma unroll
                        for (int e = 0; e < 4; ++e) { v0[e] = fast_sigmoid(v0[e]); v1[e] = fast_sigmoid(v1[e]); } }
                    *(u32x4*)(rowp + bj * HALF) = pack8(v0, v1); } }
    }
};
struct EpiMerge {
    static constexpr bool PERM = true, AFTER_DRAIN = false;
    bf16_t* O; int ldc; const bf16_t* G; int ldg; int first;
    __device__ __forceinline__ void operator()(const f32x4 (&acc)[2][2][4][2], const Unit& u, int wr, int wc, int fr, int fq) const {
        const int row0 = u.pm * BM + wr * 64 + fr, col0 = u.pn * BM + wc * 32 + 8 * fq;
#pragma unroll
        for (int ai = 0; ai < 2; ++ai)
#pragma unroll
            for (int m = 0; m < 4; ++m) { const size_t r = (size_t)(row0 + ai * HALF + m * 16);
#pragma unroll
                for (int bj = 0; bj < 2; ++bj) { const u32x4 gw = *(const u32x4*)(G + r * ldg + col0 + bj * HALF); f32x4 g0, g1; unpack8(gw, g0, g1);
                    f32x4 v0 = acc[ai][bj][m][0] * g0, v1 = acc[ai][bj][m][1] * g1;
                    bf16_t* op = O + r * ldc + col0 + bj * HALF;
                    if (!first) { const u32x4 ow = *(const u32x4*)op; f32x4 o0, o1; unpack8(ow, o0, o1); v0 += o0; v1 += o1; }
                    *(u32x4*)op = pack8(v0, v1); } }
    }
};
struct EpiSwiGLU {
    static constexpr bool PERM = true, AFTER_DRAIN = false;
    bf16_t* U; int ldc;
    __device__ __forceinline__ void operator()(const f32x4 (&acc)[2][2][4][2], const Unit& u, int wr, int wc, int fr, int fq) const {
        const int row0 = u.pm * BM + wr * 64 + fr, col0 = u.pn * HALF + wc * 32 + 8 * fq;
#pragma unroll
        for (int ai = 0; ai < 2; ++ai)
#pragma unroll
            for (int m = 0; m < 4; ++m) { bf16_t* rowp = U + (size_t)(row0 + ai * HALF + m * 16) * ldc + col0;
                f32x4 v0, v1;
#pragma unroll
                for (int e = 0; e < 4; ++e) { const float g0 = acc[ai][0][m][0][e], g1 = acc[ai][0][m][1][e];
                    v0[e] = g0 * fast_sigmoid(g0) * acc[ai][1][m][0][e]; v1[e] = g1 * fast_sigmoid(g1) * acc[ai][1][m][1][e]; }
                *(u32x4*)rowp = pack8(v0, v1); }
    }
};

template <class Epi, class Sched, bool ALIGN_EPI = false, bool SP2 = false>
__device__ __forceinline__ void gemm_phase(PG8_LAS unsigned char* lds, const Gemm g, const Sched& S, const Epi& E) {
    int tid_ = threadIdx.x; asm volatile("" : "+v"(tid_));
    const int tid = tid_, wid = __builtin_amdgcn_readfirstlane(tid >> 6), lane = tid & 63, wr = wid >> 2, wc = wid & 3, fr = lane & 15, fq = lane >> 4;
    const int K = g.K, nt = K / BK;
    unsigned voffA[2], voffB[2];
#pragma unroll
    for (int i = 0; i < 2; ++i) { int R, C; stage_rc(tid * 16 + i * 8192, R, C); const int Rb = Epi::PERM ? ((R & ~31) + perm32(R & 31)) : R;
        voffA[i] = (unsigned)(R * g.lda + C) * 2u; voffB[i] = (unsigned)(Rb * g.ldb + C) * 2u; }
    const size_t kstep = (size_t)(BK * 2);
    const size_t hstepA = (size_t)HALF * g.lda * 2, hstepB = (size_t)HALF * g.ldb * 2;
    const size_t tstepA = 2 * hstepA, tstepB = 2 * hstepB;
    const unsigned ldsw = (unsigned)wid * 1024u;
    const int aoff = lds_byte(wr * 64 + fr, fq * 8), boff = lds_byte(wc * 32 + fr, fq * 8);
#define PG8_SA(b, h) (((b) * 2 + (h)) * HTB)
#define PG8_SB(b, h) ((4 + (b) * 2 + (h)) * HTB)
#define PG8_STAGE(bufoff, gbase, voff) do { _Pragma("unroll") for (int _i = 0; _i < 2; ++_i) \
        __builtin_amdgcn_global_load_lds((const unsigned*)((const char*)(gbase) + (voff)[_i]), (PG8_LAS unsigned*)(lds + (bufoff) + ldsw + _i * 8192), 16, 0, 0); } while (0)
#define PG8_LDA(dst, b, h) do { _Pragma("unroll") for (int m = 0; m < 4; ++m) _Pragma("unroll") for (int k = 0; k < 2; ++k) dst[m][k] = *(const PG8_LAS bf16x8*)(lds + PG8_SA(b, h) + aoff + m * 2048 + k * 1024); } while (0)
#define PG8_LDB(dst, b, h) do { _Pragma("unroll") for (int n = 0; n < 2; ++n) _Pragma("unroll") for (int k = 0; k < 2; ++k) dst[n][k] = *(const PG8_LAS bf16x8*)(lds + PG8_SB(b, h) + boff + n * 2048 + k * 1024); } while (0)
#define PG8_MMA(ai, bj, At, Bt) do { __builtin_amdgcn_s_setprio(1); _Pragma("unroll") for (int m = 0; m < 4; ++m) _Pragma("unroll") for (int n = 0; n < 2; ++n) _Pragma("unroll") for (int k = 0; k < 2; ++k) \
        acc[ai][bj][m][n] = __builtin_amdgcn_mfma_f32_16x16x32_bf16(Bt[n][k], At[m][k], acc[ai][bj][m][n], 0, 0, 0); __builtin_amdgcn_s_setprio(0); } while (0)
#define PG8_WAIT_V(n) asm volatile("s_waitcnt vmcnt(" #n ")" ::: "memory")
#define PG8_WAIT_L(n) asm volatile("s_waitcnt lgkmcnt(" #n ")" ::: "memory")
#define PG8_BAR __builtin_amdgcn_s_barrier()
#define PG8_SCHED __builtin_amdgcn_sched_barrier(0)
    Unit cur, nxt; int ui = 0;
    if (!S.next(0, cur)) return;
    f32x4 acc[2][2][4][2];
#pragma unroll
    for (int a = 0; a < 2; ++a)
#pragma unroll
        for (int b = 0; b < 2; ++b)
#pragma unroll
            for (int m = 0; m < 4; ++m)
#pragma unroll
                for (int n = 0; n < 2; ++n) acc[a][b][m][n] = (f32x4){0.f, 0.f, 0.f, 0.f};
    bf16x8 At[4][2], B0[2][2], B1[2][2];
    const char* cA = (const char*)g.A + (size_t)cur.pm * tstepA; const char* cB = (const char*)g.Bt + (size_t)cur.pn * tstepB;
    S.a_ready(cur);
    if constexpr (SP2) {
        PG8_STAGE(PG8_SB(0, 0), cB, voffB); PG8_STAGE(PG8_SB(0, 1), cB + hstepB, voffB); PG8_STAGE(PG8_SA(0, 0), cA, voffA); PG8_STAGE(PG8_SA(0, 1), cA + hstepA, voffA);
        if (wr == 1) PG8_BAR;
        PG8_WAIT_V(2); PG8_BAR;
        PG8_STAGE(PG8_SB(1, 0), cB + kstep, voffB); PG8_STAGE(PG8_SA(1, 0), cA + kstep, voffA); PG8_STAGE(PG8_SB(1, 1), cB + hstepB + kstep, voffB);
        PG8_WAIT_V(6); PG8_BAR;
    } else {
        PG8_STAGE(PG8_SB(0, 0), cB, voffB); PG8_STAGE(PG8_SA(0, 0), cA, voffA); PG8_STAGE(PG8_SB(0, 1), cB + hstepB, voffB); PG8_STAGE(PG8_SA(0, 1), cA + hstepA, voffA);
        if (wr == 1) PG8_BAR;
        PG8_WAIT_V(4); PG8_BAR;
        PG8_STAGE(PG8_SB(1, 0), cB + kstep, voffB); PG8_STAGE(PG8_SA(1, 0), cA + kstep, voffA); PG8_STAGE(PG8_SB(1, 1), cB + hstepB + kstep, voffB);
        PG8_WAIT_V(6); PG8_BAR;
    }
    for (;;) {
        const bool has_next = S.next(ui + 1, nxt);
        const char* nA = has_next ? (const char*)g.A + (size_t)nxt.pm * tstepA : cA; const char* nB = has_next ? (const char*)g.Bt + (size_t)nxt.pn * tstepB : cB;
        for (int t = 0; t < nt; t += 2) {
            const bool last = (t == nt - 2);
            const char* a1 = cA + (size_t)(t + 1) * kstep;
            const char* a2 = last ? nA : cA + (size_t)(t + 2) * kstep; const char* b2 = last ? nB : cB + (size_t)(t + 2) * kstep;
            const char* a3 = a2 + kstep; const char* b3 = b2 + kstep;
            if (last && has_next) S.a_ready(nxt);
            if constexpr (SP2) {
            PG8_LDB(B0, 0, 0); PG8_LDB(B1, 0, 1); PG8_SCHED; PG8_LDA(At, 0, 0); PG8_STAGE(PG8_SA(1, 1), a1 + hstepA, voffA);
            PG8_WAIT_V(8); PG8_WAIT_L(0); PG8_BAR; PG8_MMA(0, 0, At, B0); PG8_MMA(0, 1, At, B1); PG8_BAR; PG8_SCHED;
            PG8_LDA(At, 0, 1); PG8_STAGE(PG8_SB(0, 0), b2, voffB); PG8_STAGE(PG8_SB(0, 1), b2 + hstepB, voffB); PG8_STAGE(PG8_SA(0, 0), a2, voffA);
            PG8_WAIT_V(8); PG8_WAIT_L(0); PG8_BAR; PG8_MMA(1, 0, At, B0); PG8_MMA(1, 1, At, B1); PG8_BAR; PG8_SCHED;
            PG8_LDB(B0, 1, 0); PG8_LDB(B1, 1, 1); PG8_SCHED; PG8_LDA(At, 1, 0); PG8_STAGE(PG8_SA(0, 1), a2 + hstepA, voffA);
            PG8_WAIT_V(8); PG8_WAIT_L(0); PG8_BAR; PG8_MMA(0, 0, At, B0); PG8_MMA(0, 1, At, B1); PG8_BAR; PG8_SCHED;
            PG8_LDA(At, 1, 1); PG8_STAGE(PG8_SB(1, 0), b3, voffB); PG8_STAGE(PG8_SB(1, 1), b3 + hstepB, voffB); PG8_STAGE(PG8_SA(1, 0), a3, voffA);
            PG8_WAIT_V(8); PG8_WAIT_L(0); PG8_BAR; PG8_MMA(1, 0, At, B0); PG8_MMA(1, 1, At, B1); PG8_BAR; PG8_SCHED;
            } else {
            PG8_LDB(B0, 0, 0); PG8_SCHED; PG8_LDA(At, 0, 0); PG8_STAGE(PG8_SA(1, 1), a1 + hstepA, voffA);
            PG8_WAIT_L(8); PG8_BAR; PG8_WAIT_L(0); PG8_MMA(0, 0, At, B0); PG8_BAR; PG8_SCHED;
            PG8_LDB(B1, 0, 1); PG8_STAGE(PG8_SB(0, 0), b2, voffB);
            PG8_BAR; PG8_WAIT_L(0); PG8_MMA(0, 1, At, B1); PG8_BAR;
            PG8_LDA(At, 0, 1); PG8_STAGE(PG8_SA(0, 0), a2, voffA);
            PG8_BAR; PG8_WAIT_L(0); PG8_MMA(1, 0, At, B0); PG8_BAR; PG8_SCHED;
            PG8_STAGE(PG8_SB(0, 1), b2 + hstepB, voffB);
            PG8_WAIT_V(6); PG8_BAR; PG8_MMA(1, 1, At, B1); PG8_BAR;
            PG8_LDB(B0, 1, 0); PG8_SCHED; PG8_LDA(At, 1, 0); PG8_STAGE(PG8_SA(0, 1), a2 + hstepA, voffA);
            PG8_WAIT_L(8); PG8_BAR; PG8_WAIT_L(0); PG8_MMA(0, 0, At, B0); PG8_BAR; PG8_SCHED;
            PG8_LDB(B1, 1, 1); PG8_STAGE(PG8_SB(1, 0), b3, voffB);
            PG8_BAR; PG8_WAIT_L(0); PG8_MMA(0, 1, At, B1); PG8_BAR;
            PG8_LDA(At, 1, 1); PG8_STAGE(PG8_SA(1, 0), a3, voffA);
            PG8_BAR; PG8_WAIT_L(0); PG8_MMA(1, 0, At, B0); PG8_BAR; PG8_SCHED;
            PG8_STAGE(PG8_SB(1, 1), b3 + hstepB, voffB);
            PG8_WAIT_V(6); PG8_BAR; PG8_MMA(1, 1, At, B1); PG8_BAR;
            }
        }
        if constexpr (ALIGN_EPI) { if (wr == 0) PG8_BAR; }
        if constexpr (!Epi::AFTER_DRAIN) { E(acc, cur, wr, wc, fr, fq); S.done(cur); }
        if (!has_next) break;
#pragma unroll
        for (int a = 0; a < 2; ++a)
#pragma unroll
            for (int b = 0; b < 2; ++b)
#pragma unroll
                for (int m = 0; m < 4; ++m)
#pragma unroll
                    for (int n = 0; n < 2; ++n) acc[a][b][m][n] = (f32x4){0.f, 0.f, 0.f, 0.f};
        cur = nxt; cA = nA; cB = nB; ++ui;
        if constexpr (ALIGN_EPI) { if (wr == 1) PG8_BAR; }
    }
    PG8_WAIT_V(0);
    if constexpr (!ALIGN_EPI) { if (wr == 0) PG8_BAR; }
    PG8_BAR;
    if constexpr (Epi::AFTER_DRAIN) { E.fused(acc, cur, wr, wc, fr, fq, lds, wid, lane); S.done(cur); }
#undef PG8_SA
#undef PG8_SB
#undef PG8_STAGE
#undef PG8_LDA
#undef PG8_LDB
#undef PG8_MMA
#undef PG8_WAIT_V
#undef PG8_WAIT_L
#undef PG8_BAR
#undef PG8_SCHED
}

}

typedef GAS unsigned gu32;
#define RLX_AGENT __ATOMIC_RELAXED, __HIP_MEMORY_SCOPE_AGENT
#define XB_TMO      128
#define XB_XCNT(j)  (256  + 64 * (j))
#define XB_XSUB(j)  (1280 + 64 * (j))
#define XB_XGEN(j)  (2304 + 64 * (j))
#define XB_TOP      3328
#define XB_TOPGEN   3392
#define XCD_BAR_WORDS 3456
#define XB_SPIN_CAP (1u << 18)

__device__ __forceinline__ unsigned xb_ld(unsigned* p)              { return __hip_atomic_load(p, __ATOMIC_RELAXED, __HIP_MEMORY_SCOPE_AGENT); }
__device__ __forceinline__ unsigned xb_add(unsigned* p, unsigned v) { return __hip_atomic_fetch_add(p, v, __ATOMIC_RELAXED, __HIP_MEMORY_SCOPE_AGENT); }
__device__ __forceinline__ unsigned xb_xcc_id() { return (unsigned)__builtin_amdgcn_s_getreg((3 << 11) | 20) & 0xFu; }
#define XB_SPIN(cond, bar) do { unsigned _sp = 0; while (cond) { __builtin_amdgcn_s_sleep(1); \
    if ((++_sp & 255u) == 0u) { if (xb_ld(&(bar)[XB_TMO])) break; if (_sp > XB_SPIN_CAP) { atomicAdd(&(bar)[XB_TMO], 1u); break; } } } } while (0)

struct XcdBarrier {
    unsigned* bar; unsigned x;
    volatile LAS unsigned* st;
};

__device__ __forceinline__ XcdBarrier xcd_barrier_post(unsigned* bar, volatile LAS unsigned* st) {
    XcdBarrier b; b.bar = bar; b.x = xb_xcc_id(); b.st = st;
    if (threadIdx.x == 0) (void)xb_add(&bar[XB_XCNT(b.x)], 1u);
    return b;
}
__device__ __forceinline__ void xcd_barrier_complete(unsigned* bar, unsigned x, unsigned& nloc, unsigned& nx) {
    const unsigned G = gridDim.x * gridDim.y * gridDim.z;
    unsigned sum, cnt, mine, sp = 0u;
    for (;;) {
        sum = 0u; cnt = 0u; mine = 0u;
#pragma unroll
        for (unsigned j = 0; j < 16; ++j) { const unsigned c = xb_ld(&bar[XB_XCNT(j)]); sum += c; cnt += (c > 0u) ? 1u : 0u; mine = (j == x) ? c : mine; }
        if (sum == G) break;
        __builtin_amdgcn_s_sleep(1);
        if ((++sp & 255u) == 0u) { if (xb_ld(&bar[XB_TMO])) break; if (sp > XB_SPIN_CAP) { atomicAdd(&bar[XB_TMO], 1u); break; } }
    }
    nloc = mine > 0u ? mine : 1u; nx = cnt > 0u ? cnt : 1u;
}

__device__ __forceinline__ void xcd_barrier(const XcdBarrier& b) {
    asm volatile("s_waitcnt vmcnt(0)" ::: "memory");
    __syncthreads();
    if (threadIdx.x == 0) {
        unsigned* bar = b.bar;
        __builtin_amdgcn_s_waitcnt(0);
        unsigned nloc = b.st[0], nx = b.st[1];
        if (nloc == 0u) { xcd_barrier_complete(bar, b.x, nloc, nx); b.st[0] = nloc; b.st[1] = nx; }
        const unsigned old = xb_add(&bar[XB_XSUB(b.x)], 1u);
        const unsigned gen = old / nloc;
        if (old + 1u == (gen + 1u) * nloc) {
            __builtin_amdgcn_fence(__ATOMIC_RELEASE, "agent");
            asm volatile("s_waitcnt vmcnt(0)" ::: "memory");
            const unsigned og = xb_add(&bar[XB_TOP], 1u);
            const unsigned tg = og / nx;
            if (og + 1u == (tg + 1u) * nx) xb_add(&bar[XB_TOPGEN], 1u);
            else XB_SPIN(xb_ld(&bar[XB_TOPGEN]) == tg, bar);
            __builtin_amdgcn_fence(__ATOMIC_ACQUIRE, "agent");
            xb_add(&bar[XB_XGEN(b.x)], 1u);
            asm volatile("s_waitcnt vmcnt(0)" ::: "memory");
        } else {
            XB_SPIN(xb_ld(&bar[XB_XGEN(b.x)]) == gen, bar);
            __builtin_amdgcn_fence(__ATOMIC_ACQUIRE, "agent");
            asm volatile("s_waitcnt vmcnt(0)" ::: "memory");
        }
    }
    __syncthreads();
}

#define LDS_WAIT() asm volatile("s_waitcnt lgkmcnt(0)" ::: "memory")
#define VM_WAIT() asm volatile("s_waitcnt vmcnt(0)" ::: "memory")
#define MFMA32 __builtin_amdgcn_mfma_f32_32x32x16_bf16
__device__ __forceinline__ float wave_sum(float v) {
#pragma unroll
    for (int o = 1; o < 64; o <<= 1) v += __shfl_xor(v, o);
    return v;
}
__device__ __forceinline__ float swap_max(float m) { auto rr = __builtin_amdgcn_permlane32_swap(__float_as_uint(m), __float_as_uint(m), false, false); return fmaxf(__uint_as_float(rr[0]), __uint_as_float(rr[1])); }
__device__ __forceinline__ float swap_sum(float m) { auto rr = __builtin_amdgcn_permlane32_swap(__float_as_uint(m), __float_as_uint(m), false, false); return __uint_as_float(rr[0]) + __uint_as_float(rr[1]); }
__device__ __forceinline__ int crow(int r, int hi) { return (r & 3) + 8 * (r >> 2) + 4 * hi; }
__device__ __forceinline__ int t5_bucket(int dist) {
    if (dist < 16) return dist;
    int b = 16;
    b += (dist >= 19); b += (dist >= 21); b += (dist >= 24); b += (dist >= 27); b += (dist >= 31); b += (dist >= 35); b += (dist >= 40); b += (dist >= 46);
    b += (dist >= 52); b += (dist >= 59); b += (dist >= 67); b += (dist >= 77); b += (dist >= 87); b += (dist >= 99); b += (dist >= 113);
    return b;
}
__device__ __forceinline__ float gelu_tanh(float x) { const float u = 0.7978845608028654f * (x + 0.044715f * x * x * x); return x * __builtin_amdgcn_rcpf(1.0f + __builtin_amdgcn_exp2f(-2.0f * LOG2E * u)); }

__device__ __forceinline__ void tr_item(const float* W, int ldw, bf16* WT, int ldt, int kdst, LAS float* scr, int k0, int n0, int sc, int lane) {
    float tv[32];
    const float* wp = W + (size_t)(k0 + (lane >> 5)) * ldw + (sc >= 0 ? sc : 0);
#pragma unroll
    for (int i = 0; i < 32; ++i) tv[i] = wp[(size_t)(2 * i) * ldw];
#pragma unroll
    for (int i = 0; i < 32; ++i) { const int kk = 2 * i + (lane >> 5); scr[kk * 33 + (lane & 31)] = sc >= 0 ? tv[i] : 0.f; }
    LDS_WAIT(); asm volatile("" ::: "memory");
    const int c = lane & 7;
#pragma unroll
    for (int j = 0; j < 4; ++j) { const int n = (lane >> 3) + 8 * j; const LAS float* s = scr + (8 * c) * 33 + n;
        u32x4 o; o.x = pk2(s[0 * 33], s[1 * 33]); o.y = pk2(s[2 * 33], s[3 * 33]); o.z = pk2(s[4 * 33], s[5 * 33]); o.w = pk2(s[6 * 33], s[7 * 33]);
        *(u32x4*)(WT + (size_t)(n0 + n) * ldt + kdst + k0 + 8 * c) = o; }
    LDS_WAIT(); asm volatile("" ::: "memory");
}
__device__ __forceinline__ void tr_matrix(int kind, const float* W, const float* W2, int Ksrc, int ldw, int Ndst, bf16* WT, int ldt, int kdst, LAS float* scr, int gw, int NGW, int lane) {
    const int nblk = Ndst / 32, nitems = (Ksrc / 64) * nblk;
    for (int it = gw; it < nitems; it += NGW) {
        const int kb = it / nblk, nb = it % nblk, n0 = 32 * nb, n = n0 + (lane & 31);
        const float* src = W; int sc = n;
        if (kind == 1) { sc = n < 1280 ? n : (n < 2304 ? n + 24 : (n < 2328 ? n - 1024 : (n < 2560 ? -1 : n - 232))); }
        else if (kind == 2) { const int pn = n >> 8, w = n & 255; if (w < 128) sc = 128 * pn + w; else { sc = 128 * pn + w - 128; src = W2; } }
        tr_item(src, ldw, WT, ldt, kdst, scr, 64 * kb, n0, sc, lane);
    }
}

template <int NR>
__device__ __forceinline__ void rms_rows_bf16(const float* const (&xrow)[NR], const float* g, bf16* const (&orow)[NR], int lane) {
    f32x4 v[NR][4];
#pragma unroll
    for (int r = 0; r < NR; ++r) { const f32x4* xr = (const f32x4*)xrow[r] + lane;
#pragma unroll
        for (int j = 0; j < 4; ++j) v[r][j] = xr[64 * j]; }
    const f32x4* gr = (const f32x4*)g + lane; f32x4 gv[4];
#pragma unroll
    for (int j = 0; j < 4; ++j) gv[j] = gr[64 * j];
#pragma unroll
    for (int r = 0; r < NR; ++r) { float s = 0.f;
#pragma unroll
        for (int j = 0; j < 4; ++j) s += (v[r][j].x * v[r][j].x + v[r][j].y * v[r][j].y) + (v[r][j].z * v[r][j].z + v[r][j].w * v[r][j].w);
        const float rs = rsqrtf(wave_sum(s) * (1.f / DM) + RMS_EPS);
        u32x2* o8 = (u32x2*)orow[r] + lane;
#pragma unroll
        for (int j = 0; j < 4; ++j) { u32x2 w; w.x = pk2(v[r][j].x * rs * gv[j].x, v[r][j].y * rs * gv[j].y); w.y = pk2(v[r][j].z * rs * gv[j].z, v[r][j].w * rs * gv[j].w); o8[64 * j] = w; } }
}
template <int NR>
__device__ __forceinline__ void norm_res_norm(const bf16* const (&srow)[NR], const float* gA, const float* const (&xin)[NR], float* const (&xout)[NR], const float* gB, bf16* const (&hout)[NR], bool has_h, int lane) {
    u32x2 sw[NR][4]; f32x4 xv[NR][4];
#pragma unroll
    for (int r = 0; r < NR; ++r) { const u32x2* sr = (const u32x2*)srow[r] + lane; const f32x4* xi = (const f32x4*)xin[r] + lane;
#pragma unroll
        for (int j = 0; j < 4; ++j) { sw[r][j] = sr[64 * j]; xv[r][j] = xi[64 * j]; } }
    const f32x4* ga = (const f32x4*)gA + lane; f32x4 gav[4];
#pragma unroll
    for (int j = 0; j < 4; ++j) gav[j] = ga[64 * j];
#pragma unroll
    for (int r = 0; r < NR; ++r) { f32x4 v[4]; float s = 0.f;
#pragma unroll
        for (int j = 0; j < 4; ++j) { const u32x2 w = sw[r][j]; v[j] = (f32x4){bflo(w.x), bfhi(w.x), bflo(w.y), bfhi(w.y)}; s += (v[j].x * v[j].x + v[j].y * v[j].y) + (v[j].z * v[j].z + v[j].w * v[j].w); }
        const float rA = rsqrtf(wave_sum(s) * (1.f / DM) + RMS_EPS);
        f32x4* xo = (f32x4*)xout[r] + lane; float s2 = 0.f;
#pragma unroll
        for (int j = 0; j < 4; ++j) { v[j] = xv[r][j] + v[j] * rA * gav[j]; xo[64 * j] = v[j]; s2 += (v[j].x * v[j].x + v[j].y * v[j].y) + (v[j].z * v[j].z + v[j].w * v[j].w); }
        if (has_h) {
            const float rB = rsqrtf(wave_sum(s2) * (1.f / DM) + RMS_EPS);
            const f32x4* gb = (const f32x4*)gB + lane; u32x2* o8 = (u32x2*)hout[r] + lane;
#pragma unroll
            for (int j = 0; j < 4; ++j) { const f32x4 gv = gb[64 * j]; u32x2 w; w.x = pk2(v[j].x * rB * gv.x, v[j].y * rB * gv.y); w.y = pk2(v[j].z * rB * gv.z, v[j].w * rB * gv.w); o8[64 * j] = w; }
        } }
}

__device__ __forceinline__ void compress_unit(int u, LAS unsigned char* lds, const bf16* PA, const unsigned char* wl, bf16* KC, bf16* VC, int tid) {
    const int lane = tid & 63, wid = __builtin_amdgcn_readfirstlane(tid >> 6), r32 = lane & 31, hi = lane >> 5;
    const int half = u & 1, kv = (u >> 1) & 1, g = (u >> 2) & 1, b = u >> 3;
    const bf16* w1t = (const bf16*)(wl + (kv ? WL_W1V : WL_W1K));
    const bf16* w2t = (const bf16*)(wl + (kv ? WL_W2V : WL_W2K));
    const float* posb = (const float*)(wl + (kv ? WL_POSV : WL_POSK));
    const bf16* Asrc = PA + (size_t)b * SEQ * NPA + (kv ? PA_VC : PA_KC) + g * 64;
    bf16* Out = (kv ? VC : KC) + (size_t)((b * 2 + g) * 128) * 64;
    LAS bf16* H1 = (LAS bf16*)lds;
    {
        const int ctile = wid & 1, ntile = wid >> 1;
        const int c = 64 * half + 32 * ctile + r32;
        const bf16* wrow = w1t + (size_t)(32 * ntile + r32) * 2048 + 8 * hi;
        f32x16 acc = {};
        for (int jj = 0; jj < 32; ++jj) {
            int tok = 16 * c + jj; tok = tok > SEQ - 1 ? SEQ - 1 : tok;
            const bf16* arow = Asrc + (size_t)tok * NPA + 8 * hi;
#pragma unroll
            for (int q = 0; q < 4; ++q) {
                const bf16x8 af = *(const bf16x8*)(wrow + jj * 64 + q * 16);
                const bf16x8 bfr = *(const bf16x8*)(arow + q * 16);
                acc = MFMA32(af, bfr, acc, 0, 0, 0);
            }
        }
#pragma unroll
        for (int k4 = 0; k4 < 4; ++k4) { const int n0 = 32 * ntile + 8 * k4 + 4 * hi; const f32x4 pb = *(const f32x4*)(posb + n0);
            u32x2 w; w.x = pk2(gelu_tanh(acc[4 * k4 + 0] + pb.x), gelu_tanh(acc[4 * k4 + 1] + pb.y)); w.y = pk2(gelu_tanh(acc[4 * k4 + 2] + pb.z), gelu_tanh(acc[4 * k4 + 3] + pb.w));
            *(LAS u32x2*)(H1 + (32 * ctile + r32) * 136 + n0) = w; }
    }
    __syncthreads();
    if (wid < 4) {
        const int ct2 = wid & 1, dt = wid >> 1;
        f32x16 a2 = {};
#pragma unroll
        for (int ks = 0; ks < 8; ++ks) {
            const bf16x8 af = *(const bf16x8*)(w2t + (size_t)(32 * dt + r32) * 128 + 16 * ks + 8 * hi);
            const bf16x8 bfr = *(const LAS bf16x8*)(H1 + (32 * ct2 + r32) * 136 + 16 * ks + 8 * hi);
            a2 = MFMA32(af, bfr, a2, 0, 0, 0);
        }
#pragma unroll
        for (int k4 = 0; k4 < 4; ++k4) { u32x2 w; w.x = pk2(a2[4 * k4 + 0], a2[4 * k4 + 1]); w.y = pk2(a2[4 * k4 + 2], a2[4 * k4 + 3]);
            *(u32x2*)(Out + (size_t)(64 * half + 32 * ct2 + r32) * 64 + 32 * dt + 8 * k4 + 4 * hi) = w; }
    }
    __syncthreads();
}
__device__ __forceinline__ void kmean_unit(int b, int n, LAS unsigned char* lds, const bf16* PA, float* KMEAN, int tid) {
    const int chunk = tid & 31, tg = tid >> 5;
    const bf16* src = PA + ((size_t)b * SEQ + 256 * n + 16 * tg) * NPA + PA_KM + 8 * chunk;
    f32x4 s0 = {0.f, 0.f, 0.f, 0.f}, s1 = {0.f, 0.f, 0.f, 0.f};
#pragma unroll 4
    for (int t = 0; t < 16; ++t) { const u32x4 w = *(const u32x4*)(src + (size_t)t * NPA); f32x4 a, c; pg8::unpack8(w, a, c); s0 += a; s1 += c; }
    LAS float* red = (LAS float*)lds;
    *(LAS f32x4*)(red + tg * 256 + 8 * chunk) = s0; *(LAS f32x4*)(red + tg * 256 + 8 * chunk + 4) = s1;
    __syncthreads();
    if (tid < 256) { float s = 0.f;
#pragma unroll
        for (int t = 0; t < 16; ++t) s += red[t * 256 + tid];
        KMEAN[((size_t)(b * 4 + (tid >> 6)) * 8 + n) * 64 + (tid & 63)] = s * (1.f / 256.f); }
    __syncthreads();
}

__device__ __forceinline__ void stage_kv(LAS unsigned char* buf, const bf16* kptr, const bf16* vptr, int pitch, int wid, int lane) {
    const bf16* ks = kptr + (size_t)lane * pitch + wid * 8;
    const bf16* vs = vptr + (size_t)(16 * (wid & 3) + (lane >> 2)) * pitch + (wid >> 2) * 32 + (lane & 3) * 8;
    __builtin_amdgcn_global_load_lds((const unsigned*)ks, (LAS unsigned*)(buf + wid * 1024), 16, 0, 0);
    __builtin_amdgcn_global_load_lds((const unsigned*)vs, (LAS unsigned*)(buf + 8192 + wid * 1024), 16, 0, 0);
}
__device__ __forceinline__ bf16x8 pack_p(const f32x16& p, int s) {
    u32x4 w; w.x = pg8::cvt_pk_bf16(p[8 * s + 0], p[8 * s + 1]); w.y = pg8::cvt_pk_bf16(p[8 * s + 2], p[8 * s + 3]); w.z = pg8::cvt_pk_bf16(p[8 * s + 4], p[8 * s + 5]); w.w = pg8::cvt_pk_bf16(p[8 * s + 6], p[8 * s + 7]);
    return __builtin_bit_cast(bf16x8, w);
}
__device__ __forceinline__ bf16x8 vfrag(const LAS unsigned char* p) {
    const s16x4 lo = __builtin_bit_cast(s16x4, __builtin_amdgcn_ds_read_tr16_b64_v4i16((LAS s16x4*)p));
    const s16x4 hi = __builtin_bit_cast(s16x4, __builtin_amdgcn_ds_read_tr16_b64_v4i16((LAS s16x4*)(p + 512)));
    return (bf16x8){lo[0], lo[1], lo[2], lo[3], hi[0], hi[1], hi[2], hi[3]};
}
struct WState { f32x16 o0, o1; float m, l; int first; };
__device__ __forceinline__ void ws_reset(WState& S) { S.o0 = f32x16{}; S.o1 = f32x16{}; S.m = 0.f; S.l = 0.f; S.first = 1; }
__device__ __forceinline__ void attn_tile(WState& S, const bf16x8 (&q)[4], const LAS unsigned char* buf, float cadd, bool near, const LAS float* nearp, int r32, int hi, int lane) {
    const float ci = cadd - S.m;
    f32x16 p0, p1;
#pragma unroll
    for (int r = 0; r < 16; ++r) { p0[r] = ci; p1[r] = ci; }
    const LAS unsigned char* kb = buf + hi * 1024 + r32 * 16;
#pragma unroll
    for (int ks = 0; ks < 4; ++ks) {
        const bf16x8 k0f = *(const LAS bf16x8*)(kb + ks * 2048), k1f = *(const LAS bf16x8*)(kb + ks * 2048 + 512);
        p0 = MFMA32(k0f, q[ks], p0, 0, 0, 0); p1 = MFMA32(k1f, q[ks], p1, 0, 0, 0);
    }
    if (near) {
#pragma unroll
        for (int r = 0; r < 16; ++r) { const int c = (r & 3) + 8 * (r >> 2); p0[r] += nearp[63 - c]; p1[r] += nearp[31 - c]; }
    }
    float rm = fmaxf(p0[0], p1[0]);
#pragma unroll
    for (int r = 1; r < 16; ++r) rm = fmaxf(rm, fmaxf(p0[r], p1[r]));
    rm = swap_max(rm);
    const float d = S.first ? rm : fmaxf(rm, 0.f);
    const float f = S.first ? 1.f : __builtin_amdgcn_exp2f(-d);
    S.m += d; S.first = 0;
    float ls = 0.f;
#pragma unroll
    for (int r = 0; r < 16; ++r) { p0[r] = __builtin_amdgcn_exp2f(p0[r] - d); p1[r] = __builtin_amdgcn_exp2f(p1[r] - d); ls += p0[r] + p1[r]; }
    S.l = S.l * f + ls;
    S.o0 *= f; S.o1 *= f;
    bf16x8 pa[4]; pa[0] = pack_p(p0, 0); pa[1] = pack_p(p0, 1); pa[2] = pack_p(p1, 0); pa[3] = pack_p(p1, 1);
    const LAS unsigned char* vb = buf + 8192 + ((lane >> 4) & 1) * 32 + (lane & 3) * 8 + (4 * hi + ((lane & 15) >> 2)) * 64;
#pragma unroll
    for (int s4 = 0; s4 < 4; ++s4) {
        const bf16x8 v0 = vfrag(vb + s4 * 1024), v1 = vfrag(vb + 4096 + s4 * 1024);
        S.o0 = MFMA32(v0, pa[s4], S.o0, 0, 0, 0); S.o1 = MFMA32(v1, pa[s4], S.o1, 0, 0, 0);
    }
}
__device__ __forceinline__ void store_ot(bf16* op  , const f32x16& o0, const f32x16& o1) {
#pragma unroll
    for (int k4 = 0; k4 < 4; ++k4) {
        u32x2 w0, w1; w0.x = pk2(o0[4 * k4 + 0], o0[4 * k4 + 1]); w0.y = pk2(o0[4 * k4 + 2], o0[4 * k4 + 3]); w1.x = pk2(o1[4 * k4 + 0], o1[4 * k4 + 1]); w1.y = pk2(o1[4 * k4 + 2], o1[4 * k4 + 3]);
        *(u32x2*)(op + 8 * k4) = w0; *(u32x2*)(op + 32 + 8 * k4) = w1;
    }
}
__device__ __forceinline__ void attn_tables(LAS unsigned char* lds, const float* rel_bias, int tid) {
    LAS float* tab = (LAS float*)(lds + A_TAB);
    for (int e = tid; e < 20 * TABN; e += 512) { const int t = e / TABN, i = e % TABN, dist = i - 96, head = t < 8 ? t : t - 8; const bool win = t >= 8 && t < 16;
        float v = NEGB; if (dist >= 0 && !(win && dist >= 256)) { const int bk = dist >= 128 ? 31 : t5_bucket(dist); v = rel_bias[bk * 12 + head] * LOG2E; }
        tab[e] = v; }
    LAS float* ct = (LAS float*)(lds + A_CTAB);
    for (int e = tid; e < 8 * CTABN; e += 512) { const int hd = e / CTABN, i = e % CTABN; float v = NEGB;
        if (i >= 1 && i <= 129) { const int dist = i - 1; const int bk = dist >= 128 ? 31 : t5_bucket(dist); v = rel_bias[bk * 12 + hd] * LOG2E; }
        ct[e] = v; }
    __syncthreads();
}

__device__ __forceinline__ void nsa_unit(int b, int g, int qb, LAS unsigned char* lds, const bf16* PA, const bf16* KC, const bf16* VC, bf16* OC, int tid) {
    const int lane = tid & 63, wid = __builtin_amdgcn_readfirstlane(tid >> 6), r32 = lane & 31, hi = lane >> 5;
    const int hh = wid & 3, wq = wid >> 2, head = g * 4 + hh, tq0 = 64 * qb + 32 * wq;
    const size_t row = (size_t)b * SEQ + tq0 + r32;
    bf16x8 q[4];
    { const bf16* qp = PA + row * NPA + PA_QN + head * 64 + 8 * hi;
#pragma unroll
      for (int ks = 0; ks < 4; ++ks) q[ks] = *(const bf16x8*)(qp + 16 * ks); }
    const bf16* gp = PA + row * NPA + PA_GN + head * 3;
    const float g0 = bflo(gp[0]), g1 = bflo(gp[1]), g2 = bflo(gp[2]);
    const bf16* Kc = KC + (size_t)((b * 2 + g) * 128) * 64; const bf16* Vc = VC + (size_t)((b * 2 + g) * 128) * 64;
    const bf16* Ks = PA + (size_t)b * SEQ * NPA + PA_KS + g * 64; const bf16* Vs = PA + (size_t)b * SEQ * NPA + PA_VS + g * 64;
    const bf16* Kw = PA + (size_t)b * SEQ * NPA + PA_KW + g * 64; const bf16* Vw = PA + (size_t)b * SEQ * NPA + PA_VW + g * 64;
    LAS unsigned char* kvb = lds + A_KV; LAS unsigned char* cmpb = lds + A_CMP;
    const int nsel = qb + 1, nwin = qb + 1 < 5 ? qb + 1 : 5, ns = nsel + nwin;
#define NSA_ISSUE(j) do { const int j_ = (j); const bool w_ = j_ >= nsel; const int n_ = w_ ? qb - (j_ - nsel) : qb - j_; \
        stage_kv(kvb + (j_ & 1) * 16384, (w_ ? Kw : Ks) + (size_t)(64 * n_) * NPA, (w_ ? Vw : Vs) + (size_t)(64 * n_) * NPA, NPA, wid, lane); } while (0)
    stage_kv(cmpb, Kc, Vc, 64, wid, lane); stage_kv(cmpb + 16384, Kc + 64 * 64, Vc + 64 * 64, 64, wid, lane);
    NSA_ISSUE(0);
    VM_WAIT(); __syncthreads();
    f32x16 ot0, ot1;
    {
        f32x16 sc[4];
#pragma unroll
        for (int ph = 0; ph < 4; ++ph) sc[ph] = f32x16{};
#pragma unroll
        for (int t = 0; t < 2; ++t) { const LAS unsigned char* kb = cmpb + t * 16384 + hi * 1024 + r32 * 16;
#pragma unroll
            for (int ks = 0; ks < 4; ++ks) { const bf16x8 k0f = *(const LAS bf16x8*)(kb + ks * 2048), k1f = *(const LAS bf16x8*)(kb + ks * 2048 + 512);
                sc[2 * t] = MFMA32(k0f, q[ks], sc[2 * t], 0, 0, 0); sc[2 * t + 1] = MFMA32(k1f, q[ks], sc[2 * t + 1], 0, 0, 0); } }
        __builtin_amdgcn_sched_barrier(0);
        const LAS float* ct = (const LAS float*)(lds + A_CTAB) + head * CTABN;
        const int E0 = tq0 + r32 - 31 - 64 * hi;
        float m = NEGB;
#pragma unroll
        for (int ph = 0; ph < 4; ++ph)
#pragma unroll
            for (int k4 = 0; k4 < 4; ++k4) { int base = E0 - 16 * (32 * ph + 8 * k4); asm volatile("" : "+v"(base));
#pragma unroll
                for (int i = 0; i < 4; ++i) { int dist = base - 16 * i; dist = dist < -1 ? -1 : (dist > 128 ? 128 : dist);
                    sc[ph][4 * k4 + i] += ct[dist + 1]; m = fmaxf(m, sc[ph][4 * k4 + i]); } }
        m = swap_max(m);
        const bool valid = m > -1e29f;
        float l = 0.f;
#pragma unroll
        for (int ph = 0; ph < 4; ++ph)
#pragma unroll
            for (int r = 0; r < 16; ++r) { const float e = valid ? __builtin_amdgcn_exp2f(sc[ph][r] - m) : 0.f; sc[ph][r] = e; l += e; }
        l = swap_sum(l);
        const float inv = valid ? 1.0f / l : 0.f;
#pragma unroll
        for (int ph = 0; ph < 4; ++ph) sc[ph] *= inv;
        {
            LAS float* impw = (LAS float*)(lds + A_IMP) + (hh * 64 + 32 * wq + r32) * 33;
            float prevhi = 0.f;
#pragma unroll
            for (int i = 0; i < 16; ++i) { const int ph = i >> 2, k = i & 3;
                const float av = sc[ph][4 * k] + sc[ph][4 * k + 1] + sc[ph][4 * k + 2] + 0.5f * sc[ph][4 * k + 3], bv = 0.5f * sc[ph][4 * k + 3];
                auto rr = __builtin_amdgcn_permlane32_swap(__float_as_uint(bv), __float_as_uint(bv), false, false);
                const float lo_i = __uint_as_float(rr[0]), hi_i = __uint_as_float(rr[1]);
                impw[2 * k + hi + 8 * ph] = av + (hi ? lo_i : prevhi); prevhi = hi_i; }
        }
        __builtin_amdgcn_sched_barrier(0);
        f32x16 o0 = f32x16{}, o1 = f32x16{};
#pragma unroll
        for (int ph = 0; ph < 4; ++ph)
#pragma unroll
            for (int s = 0; s < 2; ++s) { const bf16x8 pa = pack_p(sc[ph], s);
                const LAS unsigned char* vb = cmpb + (ph >> 1) * 16384 + 8192 + ((lane >> 4) & 1) * 32 + (lane & 3) * 8 + (4 * hi + ((lane & 15) >> 2)) * 64 + (2 * (ph & 1) + s) * 1024;
                const bf16x8 v0 = vfrag(vb), v1 = vfrag(vb + 4096);
                o0 = MFMA32(v0, pa, o0, 0, 0, 0); o1 = MFMA32(v1, pa, o1, 0, 0, 0); }
        ot0 = o0 * g0; ot1 = o1 * g0;
    }
    __syncthreads();
    {
        const LAS float* impb = (const LAS float*)(lds + A_IMP); LAS float* scb = (LAS float*)(lds + A_SC); LAS unsigned* selb = (LAS unsigned*)(lds + A_SEL);
#pragma unroll 1
        for (int it = 0; it < 4; ++it) { const int e = tid + 512 * it, tok = e >> 5, n = e & 31;
            float s = (impb[(0 * 64 + tok) * 33 + n] + impb[(1 * 64 + tok) * 33 + n]) + (impb[(2 * 64 + tok) * 33 + n] + impb[(3 * 64 + tok) * 33 + n]);
            const bool forced = (n == 0) | (n == qb) | (n == qb - 1);
            s = forced ? 1e4f : (n <= qb ? s : NEGB);
            scb[tok * 33 + n] = s;
            LDS_WAIT();
            int rank = 0;
#pragma unroll 8
            for (int mm = 0; mm < 32; ++mm) { const float sm = scb[tok * 33 + mm]; rank += ((sm > s) | ((sm == s) & (mm < n))) ? 1 : 0; }
            const bool sel = (rank < 8) && (s > -5e29f);
            const unsigned long long bal = __ballot(sel);
            if ((lane & 31) == 0) selb[tok] = (unsigned)(bal >> (lane & 32));
        }
    }
    __syncthreads();
    const unsigned mymask = ((const LAS unsigned*)(lds + A_SEL))[32 * wq + r32];
    const LAS float* tabC = (const LAS float*)(lds + A_TAB) + head * TABN; const LAS float* tabW = (const LAS float*)(lds + A_TAB) + (8 + head) * TABN;
    const float cfar = tabC[96 + 128];
    WState S; ws_reset(S);
#pragma unroll 1
    for (int j = 0; j < ns; ++j) {
        VM_WAIT(); __syncthreads();
        if (j + 1 < ns) NSA_ISSUE(j + 1);
        const bool win = j >= nsel;
        if (j == nsel) { const float lt = swap_sum(S.l); const float scl = g1 / lt; ot0 += S.o0 * scl; ot1 += S.o1 * scl; ws_reset(S); }
        const int n = win ? qb - (j - nsel) : qb - j;
        const int a = (tq0 - 64 * n) >> 5;
        const LAS unsigned char* buf = kvb + (j & 1) * 16384;
        const int D0 = tq0 + r32 - 64 * n - 4 * hi;
        if (!win) {
            const bool near = a < 6;
            const float cadd = (((mymask >> n) & 1u) ? 0.f : NEGB) + (near ? 0.f : cfar);
            attn_tile(S, q, buf, cadd, near, tabC + (D0 + 33), r32, hi, lane);
        } else if (a < 10) {
            const bool far = (a == 6) | (a == 7);
            attn_tile(S, q, buf, far ? cfar : 0.f, !far, tabW + (D0 + 33), r32, hi, lane);
        }
    }
    { const float lt = swap_sum(S.l); const float scl = g2 / lt; ot0 += S.o0 * scl; ot1 += S.o1 * scl; }
    store_ot(OC + row * DM + head * 64 + 4 * hi, ot0, ot1);
    __syncthreads();
#undef NSA_ISSUE
}

__device__ __forceinline__ void moba_unit(int b, int h, int ob, LAS unsigned char* lds, const bf16* PA, const float* KMEAN, bf16* OC, int tid) {
    const int lane = tid & 63, wid = __builtin_amdgcn_readfirstlane(tid >> 6), r32 = lane & 31, hi = lane >> 5;
    const int tq0 = 256 * ob + 32 * wid;
    const size_t row = (size_t)b * SEQ + tq0 + r32;
    bf16x8 q[4];
    { const bf16* qp = PA + row * NPA + PA_QM + h * 64 + 8 * hi;
#pragma unroll
      for (int ks = 0; ks < 4; ++ks) q[ks] = *(const bf16x8*)(qp + 16 * ks); }
    const bf16* Km = PA + (size_t)b * SEQ * NPA + PA_KM + h * 64; const bf16* Vm = PA + (size_t)b * SEQ * NPA + PA_VM + h * 64;
    LAS unsigned char* kvb = lds + A_KV;
    const int ns = 4 * (ob + 1);
#define MOBA_ISSUE(j) do { const int j_ = (j); const int n_ = ns - 1 - j_; stage_kv(kvb + (j_ & 1) * 16384, Km + (size_t)(64 * n_) * NPA, Vm + (size_t)(64 * n_) * NPA, NPA, wid, lane); } while (0)
    MOBA_ISSUE(0);
    LAS float* km = (LAS float*)(lds + A_KMEAN); LAS float* mg = (LAS float*)(lds + A_MG);
    km[tid] = KMEAN[(size_t)(b * 4 + h) * 512 + tid];
    __syncthreads();
    {
        const int tok = tid >> 1, hf = tid & 1; const bf16* qrow = PA + ((size_t)b * SEQ + 256 * ob + tok) * NPA + PA_QM + h * 64;
        f32x4 acc = {0.f, 0.f, 0.f, 0.f};
#pragma unroll 1
        for (int c8 = 0; c8 < 8; ++c8) { const u32x4 w = *(const u32x4*)(qrow + 8 * c8); f32x4 qa, qb_; pg8::unpack8(w, qa, qb_);
#pragma unroll
            for (int i = 0; i < 4; ++i) { const LAS float* kp = km + (4 * hf + i) * 64 + 8 * c8; const f32x4 ka = *(const LAS f32x4*)kp, kb = *(const LAS f32x4*)(kp + 4);
                acc[i] += (qa.x * ka.x + qa.y * ka.y) + (qa.z * ka.z + qa.w * ka.w) + (qb_.x * kb.x + qb_.y * kb.y) + (qb_.z * kb.z + qb_.w * kb.w); } }
        *(LAS f32x4*)(mg + tok * 8 + 4 * hf) = acc;
    }
    __syncthreads();
    unsigned mymask = 0u;
    { const LAS float* gp = mg + (32 * wid + r32) * 8; const f32x4 ga = *(const LAS f32x4*)gp, gb = *(const LAS f32x4*)(gp + 4);
      const float gt[8] = {ga.x, ga.y, ga.z, ga.w, gb.x, gb.y, gb.z, gb.w};
#pragma unroll
      for (int n = 0; n < 8; ++n) { int rank = 0;
#pragma unroll
          for (int mm = 0; mm < 8; ++mm) rank += ((mm < ob) & ((gt[mm] > gt[n]) | ((gt[mm] == gt[n]) & (mm < n)))) ? 1 : 0;
          if ((n < ob) & (rank < 3)) mymask |= 1u << n; } }
    const LAS float* tabM = (const LAS float*)(lds + A_TAB) + (16 + h) * TABN;
    const float cfar = tabM[96 + 128];
    WState S; ws_reset(S);
#pragma unroll 1
    for (int j = 0; j < ns; ++j) {
        VM_WAIT(); __syncthreads();
        if (j + 1 < ns) MOBA_ISSUE(j + 1);
        const int n = ns - 1 - j, blk = n >> 2;
        if (tq0 + 31 - 64 * n >= 0) {
            const int a = (tq0 - 64 * n) >> 5;
            const bool near = a < 6;
            float cadd = near ? 0.f : cfar;
            if (blk < ob) cadd += ((mymask >> blk) & 1u) ? 0.f : NEGB;
            const int D0 = tq0 + r32 - 64 * n - 4 * hi;
            attn_tile(S, q, kvb + (j & 1) * 16384, cadd, near, tabM + (D0 + 33), r32, hi, lane);
        }
    }
    { const float lt = swap_sum(S.l); const float scl = 1.0f / lt; S.o0 *= scl; S.o1 *= scl; }
    store_ot(OC + row * DM + 512 + h * 64 + 4 * hi, S.o0, S.o1);
    __syncthreads();
#undef MOBA_ISSUE
}

__device__ __forceinline__ void mem_unit(int b, int h, int tb, LAS unsigned char* lds, const bf16* PA, const bf16* MKV, bf16* OC, int tid) {
    const int lane = tid & 63, wid = __builtin_amdgcn_readfirstlane(tid >> 6), r32 = lane & 31, hi = lane >> 5;
    const int tq0 = 256 * tb + 32 * wid;
    const size_t row = (size_t)b * SEQ + tq0 + r32;
    bf16x8 q[4];
    { const bf16* qp = PA + row * NPA + PA_QX + h * 64 + 8 * hi;
#pragma unroll
      for (int ks = 0; ks < 4; ++ks) q[ks] = *(const bf16x8*)(qp + 16 * ks); }
    const bf16* Kx = MKV + (size_t)b * MEML * 512 + h * 64; const bf16* Vx = Kx + 256;
    LAS unsigned char* kvb = lds + A_KV;
    stage_kv(kvb, Kx, Vx, 512, wid, lane);
    WState S; ws_reset(S);
#pragma unroll 1
    for (int j = 0; j < 4; ++j) {
        VM_WAIT(); __syncthreads();
        if (j + 1 < 4) stage_kv(kvb + ((j + 1) & 1) * 16384, Kx + (size_t)(64 * (j + 1)) * 512, Vx + (size_t)(64 * (j + 1)) * 512, 512, wid, lane);
        attn_tile(S, q, kvb + (j & 1) * 16384, 0.f, false, (const LAS float*)(lds + A_TAB), r32, hi, lane);
    }
    { const float lt = swap_sum(S.l); const float scl = 1.0f / lt; S.o0 *= scl; S.o1 *= scl; }
    store_ot(OC + row * DM + 768 + h * 64 + 4 * hi, S.o0, S.o1);
    __syncthreads();
}

#ifndef MK_MULTI_LAUNCH
#define MK_MULTI_LAUNCH 0
#endif
constexpr int N_PHASES = 19;
struct Args { const float* in[23]; float* out; unsigned char* ws; int ph_lo, ph_hi; };

__global__ void __launch_bounds__(512, 2) fwd_kernel(Args args) {
    extern __shared__ __attribute__((aligned(16))) unsigned char lds_raw[];
    LAS unsigned char* lds = (LAS unsigned char*)lds_raw;
    volatile LAS unsigned* MISC = (volatile LAS unsigned*)(lds + MISC_OFF);
    const int tid = threadIdx.x, lane = tid & 63, wave = __builtin_amdgcn_readfirstlane(tid >> 6);
    const int G = gridDim.x, bx = blockIdx.x; const int vcu = (G % 8 == 0) ? (bx % 8) * (G / 8) + bx / 8 : bx;
    unsigned char* ws = args.ws; unsigned* ctl = (unsigned*)(ws + WS_CTL);
    for (int u = tid; u < (LDS_BYTES - MISC_OFF) / 4; u += 512) MISC[u] = 0u;
    __syncthreads();
    const int lo = args.ph_lo, hi = args.ph_hi;
    XcdBarrier bar; bar.bar = ctl + CW_BAR; bar.x = 0; bar.st = nullptr;
    if (hi - lo > 1) bar = xcd_barrier_post(ctl + CW_BAR, MISC + 8);
#ifndef ATT_EN
#define ATT_EN 7
#endif
#ifndef REP_J
#define REP_J -1
#endif
#define NREP(j) ((REP_J) == (j) ? 2 : 1)
#ifndef PHMASK
#define PHMASK 0x3ff
#endif
#define IN(k) (lo <= (k) && (k) < hi)
#define INJ(j) (((PHMASK >> ((j) + 1)) & 1) && IN(pb + (j)))
#define SEAM(k) do { if (IN(k) && IN((k) + 1)) xcd_barrier(bar); } while (0)
    const float* x_in = args.in[0]; const float* mem_in = args.in[1]; const float* rel_bias = args.in[2];
    const float* pre_mix_g = args.in[3]; const float* mem_norm_g = args.in[4]; const float* post_mix_g = args.in[5];
    const float* pre_ffn_g = args.in[18]; const float* post_ffn_g = args.in[19];
    float* xres = args.out;
    bf16* MEMN = (bf16*)args.out;
    bf16* H = (bf16*)(ws + WS_H); bf16* PA = (bf16*)(ws + WS_PA); bf16* GT = (bf16*)(ws + WS_GT);
    bf16* MERGED = PA; bf16* FB = PA; bf16* YB = GT; bf16* UB = GT;
    bf16* MEMKV = (bf16*)(ws + WS_MEMKV); bf16* KC = (bf16*)(ws + WS_KC); bf16* VC = (bf16*)(ws + WS_VC); float* KMEAN = (float*)(ws + WS_KMEAN);
    const int gw = vcu * 8 + wave, NGW = G * 8;

    if ((PHMASK & 1) && IN(0)) for (int rep_ = 0; rep_ < ((REP_J) == 100 ? 2 : 1); ++rep_) {
        LAS float* scr = (LAS float*)(lds + wave * 16384);
        if ((gw & 7) == 0 && (gw >> 3) < 8) {
            const int t = gw >> 3, l = t >> 2, kv = (t >> 1) & 1, nh = t & 1, n = 64 * nh + lane;
            const float* pos = args.in[kv ? 10 : 7] + (size_t)l * 2048; const float* w1 = args.in[kv ? 11 : 8] + (size_t)l * 2048 * 128;
            float acc = 0.f;
#pragma unroll 8
            for (int k = 0; k < 2048; ++k) acc += pos[k] * w1[(size_t)k * 128 + n];
            ((float*)(ws + WS_W + l * WL_STRIDE + (kv ? WL_POSV : WL_POSK)))[n] = acc;
        }
        for (int l = 0; l < 2; ++l) {
            unsigned char* wl = ws + WS_W + l * WL_STRIDE;
#pragma unroll 1
            for (int mi = 0; mi < 12; ++mi) {
                int kind = 0, Ksrc = 0, ldw = 0, Ndst = 0, ldt = 0, kdst = 0; const float* W = nullptr; const float* W2 = nullptr; bf16* WT = nullptr;
                switch (mi) {
                    case 0: kind = 1; W = args.in[6] + (size_t)l * 1024 * INW; Ksrc = 1024; ldw = INW; Ndst = NIN; WT = (bf16*)(wl + WL_IN); ldt = 1024; break;
                    case 1: kind = 2; W = args.in[20] + (size_t)l * 1024 * DFF; W2 = args.in[21] + (size_t)l * 1024 * DFF; Ksrc = 1024; ldw = DFF; Ndst = NGU; WT = (bf16*)(wl + WL_GU); ldt = 1024; break;
                    case 2: W = args.in[22] + (size_t)l * DFF * 1024; Ksrc = DFF; ldw = 1024; Ndst = 1024; WT = (bf16*)(wl + WL_DN); ldt = DFF; break;
                    case 3: W = args.in[14] + (size_t)l * 512 * 1024; Ksrc = 512; ldw = 1024; Ndst = 1024; WT = (bf16*)(wl + WL_BR); ldt = 1024; kdst = 0; break;
                    case 4: W = args.in[15] + (size_t)l * 256 * 1024; Ksrc = 256; ldw = 1024; Ndst = 1024; WT = (bf16*)(wl + WL_BR); ldt = 1024; kdst = 512; break;
                    case 5: W = args.in[16] + (size_t)l * 256 * 1024; Ksrc = 256; ldw = 1024; Ndst = 1024; WT = (bf16*)(wl + WL_BR); ldt = 1024; kdst = 768; break;
                    case 6: W = args.in[17] + (size_t)l * 1024 * 1024; Ksrc = 1024; ldw = 1024; Ndst = 1024; WT = (bf16*)(wl + WL_MIX); ldt = 1024; break;
                    case 7: W = args.in[13] + (size_t)l * 1024 * 512; Ksrc = 1024; ldw = 512; Ndst = 512; WT = (bf16*)(wl + WL_MKV); ldt = 1024; break;
                    case 8: W = args.in[8] + (size_t)l * 2048 * 128; Ksrc = 2048; ldw = 128; Ndst = 128; WT = (bf16*)(wl + WL_W1K); ldt = 2048; break;
                    case 9: W = args.in[11] + (size_t)l * 2048 * 128; Ksrc = 2048; ldw = 128; Ndst = 128; WT = (bf16*)(wl + WL_W1V); ldt = 2048; break;
                    case 10: W = args.in[9] + (size_t)l * 128 * 64; Ksrc = 128; ldw = 64; Ndst = 64; WT = (bf16*)(wl + WL_W2K); ldt = 128; break;
                    default: W = args.in[12] + (size_t)l * 128 * 64; Ksrc = 128; ldw = 64; Ndst = 64; WT = (bf16*)(wl + WL_W2V); ldt = 128; break;
                }
                tr_matrix(kind, W, W2, Ksrc, ldw, Ndst, WT, ldt, kdst, scr, gw, NGW, lane);
            }
        }
        for (int m0 = 4 * gw; m0 < 2 * NMEM; m0 += 4 * NGW) { const int l = m0 / NMEM, r = m0 % NMEM;
            const float* xr[4] = {mem_in + (size_t)r * DM, mem_in + (size_t)(r + 1) * DM, mem_in + (size_t)(r + 2) * DM, mem_in + (size_t)(r + 3) * DM};
            bf16* orow[4] = {MEMN + (size_t)m0 * DM, MEMN + (size_t)(m0 + 1) * DM, MEMN + (size_t)(m0 + 2) * DM, MEMN + (size_t)(m0 + 3) * DM};
            rms_rows_bf16<4>(xr, mem_norm_g + l * DM, orow, lane); }
        for (int m0 = 4 * gw; m0 < NTOK; m0 += 4 * NGW) {
            const float* xr[4] = {x_in + (size_t)m0 * DM, x_in + (size_t)(m0 + 1) * DM, x_in + (size_t)(m0 + 2) * DM, x_in + (size_t)(m0 + 3) * DM};
            bf16* orow[4] = {H + (size_t)m0 * DM, H + (size_t)(m0 + 1) * DM, H + (size_t)(m0 + 2) * DM, H + (size_t)(m0 + 3) * DM};
            rms_rows_bf16<4>(xr, pre_mix_g, orow, lane); }
    }
    SEAM(0);

#pragma unroll 1
    for (int l = 0; l < 2; ++l) {
        const int pb = 1 + 9 * l;
        unsigned char* wl = ws + WS_W + l * WL_STRIDE;
        if (INJ(0)) for (int rep_ = 0; rep_ < NREP(0); ++rep_) {
            { pg8::Gemm g{H, (const bf16*)(wl + WL_IN), NTOK, NIN, 1024, 1024, 1024}; pg8::StaticOrder S; S.init(NTOK, NIN, G, bx);
              pg8::EpiProj E{PA, GT}; pg8::gemm_phase<pg8::EpiProj, pg8::StaticOrder, true, true>(lds, g, S, E); }
            if (l == 0) {
#pragma unroll 1
                for (int l2 = 0; l2 < 2; ++l2) { pg8::Gemm g{MEMN + (size_t)l2 * NMEM * DM, (const bf16*)(ws + WS_W + l2 * WL_STRIDE + WL_MKV), NMEM, 512, 1024, 1024, 1024};
                    pg8::StaticOrder S; S.init(NMEM, 512, G, bx); pg8::EpiPlain E{MEMKV + (size_t)l2 * NMEM * 512, 512};
                    pg8::gemm_phase<pg8::EpiPlain, pg8::StaticOrder, true, true>(lds, g, S, E); }
            }
        }
        SEAM(pb + 0);
        if (INJ(1)) for (int rep_ = 0; rep_ < NREP(1); ++rep_) {
            int tid_p = tid; asm volatile("" : "+v"(tid_p));
            for (int u = bx; u < 256; u += G) {
                if (u < 128) compress_unit(u, lds, PA, wl, KC, VC, tid_p);
                else kmean_unit((u - 128) >> 3, (u - 128) & 7, lds, PA, KMEAN, tid_p);
            }
        }
        SEAM(pb + 1);
        if (INJ(2)) for (int rep_ = 0; rep_ < NREP(2); ++rep_) {
            int tid_p = tid; asm volatile("" : "+v"(tid_p));
            attn_tables(lds, rel_bias, tid_p);
            if (ATT_EN & 1)
#pragma unroll 1
            for (int P = vcu; P < 512; P += G) { const int bg = P >> 4, s = P & 15;
#pragma unroll 1
                for (int k = 0; k < 2; ++k) nsa_unit(bg >> 1, bg & 1, k ? 31 - s : s, lds, PA, KC, VC, H, tid_p); }
            if (ATT_EN & 2)
#pragma unroll 1
            for (int M = vcu; M < 256; M += G) { const int bh = M >> 2, s = M & 3;
#pragma unroll 1
                for (int k = 0; k < 2; ++k) moba_unit(bh >> 2, bh & 3, k ? 7 - s : s, lds, PA, KMEAN, H, tid_p); }
            if (ATT_EN & 4)
#pragma unroll 1
            for (int u = vcu; u < 512; u += G) { const int bh = u >> 3; mem_unit(bh >> 2, bh & 3, u & 7, lds, PA, MEMKV + (size_t)l * NMEM * 512, H, tid_p); }
        }
        SEAM(pb + 2);
        if (INJ(3)) for (int rep_ = 0; rep_ < NREP(3); ++rep_) {
#pragma unroll 1
            for (int br = 0; br < 3; ++br) { const int koff = br == 0 ? 0 : (br == 1 ? 512 : 768), K = br == 0 ? 512 : 256;
                pg8::Gemm g{H + koff, (const bf16*)(wl + WL_BR) + koff, NTOK, 1024, K, 1024, 1024}; pg8::StaticOrder S; S.init(NTOK, 1024, G, bx);
                pg8::EpiMerge E{MERGED, 1024, GT + br * 1024, NGT, br == 0 ? 1 : 0};
                pg8::gemm_phase<pg8::EpiMerge, pg8::StaticOrder, true, true>(lds, g, S, E);
                VM_WAIT(); __syncthreads(); }
        }
        SEAM(pb + 3);
        if (INJ(4)) for (int rep_ = 0; rep_ < NREP(4); ++rep_) {
            pg8::Gemm g{MERGED, (const bf16*)(wl + WL_MIX), NTOK, 1024, 1024, 1024, 1024}; pg8::StaticOrder S; S.init(NTOK, 1024, G, bx);
            pg8::EpiPlain E{YB, 1024}; pg8::gemm_phase<pg8::EpiPlain, pg8::StaticOrder, true, true>(lds, g, S, E);
        }
        SEAM(pb + 4);
        if (INJ(5)) for (int rep_ = 0; rep_ < (((REP_J) == 5 && l == 0) ? 2 : 1); ++rep_) {
            int lane_p = lane; asm volatile("" : "+v"(lane_p));
            const float* xin = l == 0 ? x_in : xres;
            for (int m0 = 2 * gw; m0 < NTOK; m0 += 2 * NGW) {
                const bf16* sr[2] = {YB + (size_t)m0 * DM, YB + (size_t)(m0 + 1) * DM}; const float* xi[2] = {xin + (size_t)m0 * DM, xin + (size_t)(m0 + 1) * DM};
                float* xo[2] = {xres + (size_t)m0 * DM, xres + (size_t)(m0 + 1) * DM}; bf16* ho[2] = {H + (size_t)m0 * DM, H + (size_t)(m0 + 1) * DM};
                norm_res_norm<2>(sr, post_mix_g + l * DM, xi, xo, pre_ffn_g + l * DM, ho, true, lane_p); }
        }
        SEAM(pb + 5);
        if (INJ(6)) for (int rep_ = 0; rep_ < NREP(6); ++rep_) {
            pg8::Gemm g{H, (const bf16*)(wl + WL_GU), NTOK, NGU, 1024, 1024, 1024}; pg8::StaticOrder S; S.init(NTOK, NGU, G, bx);
            pg8::EpiSwiGLU E{UB, DFF}; pg8::gemm_phase<pg8::EpiSwiGLU, pg8::StaticOrder, true, true>(lds, g, S, E);
        }
        SEAM(pb + 6);
        if (INJ(7)) for (int rep_ = 0; rep_ < NREP(7); ++rep_) {
            pg8::Gemm g{UB, (const bf16*)(wl + WL_DN), NTOK, 1024, DFF, DFF, DFF}; pg8::StaticOrder S; S.init(NTOK, 1024, G, bx);
            pg8::EpiPlain E{FB, 1024}; pg8::gemm_phase<pg8::EpiPlain, pg8::StaticOrder, true, true>(lds, g, S, E);
        }
        SEAM(pb + 7);
        if (INJ(8)) {
            int lane_p = lane; asm volatile("" : "+v"(lane_p));
            for (int m0 = 2 * gw; m0 < NTOK; m0 += 2 * NGW) {
                const bf16* sr[2] = {FB + (size_t)m0 * DM, FB + (size_t)(m0 + 1) * DM}; const float* xi[2] = {xres + (size_t)m0 * DM, xres + (size_t)(m0 + 1) * DM};
                float* xo[2] = {xres + (size_t)m0 * DM, xres + (size_t)(m0 + 1) * DM}; bf16* ho[2] = {H + (size_t)m0 * DM, H + (size_t)(m0 + 1) * DM};
                norm_res_norm<2>(sr, post_ffn_g + l * DM, xi, xo, pre_mix_g + DM, ho, l == 0, lane_p); }
        }
        SEAM(pb + 8);
    }
#undef IN
#undef INJ
#undef SEAM
}

extern "C" void kernel_launch(void* const* d_in, const int* in_sizes, int n_in, void* d_out, int out_size, void* d_ws, size_t ws_size, hipStream_t stream) {
    static int grid = 0;
    if (grid == 0) {
        if (n_in != 23 || in_sizes[0] != NTOK * DM || out_size != NTOK * DM || ws_size < WS_END) { fprintf(stderr, "kernel_launch: unexpected shapes (n_in %d, in0 %d, out %d, ws %zu); nothing launched\n", n_in, n_in > 0 ? in_sizes[0] : -1, out_size, ws_size); grid = -1; return; }
        int dev = 0, cus = 0, per_cu = 0;
        if (hipGetDevice(&dev) != hipSuccess || hipDeviceGetAttribute(&cus, hipDeviceAttributeMultiprocessorCount, dev) != hipSuccess) { grid = -1; return; }
        if (hipFuncSetAttribute((const void*)fwd_kernel, hipFuncAttributeMaxDynamicSharedMemorySize, LDS_BYTES) != hipSuccess) { fprintf(stderr, "kernel_launch: hipFuncSetAttribute failed\n"); grid = -1; return; }
        if (hipOccupancyMaxActiveBlocksPerMultiprocessor(&per_cu, (const void*)fwd_kernel, 512, LDS_BYTES) != hipSuccess || per_cu < 1) fprintf(stderr, "kernel_launch: occupancy query reports %d\n", per_cu);
        (void)hipGetLastError();
        grid = cus;
    }
    if (grid < 0) return;
    if (hipMemsetAsync((char*)d_ws + WS_CTL, 0, CTL_ZERO_BYTES, stream) != hipSuccess) return;
    Args a{};
    for (int i = 0; i < 23; ++i) a.in[i] = (const float*)d_in[i];
    a.out = (float*)d_out; a.ws = (unsigned char*)d_ws;
#if MK_MULTI_LAUNCH
    for (int p = 0; p < N_PHASES; ++p) { a.ph_lo = p; a.ph_hi = p + 1; hipLaunchKernelGGL(fwd_kernel, dim3(grid), dim3(512), LDS_BYTES, stream, a); }
#else
    a.ph_lo = 0; a.ph_hi = N_PHASES;
    hipLaunchKernelGGL(fwd_kernel, dim3(grid), dim3(512), LDS_BYTES, stream, a);
#endif
    const hipError_t le = hipPeekAtLastError();
    if (le != hipSuccess) fprintf(stderr, "kernel_launch: launch failed: %s\n", hipGetErrorName(le));
}
```

```cpp
#include <hip/hip_runtime.h>
#include <cstdio>
#include <cstdint>

#define LAS __attribute__((address_space(3)))
#define GAS __attribute__((address_space(1)))
typedef unsigned short bf16;
typedef short bf16x8 __attribute__((ext_vector_type(8)));
typedef short s16x4 __attribute__((ext_vector_type(4)));
typedef float f32x2 __attribute__((ext_vector_type(2)));
typedef float f32x4 __attribute__((ext_vector_type(4)));
typedef float f32x16 __attribute__((ext_vector_type(16)));
typedef unsigned u32x2 __attribute__((ext_vector_type(2)));
typedef unsigned u32x4 __attribute__((ext_vector_type(4)));

constexpr int BATCH = 16, SEQ = 2048, DM = 1024, NTOK = BATCH * SEQ;
constexpr int NPA = 2560;
constexpr int NGT = 3072;
constexpr int NIN = NPA + NGT;
constexpr int INW = 5400;
constexpr int DFF = 2816, NGU = 2 * DFF;
constexpr int MEML = 256, NMEM = BATCH * MEML;
constexpr int PA_QN = 0, PA_KC = 512, PA_VC = 640, PA_KS = 768, PA_VS = 896, PA_KW = 1024, PA_VW = 1152;
constexpr int PA_QM = 1280, PA_KM = 1536, PA_VM = 1792, PA_QX = 2048, PA_GN = 2304;
constexpr float RMS_EPS = 1e-6f;
constexpr float LOG2E = 1.4426950408889634f;
constexpr float C2 = 0.125f * LOG2E;
constexpr float NEGB = -1e30f;

constexpr size_t MiB = 1u << 20;
constexpr size_t WS_CTL = 0, CTL_ZERO_BYTES = 1 * MiB;
constexpr size_t WS_W = 1 * MiB;
constexpr size_t WL_STRIDE = 35 * MiB;
constexpr size_t WL_IN = 0, WL_GU = 11 * MiB, WL_DN = 22 * MiB, WL_BR = 28 * MiB, WL_MIX = 30 * MiB, WL_MKV = 32 * MiB, WL_W1K = 33 * MiB, WL_W1V = 33 * MiB + 512 * 1024;
constexpr size_t WL_SM = 34 * MiB;
constexpr size_t WL_W2K = WL_SM, WL_W2V = WL_SM + 16384, WL_POSK = WL_SM + 32768, WL_POSV = WL_SM + 32768 + 512;
constexpr size_t WS_MEMKV = 71 * MiB;
constexpr size_t WS_KC = 79 * MiB, WS_VC = 79 * MiB + 512 * 1024;
constexpr size_t WS_KMEAN = 80 * MiB;
constexpr size_t WS_H = 81 * MiB;
constexpr size_t WS_PA = 145 * MiB;
constexpr size_t WS_GT = 305 * MiB;
constexpr size_t WS_END = 497 * MiB;
static_assert(WL_DN + (size_t)DM * DFF * 2 <= WL_BR && WS_W + 2 * WL_STRIDE <= WS_MEMKV && WS_H + (size_t)NTOK * DM * 2 <= WS_PA && WS_PA + (size_t)NTOK * NPA * 2 <= WS_GT && WS_GT + (size_t)NTOK * NGT * 2 <= WS_END, "ws map");
constexpr int CW_TMO = 0, CW_BAR = 4096;

constexpr int RING_BYTES = 131072;
constexpr int MISC_OFF = 156672;
constexpr int LDS_BYTES = 157696;
constexpr int A_KV = 0, A_CMP = 49152, A_TAB = 81920, A_CTAB = 117760, A_IMP = 121984, A_SC = A_CMP, A_SEL = A_CMP + 16384, A_KMEAN = A_IMP, A_MG = A_IMP + 2048;
constexpr int TABN = 448, CTABN = 132;
static_assert(A_IMP + 4 * 64 * 33 * 4 <= MISC_OFF && A_TAB + 20 * TABN * 4 <= A_CTAB && A_CTAB + 8 * CTABN * 4 <= A_IMP, "lds map");

__device__ __forceinline__ unsigned f2bf(float f) { unsigned u = __builtin_bit_cast(unsigned, f); return (u + 0x7fffu + ((u >> 16) & 1u)) >> 16; }
__device__ __forceinline__ unsigned pk2(float lo, float hi) { return f2bf(lo) | (f2bf(hi) << 16); }
__device__ __forceinline__ float bflo(unsigned w) { return __builtin_bit_cast(float, w << 16); }
__device__ __forceinline__ float bfhi(unsigned w) { return __builtin_bit_cast(float, w & 0xffff0000u); }
__device__ __forceinline__ float fast_sigmoid(float v) { return __builtin_amdgcn_rcpf(1.0f + __builtin_amdgcn_exp2f(-LOG2E * v)); }

namespace pg8 {
#define PG8_LAS __attribute__((address_space(3)))
typedef unsigned short bf16_t;
constexpr int BM = 256, BK = 64, HALF = 128, HTB = HALF * BK * 2  , STAGE_BYTES = 8 * HTB, NXCD = 8, WGM = 8;

__host__ __device__ __forceinline__ int lds_byte(int r, int c) { const int st = (r >> 4) * 2 + (c >> 5), rr = r & 15, cc = c & 31, ob = rr * 64 + cc * 2; return st * 1024 + (ob ^ (((ob >> 9) & 1) << 5)); }
__host__ __device__ __forceinline__ void stage_rc(int b, int& R, int& C) { const int st = b / 1024, sb = b % 1024, swz = sb ^ (((sb >> 9) & 1) << 5); R = (st >> 1) * 16 + swz / 64; C = (st & 1) * 32 + (swz % 64) / 2; }
__host__ __device__ __forceinline__ int perm32(int rho) { const int n = rho >> 4, i = rho & 15; return 8 * (i >> 2) + 4 * n + (i & 3); }

struct Unit { int pm, pn; };
struct Gemm { const bf16_t* A; const bf16_t* Bt; int M, N, K, lda, ldb; };

struct StaticOrder {
    int nM, nN, nwg, G, c;
    __host__ __device__ void init(int M, int N, int G_, int c_) { nM = M / BM; nN = N / BM; nwg = nM * nN; G = G_; c = c_; }
    __host__ __device__ bool next(int i, Unit& u) const {
        const long L = (long)i * G + c; if (L >= nwg) return false;
        int wgid = (int)L; { const int q = nwg / NXCD, r = nwg % NXCD, xcd = wgid % NXCD, off = wgid / NXCD; wgid = (xcd < r ? xcd * (q + 1) : r * (q + 1) + (xcd - r) * q) + off; }
        const int nig = WGM * nN, gid = wgid / nig, fm = gid * WGM, gsz = (nM - fm) < WGM ? (nM - fm) : WGM;
        u.pm = fm + ((wgid % nig) % gsz); u.pn = (wgid % nig) / gsz; return true;
    }
    __device__ __forceinline__ void a_ready(const Unit&) const {}
    __device__ __forceinline__ void done(const Unit&) const {}
};

__device__ __forceinline__ unsigned cvt_pk_bf16(float lo, float hi) { unsigned r; asm volatile("v_cvt_pk_bf16_f32 %0, %1, %2" : "=v"(r) : "v"(lo), "v"(hi)); return r; }
__device__ __forceinline__ u32x4 pack8(const f32x4& v0, const f32x4& v1) { u32x4 w; w.x = cvt_pk_bf16(v0[0], v0[1]); w.y = cvt_pk_bf16(v0[2], v0[3]); w.z = cvt_pk_bf16(v1[0], v1[1]); w.w = cvt_pk_bf16(v1[2], v1[3]); return w; }
__device__ __forceinline__ void unpack8(const u32x4& w, f32x4& v0, f32x4& v1) { v0 = (f32x4){bflo(w.x), bfhi(w.x), bflo(w.y), bfhi(w.y)}; v1 = (f32x4){bflo(w.z), bfhi(w.z), bflo(w.w), bfhi(w.w)}; }

struct EpiPlain {
    static constexpr bool PERM = true, AFTER_DRAIN = false, SEG = false;
    bf16_t* O; int ldc;
    __device__ __forceinline__ void operator()(const f32x4 (&acc)[2][2][4][2], const Unit& u, int wr, int wc, int fr, int fq) const {
        const int row0 = u.pm * BM + wr * 64 + fr, col0 = u.pn * BM + wc * 32 + 8 * fq;
#pragma unroll
        for (int ai = 0; ai < 2; ++ai)
#pragma unroll
            for (int m = 0; m < 4; ++m) { bf16_t* rowp = O + (size_t)(row0 + ai * HALF + m * 16) * ldc + col0;
#pragma unroll
                for (int bj = 0; bj < 2; ++bj) *(u32x4*)(rowp + bj * HALF) = pack8(acc[ai][bj][m][0], acc[ai][bj][m][1]); }
    }
};
struct EpiProj {
    static constexpr bool PERM = true, AFTER_DRAIN = false, SEG = false;
    bf16_t* PA; bf16_t* GT;
    __device__ __forceinline__ void operator()(const f32x4 (&acc)[2][2][4][2], const Unit& u, int wr, int wc, int fr, int fq) const {
        const int pn = u.pn; bf16_t* base; int ldc, colt; float sc = 1.f; bool sig = false;
        if (pn < 10) { base = PA; ldc = NPA; colt = pn * BM; if (pn < 2 || pn == 5 || pn == 8) sc = C2; if (pn == 9) sig = true; }
        else { base = GT; ldc = NGT; colt = (pn - 10) * BM; sig = true; }
        const int row0 = u.pm * BM + wr * 64 + fr, col0 = colt + wc * 32 + 8 * fq;
#pragma unroll
        for (int ai = 0; ai < 2; ++ai)
#pragma unroll
            for (int m = 0; m < 4; ++m) { bf16_t* rowp = base + (size_t)(row0 + ai * HALF + m * 16) * ldc + col0;
#pragma unroll
                for (int bj = 0; bj < 2; ++bj) { f32x4 v0 = acc[ai][bj][m][0] * sc, v1 = acc[ai][bj][m][1] * sc;
                    if (sig) {
#pragma unroll
                        for (int e = 0; e < 4; ++e) { v0[e] = fast_sigmoid(v0[e]); v1[e] = fast_sigmoid(v1[e]); } }
                    *(u32x4*)(rowp + bj * HALF) = pack8(v0, v1); } }
    }
};
struct EpiMerge {
    static constexpr bool PERM = true, AFTER_DRAIN = false, SEG = false;
    bf16_t* O; int ldc; const bf16_t* G; int ldg; int first;
    __device__ __forceinline__ void operator()(const f32x4 (&acc)[2][2][4][2], const Unit& u, int wr, int wc, int fr, int fq) const {
        const int row0 = u.pm * BM + wr * 64 + fr, col0 = u.pn * BM + wc * 32 + 8 * fq;
#pragma unroll
        for (int ai = 0; ai < 2; ++ai)
#pragma unroll
            for (int mp = 0; mp < 2; ++mp) {
                u32x4 gw[2][2], ow[2][2];
#pragma unroll
                for (int mi = 0; mi < 2; ++mi) { const size_t r = (size_t)(row0 + ai * HALF + (2 * mp + mi) * 16);
#pragma unroll
                    for (int bj = 0; bj < 2; ++bj) { gw[mi][bj] = *(const u32x4*)(G + r * ldg + col0 + bj * HALF); ow[mi][bj] = first ? (u32x4){0u, 0u, 0u, 0u} : *(const u32x4*)(O + r * ldc + col0 + bj * HALF); } }
                asm volatile("" ::: "memory");
#pragma unroll
                for (int mi = 0; mi < 2; ++mi) { const int m = 2 * mp + mi; const size_t r = (size_t)(row0 + ai * HALF + m * 16);
#pragma unroll
                    for (int bj = 0; bj < 2; ++bj) { f32x4 g0, g1, o0, o1; unpack8(gw[mi][bj], g0, g1); unpack8(ow[mi][bj], o0, o1);
                        *(u32x4*)(O + r * ldc + col0 + bj * HALF) = pack8(acc[ai][bj][m][0] * g0 + o0, acc[ai][bj][m][1] * g1 + o1); } }
                asm volatile("" ::: "memory");
            }
    }
};
struct EpiSwiGLU {
    static constexpr bool PERM = true, AFTER_DRAIN = false, SEG = false;
    bf16_t* U; int ldc;
    __device__ __forceinline__ void operator()(const f32x4 (&acc)[2][2][4][2], const Unit& u, int wr, int wc, int fr, int fq) const {
        const int row0 = u.pm * BM + wr * 64 + fr, col0 = u.pn * HALF + wc * 32 + 8 * fq;
#pragma unroll
        for (int ai = 0; ai < 2; ++ai)
#pragma unroll
            for (int m = 0; m < 4; ++m) { bf16_t* rowp = U + (size_t)(row0 + ai * HALF + m * 16) * ldc + col0;
                f32x4 v0, v1;
#pragma unroll
                for (int e = 0; e < 4; ++e) { const float g0 = acc[ai][0][m][0][e], g1 = acc[ai][0][m][1][e];
                    v0[e] = g0 * fast_sigmoid(g0) * acc[ai][1][m][0][e]; v1[e] = g1 * fast_sigmoid(g1) * acc[ai][1][m][1][e]; }
                *(u32x4*)rowp = pack8(v0, v1); }
    }
};

template <class Epi, class Sched, bool ALIGN_EPI = false, bool SP2 = false>
__device__ __forceinline__ void gemm_phase(PG8_LAS unsigned char* lds, const Gemm g, const Sched& S, const Epi& E, int wave_in) {
    unsigned z_ = 0u; asm volatile("" : "+s"(z_));
    int tid_ = wave_in * 64 + (int)__builtin_amdgcn_mbcnt_hi(~0u, __builtin_amdgcn_mbcnt_lo(~0u, z_)); asm volatile("" : "+v"(tid_));
    const int tid = tid_, wid = __builtin_amdgcn_readfirstlane(tid >> 6), lane = tid & 63, wr = wid >> 2, wc = wid & 3, fr = lane & 15, fq = lane >> 4;
    const int K = g.K, nt = K / BK;
    unsigned voffA[2], voffB[2];
#pragma unroll
    for (int i = 0; i < 2; ++i) { int R, C; stage_rc(tid * 16 + i * 8192, R, C); const int Rb = Epi::PERM ? ((R & ~31) + perm32(R & 31)) : R;
        voffA[i] = (unsigned)(R * g.lda + C) * 2u; voffB[i] = (unsigned)(Rb * g.ldb + C) * 2u; }
    const size_t kstep = (size_t)(BK * 2);
    const size_t hstepA = (size_t)HALF * g.lda * 2, hstepB = (size_t)HALF * g.ldb * 2;
    const size_t tstepA = 2 * hstepA, tstepB = 2 * hstepB;
    const unsigned ldsw = (unsigned)wid * 1024u;
    const int aoff = lds_byte(wr * 64 + fr, fq * 8), boff = lds_byte(wc * 32 + fr, fq * 8);
#define PG8_SA(b, h) (((b) * 2 + (h)) * HTB)
#define PG8_SB(b, h) ((4 + (b) * 2 + (h)) * HTB)
#define PG8_STAGE(bufoff, gbase, voff) do { _Pragma("unroll") for (int _i = 0; _i < 2; ++_i) \
        __builtin_amdgcn_global_load_lds((const unsigned*)((const char*)(gbase) + (voff)[_i]), (PG8_LAS unsigned*)(lds + (bufoff) + ldsw + _i * 8192), 16, 0, 0); } while (0)
#define PG8_LDA(dst, b, h) do { _Pragma("unroll") for (int m = 0; m < 4; ++m) _Pragma("unroll") for (int k = 0; k < 2; ++k) dst[m][k] = *(const PG8_LAS bf16x8*)(lds + PG8_SA(b, h) + aoff + m * 2048 + k * 1024); } while (0)
#define PG8_LDB(dst, b, h) do { _Pragma("unroll") for (int n = 0; n < 2; ++n) _Pragma("unroll") for (int k = 0; k < 2; ++k) dst[n][k] = *(const PG8_LAS bf16x8*)(lds + PG8_SB(b, h) + boff + n * 2048 + k * 1024); } while (0)
#define PG8_MMA(ai, bj, At, Bt) do { __builtin_amdgcn_s_setprio(1); _Pragma("unroll") for (int m = 0; m < 4; ++m) _Pragma("unroll") for (int n = 0; n < 2; ++n) _Pragma("unroll") for (int k = 0; k < 2; ++k) \
        acc[ai][bj][m][n] = __builtin_amdgcn_mfma_f32_16x16x32_bf16(Bt[n][k], At[m][k], acc[ai][bj][m][n], 0, 0, 0); __builtin_amdgcn_s_setprio(0); } while (0)
#define PG8_WAIT_V(n) asm volatile("s_waitcnt vmcnt(" #n ")" ::: "memory")
#define PG8_WAIT_L(n) asm volatile("s_waitcnt lgkmcnt(" #n ")" ::: "memory")
#define PG8_BAR __builtin_amdgcn_s_barrier()
#define PG8_SCHED __builtin_amdgcn_sched_barrier(0)
    Unit cur, nxt; int ui = 0;
    if (!S.next(0, cur)) return;
    f32x4 acc[2][2][4][2];
#pragma unroll
    for (int a = 0; a < 2; ++a)
#pragma unroll
        for (int b = 0; b < 2; ++b)
#pragma unroll
            for (int m = 0; m < 4; ++m)
#pragma unroll
                for (int n = 0; n < 2; ++n) acc[a][b][m][n] = (f32x4){0.f, 0.f, 0.f, 0.f};
    bf16x8 At[4][2], B0[2][2], B1[2][2];
    const char* cA = (const char*)g.A + (size_t)cur.pm * tstepA; const char* cB = (const char*)g.Bt + (size_t)cur.pn * tstepB;
    S.a_ready(cur);
    if constexpr (SP2) {
        PG8_STAGE(PG8_SB(0, 0), cB, voffB); PG8_STAGE(PG8_SB(0, 1), cB + hstepB, voffB); PG8_STAGE(PG8_SA(0, 0), cA, voffA); PG8_STAGE(PG8_SA(0, 1), cA + hstepA, voffA);
        if (wr == 1) PG8_BAR;
        PG8_WAIT_V(2); PG8_BAR;
        PG8_STAGE(PG8_SB(1, 0), cB + kstep, voffB); PG8_STAGE(PG8_SA(1, 0), cA + kstep, voffA); PG8_STAGE(PG8_SB(1, 1), cB + hstepB + kstep, voffB);
        PG8_WAIT_V(6); PG8_BAR;
    } else {
        PG8_STAGE(PG8_SB(0, 0), cB, voffB); PG8_STAGE(PG8_SA(0, 0), cA, voffA); PG8_STAGE(PG8_SB(0, 1), cB + hstepB, voffB); PG8_STAGE(PG8_SA(0, 1), cA + hstepA, voffA);
        if (wr == 1) PG8_BAR;
        PG8_WAIT_V(4); PG8_BAR;
        PG8_STAGE(PG8_SB(1, 0), cB + kstep, voffB); PG8_STAGE(PG8_SA(1, 0), cA + kstep, voffA); PG8_STAGE(PG8_SB(1, 1), cB + hstepB + kstep, voffB);
        PG8_WAIT_V(6); PG8_BAR;
    }
    for (;;) {
        const bool has_next = S.next(ui + 1, nxt);
        const char* nA = has_next ? (const char*)g.A + (size_t)nxt.pm * tstepA : cA; const char* nB = has_next ? (const char*)g.Bt + (size_t)nxt.pn * tstepB : cB;
        for (int t = 0; t < nt; t += 2) {
            const bool last = (t == nt - 2);
            const char* a1 = cA + (size_t)(t + 1) * kstep;
            const char* a2 = last ? nA : cA + (size_t)(t + 2) * kstep; const char* b2 = last ? nB : cB + (size_t)(t + 2) * kstep;
            const char* a3 = a2 + kstep; const char* b3 = b2 + kstep;
            if (last && has_next) S.a_ready(nxt);
            if constexpr (Epi::SEG) { if (t == E.seg1) E.rescale(acc, cur, wr, wc, fr, fq, 0); else if (t == E.seg2) E.rescale(acc, cur, wr, wc, fr, fq, 1); }
            if constexpr (SP2) {
            PG8_LDB(B0, 0, 0); PG8_LDB(B1, 0, 1); PG8_SCHED; PG8_LDA(At, 0, 0); PG8_STAGE(PG8_SA(1, 1), a1 + hstepA, voffA);
            PG8_WAIT_V(8); PG8_WAIT_L(0); PG8_BAR; PG8_MMA(0, 0, At, B0); PG8_MMA(0, 1, At, B1); PG8_BAR; PG8_SCHED;
            PG8_LDA(At, 0, 1); PG8_STAGE(PG8_SB(0, 0), b2, voffB); PG8_STAGE(PG8_SB(0, 1), b2 + hstepB, voffB); PG8_STAGE(PG8_SA(0, 0), a2, voffA);
            PG8_WAIT_V(8); PG8_WAIT_L(0); PG8_BAR; PG8_MMA(1, 0, At, B0); PG8_MMA(1, 1, At, B1); PG8_BAR; PG8_SCHED;
            PG8_LDB(B0, 1, 0); PG8_LDB(B1, 1, 1); PG8_SCHED; PG8_LDA(At, 1, 0); PG8_STAGE(PG8_SA(0, 1), a2 + hstepA, voffA);
            PG8_WAIT_V(8); PG8_WAIT_L(0); PG8_BAR; PG8_MMA(0, 0, At, B0); PG8_MMA(0, 1, At, B1); PG8_BAR; PG8_SCHED;
            PG8_LDA(At, 1, 1); PG8_STAGE(PG8_SB(1, 0), b3, voffB); PG8_STAGE(PG8_SB(1, 1), b3 + hstepB, voffB); PG8_STAGE(PG8_SA(1, 0), a3, voffA);
            PG8_WAIT_V(8); PG8_WAIT_L(0); PG8_BAR; PG8_MMA(1, 0, At, B0); PG8_MMA(1, 1, At, B1); PG8_BAR; PG8_SCHED;
            } else {
            PG8_LDB(B0, 0, 0); PG8_SCHED; PG8_LDA(At, 0, 0); PG8_STAGE(PG8_SA(1, 1), a1 + hstepA, voffA);
            PG8_WAIT_L(8); PG8_BAR; PG8_WAIT_L(0); PG8_MMA(0, 0, At, B0); PG8_BAR; PG8_SCHED;
            PG8_LDB(B1, 0, 1); PG8_STAGE(PG8_SB(0, 0), b2, voffB);
            PG8_BAR; PG8_WAIT_L(0); PG8_MMA(0, 1, At, B1); PG8_BAR;
            PG8_LDA(At, 0, 1); PG8_STAGE(PG8_SA(0, 0), a2, voffA);
            PG8_BAR; PG8_WAIT_L(0); PG8_MMA(1, 0, At, B0); PG8_BAR; PG8_SCHED;
            PG8_STAGE(PG8_SB(0, 1), b2 + hstepB, voffB);
            PG8_WAIT_V(6); PG8_BAR; PG8_MMA(1, 1, At, B1); PG8_BAR;
            PG8_LDB(B0, 1, 0); PG8_SCHED; PG8_LDA(At, 1, 0); PG8_STAGE(PG8_SA(0, 1), a2 + hstepA, voffA);
            PG8_WAIT_L(8); PG8_BAR; PG8_WAIT_L(0); PG8_MMA(0, 0, At, B0); PG8_BAR; PG8_SCHED;
            PG8_LDB(B1, 1, 1); PG8_STAGE(PG8_SB(1, 0), b3, voffB);
            PG8_BAR; PG8_WAIT_L(0); PG8_MMA(0, 1, At, B1); PG8_BAR;
            PG8_LDA(At, 1, 1); PG8_STAGE(PG8_SA(1, 0), a3, voffA);
            PG8_BAR; PG8_WAIT_L(0); PG8_MMA(1, 0, At, B0); PG8_BAR; PG8_SCHED;
            PG8_STAGE(PG8_SB(1, 1), b3 + hstepB, voffB);
            PG8_WAIT_V(6); PG8_BAR; PG8_MMA(1, 1, At, B1); PG8_BAR;
            }
        }
        if constexpr (ALIGN_EPI) { if (wr == 0) PG8_BAR; }
        if constexpr (!Epi::AFTER_DRAIN) { E(acc, cur, wr, wc, fr, fq); S.done(cur); }
        if (!has_next) break;
#pragma unroll
        for (int a = 0; a < 2; ++a)
#pragma unroll
            for (int b = 0; b < 2; ++b)
#pragma unroll
                for (int m = 0; m < 4; ++m)
#pragma unroll
                    for (int n = 0; n < 2; ++n) acc[a][b][m][n] = (f32x4){0.f, 0.f, 0.f, 0.f};
        cur = nxt; cA = nA; cB = nB; ++ui;
        if constexpr (ALIGN_EPI) { if (wr == 1) PG8_BAR; }
    }
    PG8_WAIT_V(0);
    if constexpr (!ALIGN_EPI) { if (wr == 0) PG8_BAR; }
    PG8_BAR;
    if constexpr (Epi::AFTER_DRAIN) { E.fused(acc, cur, wr, wc, fr, fq, lds, wid, lane); S.done(cur); }
#undef PG8_SA
#undef PG8_SB
#undef PG8_STAGE
#undef PG8_LDA
#undef PG8_LDB
#undef PG8_MMA
#undef PG8_WAIT_V
#undef PG8_WAIT_L
#undef PG8_BAR
#undef PG8_SCHED
}

}

typedef GAS unsigned gu32;
#define RLX_AGENT __ATOMIC_RELAXED, __HIP_MEMORY_SCOPE_AGENT
#define XB_TMO      128
#define XB_XCNT(j)  (256  + 64 * (j))
#define XB_XSUB(j)  (1280 + 64 * (j))
#define XB_XGEN(j)  (2304 + 64 * (j))
#define XB_TOP      3328
#define XB_TOPGEN   3392
#define XCD_BAR_WORDS 3456
#define XB_SPIN_CAP (1u << 18)

__device__ __forceinline__ unsigned xb_ld(unsigned* p)              { return __hip_atomic_load(p, __ATOMIC_RELAXED, __HIP_MEMORY_SCOPE_AGENT); }
__device__ __forceinline__ unsigned xb_add(unsigned* p, unsigned v) { return __hip_atomic_fetch_add(p, v, __ATOMIC_RELAXED, __HIP_MEMORY_SCOPE_AGENT); }
__device__ __forceinline__ unsigned xb_xcc_id() { return (unsigned)__builtin_amdgcn_s_getreg((3 << 11) | 20) & 0xFu; }
#define XB_SPIN(cond, bar) do { unsigned _sp = 0; while (cond) { __builtin_amdgcn_s_sleep(1); \
    if ((++_sp & 255u) == 0u) { if (xb_ld(&(bar)[XB_TMO])) break; if (_sp > XB_SPIN_CAP) { atomicAdd(&(bar)[XB_TMO], 1u); break; } } } } while (0)

struct XcdBarrier {
    unsigned* bar; unsigned x;
    volatile LAS unsigned* st;
};

__device__ __forceinline__ XcdBarrier xcd_barrier_post(unsigned* bar, volatile LAS unsigned* st) {
    XcdBarrier b; b.bar = bar; b.x = xb_xcc_id(); b.st = st;
    if (threadIdx.x == 0) (void)xb_add(&bar[XB_XCNT(b.x)], 1u);
    return b;
}
__device__ __forceinline__ void xcd_barrier_complete(unsigned* bar, unsigned x, unsigned& nloc, unsigned& nx) {
    const unsigned G = gridDim.x * gridDim.y * gridDim.z;
    unsigned sum, cnt, mine, sp = 0u;
    for (;;) {
        sum = 0u; cnt = 0u; mine = 0u;
#pragma unroll
        for (unsigned j = 0; j < 16; ++j) { const unsigned c = xb_ld(&bar[XB_XCNT(j)]); sum += c; cnt += (c > 0u) ? 1u : 0u; mine = (j == x) ? c : mine; }
        if (sum == G) break;
        __builtin_amdgcn_s_sleep(1);
        if ((++sp & 255u) == 0u) { if (xb_ld(&bar[XB_TMO])) break; if (sp > XB_SPIN_CAP) { atomicAdd(&bar[XB_TMO], 1u); break; } }
    }
    nloc = mine > 0u ? mine : 1u; nx = cnt > 0u ? cnt : 1u;
}

__device__ __forceinline__ void xcd_barrier(const XcdBarrier& b) {
    asm volatile("s_waitcnt vmcnt(0)" ::: "memory");
    __syncthreads();
    if (threadIdx.x == 0) {
        unsigned* bar = b.bar;
        __builtin_amdgcn_s_waitcnt(0);
        unsigned nloc = b.st[0], nx = b.st[1];
        if (nloc == 0u) { xcd_barrier_complete(bar, b.x, nloc, nx); b.st[0] = nloc; b.st[1] = nx; }
        const unsigned old = xb_add(&bar[XB_XSUB(b.x)], 1u);
        const unsigned gen = old / nloc;
        if (old + 1u == (gen + 1u) * nloc) {
            __builtin_amdgcn_fence(__ATOMIC_RELEASE, "agent");
            asm volatile("s_waitcnt vmcnt(0)" ::: "memory");
            const unsigned og = xb_add(&bar[XB_TOP], 1u);
            const unsigned tg = og / nx;
            if (og + 1u == (tg + 1u) * nx) xb_add(&bar[XB_TOPGEN], 1u);
            else XB_SPIN(xb_ld(&bar[XB_TOPGEN]) == tg, bar);
            __builtin_amdgcn_fence(__ATOMIC_ACQUIRE, "agent");
            xb_add(&bar[XB_XGEN(b.x)], 1u);
            asm volatile("s_waitcnt vmcnt(0)" ::: "memory");
        } else {
            XB_SPIN(xb_ld(&bar[XB_XGEN(b.x)]) == gen, bar);
            __builtin_amdgcn_fence(__ATOMIC_ACQUIRE, "agent");
            asm volatile("s_waitcnt vmcnt(0)" ::: "memory");
        }
    }
    __syncthreads();
}

#define LDS_WAIT() asm volatile("s_waitcnt lgkmcnt(0)" ::: "memory")
#define VM_WAIT() asm volatile("s_waitcnt vmcnt(0)" ::: "memory")
#define MFMA32 __builtin_amdgcn_mfma_f32_32x32x16_bf16
__device__ __forceinline__ float wave_sum(float v) {
#pragma unroll
    for (int o = 1; o < 64; o <<= 1) v += __shfl_xor(v, o);
    return v;
}
__device__ __forceinline__ float swap_max(float m) { auto rr = __builtin_amdgcn_permlane32_swap(__float_as_uint(m), __float_as_uint(m), false, false); return fmaxf(__uint_as_float(rr[0]), __uint_as_float(rr[1])); }
__device__ __forceinline__ float swap_sum(float m) { auto rr = __builtin_amdgcn_permlane32_swap(__float_as_uint(m), __float_as_uint(m), false, false); return __uint_as_float(rr[0]) + __uint_as_float(rr[1]); }
__device__ __forceinline__ int crow(int r, int hi) { return (r & 3) + 8 * (r >> 2) + 4 * hi; }
__device__ __forceinline__ int t5_bucket(int dist) {
    if (dist < 16) return dist;
    int b = 16;
    b += (dist >= 19); b += (dist >= 21); b += (dist >= 24); b += (dist >= 27); b += (dist >= 31); b += (dist >= 35); b += (dist >= 40); b += (dist >= 46);
    b += (dist >= 52); b += (dist >= 59); b += (dist >= 67); b += (dist >= 77); b += (dist >= 87); b += (dist >= 99); b += (dist >= 113);
    return b;
}
__device__ __forceinline__ float gelu_tanh(float x) { const float u = 0.7978845608028654f * (x + 0.044715f * x * x * x); return x * __builtin_amdgcn_rcpf(1.0f + __builtin_amdgcn_exp2f(-2.0f * LOG2E * u)); }

__device__ __forceinline__ void tr_item(const float* W, int ldw, bf16* WT, int ldt, int kdst, LAS float* scr, int k0, int n0, int sc, int lane) {
    float tv[32];
    const float* wp = W + (size_t)(k0 + (lane >> 5)) * ldw + (sc >= 0 ? sc : 0);
#pragma unroll
    for (int i = 0; i < 32; ++i) tv[i] = wp[(size_t)(2 * i) * ldw];
#pragma unroll
    for (int i = 0; i < 32; ++i) { const int kk = 2 * i + (lane >> 5); scr[kk * 33 + (lane & 31)] = sc >= 0 ? tv[i] : 0.f; }
    LDS_WAIT(); asm volatile("" ::: "memory");
    const int c = lane & 7;
#pragma unroll
    for (int j = 0; j < 4; ++j) { const int n = (lane >> 3) + 8 * j; const LAS float* s = scr + (8 * c) * 33 + n;
        u32x4 o; o.x = pk2(s[0 * 33], s[1 * 33]); o.y = pk2(s[2 * 33], s[3 * 33]); o.z = pk2(s[4 * 33], s[5 * 33]); o.w = pk2(s[6 * 33], s[7 * 33]);
        *(u32x4*)(WT + (size_t)(n0 + n) * ldt + kdst + k0 + 8 * c) = o; }
    LDS_WAIT(); asm volatile("" ::: "memory");
}
__device__ __forceinline__ void tr_matrix(int kind, const float* W, const float* W2, int Ksrc, int ldw, int Ndst, bf16* WT, int ldt, int kdst, LAS float* scr, int gw, int NGW, int lane) {
    const int nblk = Ndst / 32, nitems = (Ksrc / 64) * nblk;
    for (int it = gw; it < nitems; it += NGW) {
        const int kb = it / nblk, nb = it % nblk, n0 = 32 * nb, n = n0 + (lane & 31);
        const float* src = W; int sc = n;
        if (kind == 1) { sc = n < 1280 ? n : (n < 2304 ? n + 24 : (n < 2328 ? n - 1024 : (n < 2560 ? -1 : n - 232))); }
        else if (kind == 2) { const int pn = n >> 8, w = n & 255; if (w < 128) sc = 128 * pn + w; else { sc = 128 * pn + w - 128; src = W2; } }
        tr_item(src, ldw, WT, ldt, kdst, scr, 64 * kb, n0, sc, lane);
    }
}

template <int NR>
__device__ __forceinline__ void rms_rows_bf16(const float* const (&xrow)[NR], const float* g, bf16* const (&orow)[NR], int lane) {
    f32x4 v[NR][4];
#pragma unroll
    for (int r = 0; r < NR; ++r) { const f32x4* xr = (const f32x4*)xrow[r] + lane;
#pragma unroll
        for (int j = 0; j < 4; ++j) v[r][j] = xr[64 * j]; }
    const f32x4* gr = (const f32x4*)g + lane; f32x4 gv[4];
#pragma unroll
    for (int j = 0; j < 4; ++j) gv[j] = gr[64 * j];
#pragma unroll
    for (int r = 0; r < NR; ++r) { float s = 0.f;
#pragma unroll
        for (int j = 0; j < 4; ++j) s += (v[r][j].x * v[r][j].x + v[r][j].y * v[r][j].y) + (v[r][j].z * v[r][j].z + v[r][j].w * v[r][j].w);
        const float rs = rsqrtf(wave_sum(s) * (1.f / DM) + RMS_EPS);
        u32x2* o8 = (u32x2*)orow[r] + lane;
#pragma unroll
        for (int j = 0; j < 4; ++j) { u32x2 w; w.x = pk2(v[r][j].x * rs * gv[j].x, v[r][j].y * rs * gv[j].y); w.y = pk2(v[r][j].z * rs * gv[j].z, v[r][j].w * rs * gv[j].w); o8[64 * j] = w; } }
}
template <int NR>
__device__ __forceinline__ void norm_res_norm(const bf16* const (&srow)[NR], const float* gA, const float* const (&xin)[NR], float* const (&xout)[NR], const float* gB, bf16* const (&hout)[NR], bool has_h, int lane) {
    u32x2 sw[NR][4]; f32x4 xv[NR][4];
#pragma unroll
    for (int r = 0; r < NR; ++r) { const u32x2* sr = (const u32x2*)srow[r] + lane; const f32x4* xi = (const f32x4*)xin[r] + lane;
#pragma unroll
        for (int j = 0; j < 4; ++j) { sw[r][j] = sr[64 * j]; xv[r][j] = xi[64 * j]; } }
    const f32x4* ga = (const f32x4*)gA + lane; f32x4 gav[4];
#pragma unroll
    for (int j = 0; j < 4; ++j) gav[j] = ga[64 * j];
#pragma unroll
    for (int r = 0; r < NR; ++r) { f32x4 v[4]; float s = 0.f;
#pragma unroll
        for (int j = 0; j < 4; ++j) { const u32x2 w = sw[r][j]; v[j] = (f32x4){bflo(w.x), bfhi(w.x), bflo(w.y), bfhi(w.y)}; s += (v[j].x * v[j].x + v[j].y * v[j].y) + (v[j].z * v[j].z + v[j].w * v[j].w); }
        const float rA = rsqrtf(wave_sum(s) * (1.f / DM) + RMS_EPS);
        f32x4* xo = (f32x4*)xout[r] + lane; float s2 = 0.f;
#pragma unroll
        for (int j = 0; j < 4; ++j) { v[j] = xv[r][j] + v[j] * rA * gav[j]; xo[64 * j] = v[j]; s2 += (v[j].x * v[j].x + v[j].y * v[j].y) + (v[j].z * v[j].z + v[j].w * v[j].w); }
        if (has_h) {
            const float rB = rsqrtf(wave_sum(s2) * (1.f / DM) + RMS_EPS);
            const f32x4* gb = (const f32x4*)gB + lane; u32x2* o8 = (u32x2*)hout[r] + lane;
#pragma unroll
            for (int j = 0; j < 4; ++j) { const f32x4 gv = gb[64 * j]; u32x2 w; w.x = pk2(v[j].x * rB * gv.x, v[j].y * rB * gv.y); w.y = pk2(v[j].z * rB * gv.z, v[j].w * rB * gv.w); o8[64 * j] = w; }
        } }
}

__device__ __forceinline__ void compress_unit(int u, LAS unsigned char* lds, const bf16* PA, const unsigned char* wl, bf16* KC, bf16* VC, int tid) {
    const int lane = tid & 63, wid = __builtin_amdgcn_readfirstlane(tid >> 6), r32 = lane & 31, hi = lane >> 5;
    const int half = u & 1, kv = (u >> 1) & 1, g = (u >> 2) & 1, b = u >> 3;
    const bf16* w1t = (const bf16*)(wl + (kv ? WL_W1V : WL_W1K));
    const bf16* w2t = (const bf16*)(wl + (kv ? WL_W2V : WL_W2K));
    const float* posb = (const float*)(wl + (kv ? WL_POSV : WL_POSK));
    const bf16* Asrc = PA + (size_t)b * SEQ * NPA + (kv ? PA_VC : PA_KC) + g * 64;
    bf16* Out = (kv ? VC : KC) + (size_t)((b * 2 + g) * 128) * 64;
    LAS bf16* H1 = (LAS bf16*)lds;
    {
        const int ctile = wid & 1, ntile = wid >> 1;
        const int c = 64 * half + 32 * ctile + r32;
        const bf16* wrow = w1t + (size_t)(32 * ntile + r32) * 2048 + 8 * hi;
        f32x16 acc = {};
        for (int jj = 0; jj < 32; ++jj) {
            int tok = 16 * c + jj; tok = tok > SEQ - 1 ? SEQ - 1 : tok;
            const bf16* arow = Asrc + (size_t)tok * NPA + 8 * hi;
#pragma unroll
            for (int q = 0; q < 4; ++q) {
                const bf16x8 af = *(const bf16x8*)(wrow + jj * 64 + q * 16);
                const bf16x8 bfr = *(const bf16x8*)(arow + q * 16);
                acc = MFMA32(af, bfr, acc, 0, 0, 0);
            }
        }
#pragma unroll
        for (int k4 = 0; k4 < 4; ++k4) { const int n0 = 32 * ntile + 8 * k4 + 4 * hi; const f32x4 pb = *(const f32x4*)(posb + n0);
            u32x2 w; w.x = pk2(gelu_tanh(acc[4 * k4 + 0] + pb.x), gelu_tanh(acc[4 * k4 + 1] + pb.y)); w.y = pk2(gelu_tanh(acc[4 * k4 + 2] + pb.z), gelu_tanh(acc[4 * k4 + 3] + pb.w));
            *(LAS u32x2*)(H1 + (32 * ctile + r32) * 136 + n0) = w; }
    }
    __syncthreads();
    if (wid < 4) {
        const int ct2 = wid & 1, dt = wid >> 1;
        f32x16 a2 = {};
#pragma unroll
        for (int ks = 0; ks < 8; ++ks) {
            const bf16x8 af = *(const bf16x8*)(w2t + (size_t)(32 * dt + r32) * 128 + 16 * ks + 8 * hi);
            const bf16x8 bfr = *(const LAS bf16x8*)(H1 + (32 * ct2 + r32) * 136 + 16 * ks + 8 * hi);
            a2 = MFMA32(af, bfr, a2, 0, 0, 0);
        }
#pragma unroll
        for (int k4 = 0; k4 < 4; ++k4) { u32x2 w; w.x = pk2(a2[4 * k4 + 0], a2[4 * k4 + 1]); w.y = pk2(a2[4 * k4 + 2], a2[4 * k4 + 3]);
            *(u32x2*)(Out + (size_t)(64 * half + 32 * ct2 + r32) * 64 + 32 * dt + 8 * k4 + 4 * hi) = w; }
    }
    __syncthreads();
}
__device__ __forceinline__ void kmean_unit(int b, int n, LAS unsigned char* lds, const bf16* PA, float* KMEAN, int tid) {
    const int chunk = tid & 31, tg = tid >> 5;
    const bf16* src = PA + ((size_t)b * SEQ + 256 * n + 16 * tg) * NPA + PA_KM + 8 * chunk;
    f32x4 s0 = {0.f, 0.f, 0.f, 0.f}, s1 = {0.f, 0.f, 0.f, 0.f};
#pragma unroll 4
    for (int t = 0; t < 16; ++t) { const u32x4 w = *(const u32x4*)(src + (size_t)t * NPA); f32x4 a, c; pg8::unpack8(w, a, c); s0 += a; s1 += c; }
    LAS float* red = (LAS float*)lds;
    *(LAS f32x4*)(red + tg * 256 + 8 * chunk) = s0; *(LAS f32x4*)(red + tg * 256 + 8 * chunk + 4) = s1;
    __syncthreads();
    if (tid < 256) { float s = 0.f;
#pragma unroll
        for (int t = 0; t < 16; ++t) s += red[t * 256 + tid];
        KMEAN[((size_t)(b * 4 + (tid >> 6)) * 8 + n) * 64 + (tid & 63)] = s * (1.f / 256.f); }
    __syncthreads();
}

__device__ __forceinline__ void glds16(const void* gsrc, unsigned lds_dst) { unsigned keep;
    asm volatile("s_mov_b32 %0, m0\n\ts_mov_b32 m0, %2\n\ts_nop 0\n\tglobal_load_lds_dwordx4 %1, off\n\ts_mov_b32 m0, %0" : "=&s"(keep) : "v"(gsrc), "s"(lds_dst) : "memory"); }
__device__ __forceinline__ void stage_kv(LAS unsigned char* buf, const bf16* kptr, const bf16* vptr, int pitch, int wid, int lane) {
    const int kkey = 8 * wid + (lane >> 3);
    const bf16* ks = kptr + (size_t)kkey * pitch + (((lane & 7) ^ ((kkey >> 1) & 7)) * 8);
    const bf16* vs = vptr + (size_t)(16 * (wid & 3) + (lane >> 2)) * pitch + (wid >> 2) * 32 + (lane & 3) * 8;
    const unsigned dst = (unsigned)__builtin_amdgcn_readfirstlane((int)(unsigned)(uintptr_t)buf + wid * 1024);
    glds16(ks, dst); glds16(vs, dst + 8192u);
}
typedef __bf16 bf16x2_t __attribute__((ext_vector_type(2)));
__device__ __forceinline__ unsigned cvtpk_s(float lo, float hi) { f32x2 v = {lo, hi}; bf16x2_t b = __builtin_convertvector(v, bf16x2_t); return __builtin_bit_cast(unsigned, b); }
__device__ __forceinline__ bf16x8 pack_p(const f32x16& p, int s) {
    u32x4 w; w.x = cvtpk_s(p[8 * s + 0], p[8 * s + 1]); w.y = cvtpk_s(p[8 * s + 2], p[8 * s + 3]); w.z = cvtpk_s(p[8 * s + 4], p[8 * s + 5]); w.w = cvtpk_s(p[8 * s + 6], p[8 * s + 7]);
    return __builtin_bit_cast(bf16x8, w);
}
__device__ __forceinline__ bf16x8 vfrag(const LAS unsigned char* p) {
    const s16x4 lo = __builtin_bit_cast(s16x4, __builtin_amdgcn_ds_read_tr16_b64_v4i16((LAS s16x4*)p));
    const s16x4 hi = __builtin_bit_cast(s16x4, __builtin_amdgcn_ds_read_tr16_b64_v4i16((LAS s16x4*)(p + 512)));
    return (bf16x8){lo[0], lo[1], lo[2], lo[3], hi[0], hi[1], hi[2], hi[3]};
}
#define RING_WAIT_BAR(n) do { asm volatile("s_waitcnt vmcnt(" #n ")" ::: "memory"); __builtin_amdgcn_s_barrier(); asm volatile("" ::: "memory"); } while (0)
#define RING_STEP_SYNC(j, ns) do { if ((j) + 1 < (ns)) RING_WAIT_BAR(2); else RING_WAIT_BAR(0); } while (0)
__device__ __forceinline__ float max3f(float a, float b, float c) { float r; asm("v_max3_f32 %0, %1, %2, %3" : "=v"(r) : "v"(a), "v"(b), "v"(c)); return r; }
#define LOADED4(q) asm volatile("" :: "v"((q)[0]), "v"((q)[1]), "v"((q)[2]), "v"((q)[3]))
#define LOADED1(x) asm volatile("" :: "v"(x))
struct WState { f32x16 o0, o1; float m, l; int first; };
typedef unsigned u32x8 __attribute__((ext_vector_type(8)));
struct OtPk { u32x8 a, b; };
__device__ __forceinline__ void ot_set(OtPk& t, const f32x16& o0, const f32x16& o1, float sc) {
#pragma unroll
    for (int i = 0; i < 8; ++i) { t.a[i] = cvtpk_s(o0[2 * i] * sc, o0[2 * i + 1] * sc); t.b[i] = cvtpk_s(o1[2 * i] * sc, o1[2 * i + 1] * sc); }
}
__device__ __forceinline__ void ot_add(OtPk& t, const f32x16& o0, const f32x16& o1, float sc) {
#pragma unroll
    for (int i = 0; i < 8; ++i) { t.a[i] = cvtpk_s(bflo(t.a[i]) + o0[2 * i] * sc, bfhi(t.a[i]) + o0[2 * i + 1] * sc); t.b[i] = cvtpk_s(bflo(t.b[i]) + o1[2 * i] * sc, bfhi(t.b[i]) + o1[2 * i + 1] * sc); }
}
__device__ __forceinline__ void ot_store(bf16* op, const OtPk& t) {
#pragma unroll
    for (int k4 = 0; k4 < 4; ++k4) { u32x2 w0 = {t.a[2 * k4], t.a[2 * k4 + 1]}, w1 = {t.b[2 * k4], t.b[2 * k4 + 1]}; *(u32x2*)(op + 8 * k4) = w0; *(u32x2*)(op + 32 + 8 * k4) = w1; }
}
__device__ __forceinline__ void ws_reset(WState& S) { S.o0 = f32x16{}; S.o1 = f32x16{}; S.m = 0.f; S.l = 0.f; S.first = 1; }
__device__ __forceinline__ void attn_qk(WState& S, const bf16x8 (&q)[4], const LAS unsigned char* buf, float cadd, bool near, const LAS float* nearp, int r32, int hi, bf16x8 (&pa)[4]) {
    const float ci = cadd - S.m;
    f32x16 p0, p1;
#pragma unroll
    for (int r = 0; r < 16; ++r) { p0[r] = ci; p1[r] = ci; }
    const LAS unsigned char* kb = buf + r32 * 128; const int ksw = (r32 >> 1) & 7;
#pragma unroll
    for (int ks = 0; ks < 4; ++ks) {
        const int ko = ((2 * ks + hi) ^ ksw) * 16;
        const bf16x8 k0f = *(const LAS bf16x8*)(kb + ko), k1f = *(const LAS bf16x8*)(kb + ko + 4096);
        p0 = MFMA32(k0f, q[ks], p0, 0, 0, 0); p1 = MFMA32(k1f, q[ks], p1, 0, 0, 0);
    }
    asm volatile("s_nop 15\n\ts_nop 7" : "+v"(p0), "+v"(p1));
    if (near) {
#pragma unroll
        for (int r = 0; r < 16; ++r) { const int c = (r & 3) + 8 * (r >> 2); p0[r] += nearp[63 - c]; }
        __builtin_amdgcn_sched_barrier(0);
#pragma unroll
        for (int r = 0; r < 16; ++r) { const int c = (r & 3) + 8 * (r >> 2); p1[r] += nearp[31 - c]; }
    }
    __builtin_amdgcn_sched_barrier(0);
    float rm = max3f(p0[0], p1[0], p0[1]), rm2 = max3f(p1[1], p0[2], p1[2]);
#pragma unroll
    for (int r = 3; r < 15; r += 2) { rm = max3f(rm, p0[r], p1[r]); rm2 = max3f(rm2, p0[r + 1], p1[r + 1]); }
    rm = max3f(rm, p0[15], p1[15]); rm = max3f(rm, rm2, rm2);
    rm = swap_max(rm);
    if (S.first || __any(rm > 5.0f)) {
        const float d = S.first ? rm : fmaxf(rm, 0.f);
        const float f = S.first ? 1.f : __builtin_amdgcn_exp2f(-d);
        S.m += d; S.first = 0; S.l *= f; S.o0 *= f; S.o1 *= f;
#pragma unroll
        for (int r = 0; r < 16; ++r) { p0[r] -= d; p1[r] -= d; }
    }
    float ls = 0.f;
#pragma unroll
    for (int r = 0; r < 16; ++r) { p0[r] = __builtin_amdgcn_exp2f(p0[r]); p1[r] = __builtin_amdgcn_exp2f(p1[r]); ls += p0[r] + p1[r]; }
    S.l += ls;
    pa[0] = pack_p(p0, 0); pa[1] = pack_p(p0, 1); pa[2] = pack_p(p1, 0); pa[3] = pack_p(p1, 1);
}
__device__ __forceinline__ void attn_pv(WState& S, const LAS unsigned char* buf, const bf16x8 (&pa)[4], int hi, int lane) {
    const LAS unsigned char* vb = buf + 8192 + ((lane >> 4) & 1) * 32 + (lane & 3) * 8 + (4 * hi + ((lane & 15) >> 2)) * 64;
#pragma unroll
    for (int s4 = 0; s4 < 4; ++s4) {
        const bf16x8 v0 = vfrag(vb + s4 * 1024), v1 = vfrag(vb + 4096 + s4 * 1024);
        S.o0 = MFMA32(v0, pa[s4], S.o0, 0, 0, 0); S.o1 = MFMA32(v1, pa[s4], S.o1, 0, 0, 0);
    }
}
#define STAG_LOOP(NS, ISSUE, QKBLOCK) do { bf16x8 pa[4]; int have = 0; (void)grpB; \
    _Pragma("unroll 1") for (int j = 0; j < (NS); ++j) { \
        RING_STEP_SYNC(j, NS); \
        if (j + 2 < (NS)) { ISSUE(j + 2); } \
        { QKBLOCK(j); } \
        if (have) attn_pv(S, kvb + (j % 3) * 16384, pa, hi, lane); have = 0; \
    } } while (0)

__device__ __forceinline__ void store_ot(bf16* op  , const f32x16& o0, const f32x16& o1) {
#pragma unroll
    for (int k4 = 0; k4 < 4; ++k4) {
        u32x2 w0, w1; w0.x = pk2(o0[4 * k4 + 0], o0[4 * k4 + 1]); w0.y = pk2(o0[4 * k4 + 2], o0[4 * k4 + 3]); w1.x = pk2(o1[4 * k4 + 0], o1[4 * k4 + 1]); w1.y = pk2(o1[4 * k4 + 2], o1[4 * k4 + 3]);
        *(u32x2*)(op + 8 * k4) = w0; *(u32x2*)(op + 32 + 8 * k4) = w1;
    }
}
__device__ __forceinline__ void attn_tables(LAS unsigned char* lds, const float* rel_bias, int tid) {
    LAS float* tab = (LAS float*)(lds + A_TAB);
    for (int e = tid; e < 20 * TABN; e += 512) { const int t = e / TABN, i = e % TABN, dist = i - 96, head = t < 8 ? t : t - 8; const bool win = t >= 8 && t < 16;
        float v = NEGB; if (dist >= 0 && !(win && dist >= 256)) { const int bk = dist >= 128 ? 31 : t5_bucket(dist); v = rel_bias[bk * 12 + head] * LOG2E; }
        tab[e] = v; }
    LAS float* ct = (LAS float*)(lds + A_CTAB);
    for (int e = tid; e < 8 * CTABN; e += 512) { const int hd = e / CTABN, i = e % CTABN; float v = NEGB;
        if (i >= 1 && i <= 129) { const int dist = i - 1; const int bk = dist >= 128 ? 31 : t5_bucket(dist); v = rel_bias[bk * 12 + hd] * LOG2E; }
        ct[e] = v; }
    __syncthreads();
}

__device__ __forceinline__ void nsa_unit(int b, int g, int qb, LAS unsigned char* lds, const bf16* PA, const bf16* KC, const bf16* VC, bf16* OC, int tid) {
    const int lane = tid & 63, wid = __builtin_amdgcn_readfirstlane(tid >> 6), r32 = lane & 31, hi = lane >> 5;
    const int hh = wid & 3, wq = wid >> 2, head = g * 4 + hh, tq0 = 64 * qb + 32 * wq;
    const size_t row = (size_t)b * SEQ + tq0 + r32;
    bf16x8 q[4];
    { const bf16* qp = PA + row * NPA + PA_QN + head * 64 + 8 * hi;
#pragma unroll
      for (int ks = 0; ks < 4; ++ks) q[ks] = *(const bf16x8*)(qp + 16 * ks); }
    const bf16* gp = PA + row * NPA + PA_GN + head * 3;
    const float g0 = bflo(gp[0]), g1 = bflo(gp[1]), g2 = bflo(gp[2]);
    const bf16* Kc = KC + (size_t)((b * 2 + g) * 128) * 64; const bf16* Vc = VC + (size_t)((b * 2 + g) * 128) * 64;
    const bf16* Ks = PA + (size_t)b * SEQ * NPA + PA_KS + g * 64; const bf16* Vs = PA + (size_t)b * SEQ * NPA + PA_VS + g * 64;
    const bf16* Kw = PA + (size_t)b * SEQ * NPA + PA_KW + g * 64; const bf16* Vw = PA + (size_t)b * SEQ * NPA + PA_VW + g * 64;
    LAS unsigned char* kvb = lds + A_KV; LAS unsigned char* cmpb = lds + A_CMP;
    const int nsel = qb + 1, nwin = qb + 1 < 5 ? qb + 1 : 5, ns = nsel + nwin;
#define NSA_ISSUE(j) do { const int j_ = (j); const bool w_ = j_ >= nsel; const int n_ = w_ ? qb - (j_ - nsel) : qb - j_; \
        stage_kv(kvb + (j_ % 3) * 16384, (w_ ? Kw : Ks) + (size_t)(64 * n_) * NPA, (w_ ? Vw : Vs) + (size_t)(64 * n_) * NPA, NPA, wid, lane); } while (0)
    stage_kv(cmpb, Kc, Vc, 64, wid, lane); stage_kv(cmpb + 16384, Kc + 64 * 64, Vc + 64 * 64, 64, wid, lane);
    NSA_ISSUE(0);
    if (ns > 1) { NSA_ISSUE(1); RING_WAIT_BAR(4); } else RING_WAIT_BAR(2);
    OtPk ot;
    {
        f32x16 sc[4];
#pragma unroll
        for (int ph = 0; ph < 4; ++ph) sc[ph] = f32x16{};
#pragma unroll
        for (int t = 0; t < 2; ++t) { const LAS unsigned char* kb = cmpb + t * 16384 + r32 * 128; const int ksw = (r32 >> 1) & 7;
#pragma unroll
            for (int ks = 0; ks < 4; ++ks) { const int ko = ((2 * ks + hi) ^ ksw) * 16; const bf16x8 k0f = *(const LAS bf16x8*)(kb + ko), k1f = *(const LAS bf16x8*)(kb + ko + 4096);
                sc[2 * t] = MFMA32(k0f, q[ks], sc[2 * t], 0, 0, 0); sc[2 * t + 1] = MFMA32(k1f, q[ks], sc[2 * t + 1], 0, 0, 0); } }
        __builtin_amdgcn_sched_barrier(0);
        const LAS float* ct = (const LAS float*)(lds + A_CTAB) + head * CTABN;
        const int E0 = tq0 + r32 - 31 - 64 * hi;
        float m = NEGB;
#pragma unroll
        for (int ph = 0; ph < 4; ++ph)
#pragma unroll
            for (int k4 = 0; k4 < 4; ++k4) { int base = E0 - 16 * (32 * ph + 8 * k4); asm volatile("" : "+v"(base));
#pragma unroll
                for (int i = 0; i < 4; ++i) { int dist = base - 16 * i; dist = dist < -1 ? -1 : (dist > 128 ? 128 : dist);
                    sc[ph][4 * k4 + i] += ct[dist + 1]; m = fmaxf(m, sc[ph][4 * k4 + i]); } }
        m = swap_max(m);
        const bool valid = m > -1e29f;
        float l = 0.f;
#pragma unroll
        for (int ph = 0; ph < 4; ++ph)
#pragma unroll
            for (int r = 0; r < 16; ++r) { const float e = valid ? __builtin_amdgcn_exp2f(sc[ph][r] - m) : 0.f; sc[ph][r] = e; l += e; }
        l = swap_sum(l);
        const float inv = valid ? 1.0f / l : 0.f;
#pragma unroll
        for (int ph = 0; ph < 4; ++ph) sc[ph] *= inv;
        {
            LAS float* impw = (LAS float*)(lds + A_IMP) + (hh * 64 + 32 * wq + r32) * 33;
            float prevhi = 0.f;
#pragma unroll
            for (int i = 0; i < 16; ++i) { const int ph = i >> 2, k = i & 3;
                const float av = sc[ph][4 * k] + sc[ph][4 * k + 1] + sc[ph][4 * k + 2] + 0.5f * sc[ph][4 * k + 3], bv = 0.5f * sc[ph][4 * k + 3];
                auto rr = __builtin_amdgcn_permlane32_swap(__float_as_uint(bv), __float_as_uint(bv), false, false);
                const float lo_i = __uint_as_float(rr[0]), hi_i = __uint_as_float(rr[1]);
                impw[2 * k + hi + 8 * ph] = av + (hi ? lo_i : prevhi); prevhi = hi_i; }
        }
        __builtin_amdgcn_sched_barrier(0);
        f32x16 o0 = f32x16{}, o1 = f32x16{};
#pragma unroll
        for (int ph = 0; ph < 4; ++ph)
#pragma unroll
            for (int s = 0; s < 2; ++s) { const bf16x8 pa = pack_p(sc[ph], s);
                const LAS unsigned char* vb = cmpb + (ph >> 1) * 16384 + 8192 + ((lane >> 4) & 1) * 32 + (lane & 3) * 8 + (4 * hi + ((lane & 15) >> 2)) * 64 + (2 * (ph & 1) + s) * 1024;
                const bf16x8 v0 = vfrag(vb), v1 = vfrag(vb + 4096);
                o0 = MFMA32(v0, pa, o0, 0, 0, 0); o1 = MFMA32(v1, pa, o1, 0, 0, 0); }
        ot_set(ot, o0, o1, g0);
    }
    __syncthreads();
    {
        const LAS float* impb = (const LAS float*)(lds + A_IMP); LAS float* scb = (LAS float*)(lds + A_SC); LAS unsigned* selb = (LAS unsigned*)(lds + A_SEL);
#pragma unroll 1
        for (int it = 0; it < 4; ++it) { const int e = tid + 512 * it, tok = e >> 5, n = e & 31;
            float s = (impb[(0 * 64 + tok) * 33 + n] + impb[(1 * 64 + tok) * 33 + n]) + (impb[(2 * 64 + tok) * 33 + n] + impb[(3 * 64 + tok) * 33 + n]);
            const bool forced = (n == 0) | (n == qb) | (n == qb - 1);
            s = forced ? 1e4f : (n <= qb ? s : NEGB);
            scb[tok * 33 + n] = s;
            LDS_WAIT();
            int rank = 0;
#pragma unroll 8
            for (int mm = 0; mm < 32; ++mm) { const float sm = scb[tok * 33 + mm]; rank += ((sm > s) | ((sm == s) & (mm < n))) ? 1 : 0; }
            const bool sel = (rank < 8) && (s > -5e29f);
            const unsigned long long bal = __ballot(sel);
            if ((lane & 31) == 0) selb[tok] = (unsigned)(bal >> (lane & 32));
        }
    }
    __syncthreads();
    const unsigned mymask = ((const LAS unsigned*)(lds + A_SEL))[32 * wq + r32];
    const LAS float* tabC = (const LAS float*)(lds + A_TAB) + head * TABN; const LAS float* tabW = (const LAS float*)(lds + A_TAB) + (8 + head) * TABN;
    const float cfar = tabC[96 + 128];
    WState S; ws_reset(S);
    LOADED4(q); LOADED1(g1); LOADED1(g2);
    const int grpB = wq;
#define NSA_QK(j) do { \
        if ((j) == nsel) { const float lt = swap_sum(S.l); ot_add(ot, S.o0, S.o1, g1 / lt); ws_reset(S); } \
        const bool win = (j) >= nsel; const int n = win ? qb - ((j) - nsel) : qb - (j); const int a = (tq0 - 64 * n) >> 5; \
        const LAS unsigned char* buf = kvb + ((j) % 3) * 16384; const int D0 = tq0 + r32 - 64 * n - 4 * hi; \
        if (!win) { const bool near = a < 6; const float cadd = (((mymask >> n) & 1u) ? 0.f : NEGB) + (near ? 0.f : cfar); attn_qk(S, q, buf, cadd, near, tabC + (D0 + 33), r32, hi, pa); have = 1; } \
        else if (a < 10) { const bool far = (a == 6) | (a == 7); attn_qk(S, q, buf, far ? cfar : 0.f, !far, tabW + (D0 + 33), r32, hi, pa); have = 1; } } while (0)
    STAG_LOOP(ns, NSA_ISSUE, NSA_QK);
#undef NSA_QK
    { const float lt = swap_sum(S.l); ot_add(ot, S.o0, S.o1, g2 / lt); }
    ot_store(OC + row * DM + head * 64 + 4 * hi, ot);
    __syncthreads();
#undef NSA_ISSUE
}

__device__ __forceinline__ void moba_unit(int b, int h, int ob, LAS unsigned char* lds, const bf16* PA, const float* KMEAN, bf16* OC, int tid) {
    const int lane = tid & 63, wid = __builtin_amdgcn_readfirstlane(tid >> 6), r32 = lane & 31, hi = lane >> 5;
    const int tq0 = 256 * ob + 32 * wid;
    const size_t row = (size_t)b * SEQ + tq0 + r32;
    bf16x8 q[4];
    { const bf16* qp = PA + row * NPA + PA_QM + h * 64 + 8 * hi;
#pragma unroll
      for (int ks = 0; ks < 4; ++ks) q[ks] = *(const bf16x8*)(qp + 16 * ks); }
    const bf16* Km = PA + (size_t)b * SEQ * NPA + PA_KM + h * 64; const bf16* Vm = PA + (size_t)b * SEQ * NPA + PA_VM + h * 64;
    LAS unsigned char* kvb = lds + A_KV;
    const int ns = 4 * (ob + 1);
#define MOBA_ISSUE(j) do { const int j_ = (j); const int n_ = ns - 1 - j_; stage_kv(kvb + (j_ % 3) * 16384, Km + (size_t)(64 * n_) * NPA, Vm + (size_t)(64 * n_) * NPA, NPA, wid, lane); } while (0)
    MOBA_ISSUE(0); MOBA_ISSUE(1);
    LAS float* km = (LAS float*)(lds + A_KMEAN); LAS float* mg = (LAS float*)(lds + A_MG);
    km[tid] = KMEAN[(size_t)(b * 4 + h) * 512 + tid];
    __syncthreads();
    {
        const int tok = tid >> 1, hf = tid & 1; const bf16* qrow = PA + ((size_t)b * SEQ + 256 * ob + tok) * NPA + PA_QM + h * 64;
        f32x4 acc = {0.f, 0.f, 0.f, 0.f};
#pragma unroll 1
        for (int c8 = 0; c8 < 8; ++c8) { const u32x4 w = *(const u32x4*)(qrow + 8 * c8); f32x4 qa, qb_; pg8::unpack8(w, qa, qb_);
#pragma unroll
            for (int i = 0; i < 4; ++i) { const LAS float* kp = km + (4 * hf + i) * 64 + 8 * c8; const f32x4 ka = *(const LAS f32x4*)kp, kb = *(const LAS f32x4*)(kp + 4);
                acc[i] += (qa.x * ka.x + qa.y * ka.y) + (qa.z * ka.z + qa.w * ka.w) + (qb_.x * kb.x + qb_.y * kb.y) + (qb_.z * kb.z + qb_.w * kb.w); } }
        *(LAS f32x4*)(mg + tok * 8 + 4 * hf) = acc;
    }
    __syncthreads();
    unsigned mymask = 0u;
    { const LAS float* gp = mg + (32 * wid + r32) * 8; const f32x4 ga = *(const LAS f32x4*)gp, gb = *(const LAS f32x4*)(gp + 4);
      const float gt[8] = {ga.x, ga.y, ga.z, ga.w, gb.x, gb.y, gb.z, gb.w};
#pragma unroll
      for (int n = 0; n < 8; ++n) { int rank = 0;
#pragma unroll
          for (int mm = 0; mm < 8; ++mm) rank += ((mm < ob) & ((gt[mm] > gt[n]) | ((gt[mm] == gt[n]) & (mm < n)))) ? 1 : 0;
          if ((n < ob) & (rank < 3)) mymask |= 1u << n; } }
    const LAS float* tabM = (const LAS float*)(lds + A_TAB) + (16 + h) * TABN;
    const float cfar = tabM[96 + 128];
    WState S; ws_reset(S);
    LOADED4(q);
    const int grpB = wid >> 2;
#define MOBA_QK(j) do { const int n = ns - 1 - (j), blk = n >> 2; \
        if (tq0 + 31 - 64 * n >= 0) { const int a = (tq0 - 64 * n) >> 5; const bool near = a < 6; float cadd = near ? 0.f : cfar; \
            if (blk < ob) cadd += ((mymask >> blk) & 1u) ? 0.f : NEGB; \
            const int D0 = tq0 + r32 - 64 * n - 4 * hi; \
            attn_qk(S, q, kvb + ((j) % 3) * 16384, cadd, near, tabM + (D0 + 33), r32, hi, pa); have = 1; } } while (0)
    STAG_LOOP(ns, MOBA_ISSUE, MOBA_QK);
#undef MOBA_QK
    { const float lt = swap_sum(S.l); const float scl = 1.0f / lt; S.o0 *= scl; S.o1 *= scl; }
    store_ot(OC + row * DM + 512 + h * 64 + 4 * hi, S.o0, S.o1);
    __syncthreads();
#undef MOBA_ISSUE
}

__device__ __forceinline__ void mem_unit(int b, int h, int tb, LAS unsigned char* lds, const bf16* PA, const bf16* MKV, bf16* OC, int tid) {
    const int lane = tid & 63, wid = __builtin_amdgcn_readfirstlane(tid >> 6), r32 = lane & 31, hi = lane >> 5;
    const int tq0 = 256 * tb + 32 * wid;
    const size_t row = (size_t)b * SEQ + tq0 + r32;
    bf16x8 q[4];
    { const bf16* qp = PA + row * NPA + PA_QX + h * 64 + 8 * hi;
#pragma unroll
      for (int ks = 0; ks < 4; ++ks) q[ks] = *(const bf16x8*)(qp + 16 * ks); }
    const bf16* Kx = MKV + (size_t)b * MEML * 512 + h * 64; const bf16* Vx = Kx + 256;
    LAS unsigned char* kvb = lds + A_KV;
    stage_kv(kvb, Kx, Vx, 512, wid, lane); stage_kv(kvb + 16384, Kx + (size_t)64 * 512, Vx + (size_t)64 * 512, 512, wid, lane);
    WState S; ws_reset(S);
    LOADED4(q);
    const int grpB = wid >> 2;
#define MEM_ISSUE(j) stage_kv(kvb + ((j) % 3) * 16384, Kx + (size_t)(64 * (j)) * 512, Vx + (size_t)(64 * (j)) * 512, 512, wid, lane)
#define MEM_QK(j) do { attn_qk(S, q, kvb + ((j) % 3) * 16384, 0.f, false, (const LAS float*)(lds + A_TAB), r32, hi, pa); have = 1; } while (0)
    STAG_LOOP(4, MEM_ISSUE, MEM_QK);
#undef MEM_QK
#undef MEM_ISSUE
    { const float lt = swap_sum(S.l); const float scl = 1.0f / lt; S.o0 *= scl; S.o1 *= scl; }
    store_ot(OC + row * DM + 768 + h * 64 + 4 * hi, S.o0, S.o1);
    __syncthreads();
}

#ifndef MK_MULTI_LAUNCH
#define MK_MULTI_LAUNCH 0
#endif
constexpr int N_PHASES = 19;
__device__ __forceinline__ int lane_now() { unsigned z = 0u; asm volatile("" : "+s"(z)); return (int)__builtin_amdgcn_mbcnt_hi(~0u, __builtin_amdgcn_mbcnt_lo(~0u, z)); }
struct Args { const float* in[23]; float* out; unsigned char* ws; int ph_lo, ph_hi; };

__global__ void __launch_bounds__(512, 2) fwd_kernel(Args args) {
    extern __shared__ __attribute__((aligned(16))) unsigned char lds_raw[];
    LAS unsigned char* lds = (LAS unsigned char*)lds_raw;
    volatile LAS unsigned* MISC = (volatile LAS unsigned*)(lds + MISC_OFF);
    const int wave = __builtin_amdgcn_readfirstlane((int)threadIdx.x >> 6);
#define TID_NOW (wave * 64 + lane_now())
    const int G = gridDim.x, bx_k = blockIdx.x; const int vcu_k = (G % 8 == 0) ? (bx_k % 8) * (G / 8) + bx_k / 8 : bx_k;
    unsigned* ctl = (unsigned*)(args.ws + WS_CTL);
    for (int u = threadIdx.x; u < (LDS_BYTES - MISC_OFF) / 4; u += 512) MISC[u] = 0u;
    __syncthreads();
    const int lo = args.ph_lo, hi = args.ph_hi;
    XcdBarrier bar; bar.bar = ctl + CW_BAR; bar.x = 0; bar.st = nullptr;
    if (hi - lo > 1) bar = xcd_barrier_post(ctl + CW_BAR, MISC + 8);
#ifndef ATT_EN
#define ATT_EN 7
#endif
#ifndef REP_J
#define REP_J -1
#endif
#define NREP(j) ((REP_J) == (j) ? 2 : 1)
#ifndef PHMASK
#define PHMASK 0x3ff
#endif
#define IN(k) (lo <= (k) && (k) < hi)
#define INJ(j) (((PHMASK >> ((j) + 1)) & 1) && IN(pb + (j)))
#define SEAM(k) do { if (IN(k) && IN((k) + 1)) xcd_barrier(bar); } while (0)
    typedef const __attribute__((address_space(4))) unsigned char* kaptr_t;
#define KA_DECL kaptr_t ka = (kaptr_t)__builtin_amdgcn_kernarg_segment_ptr(); int bx = bx_k, vcu = vcu_k, gw = gw_k; asm volatile("" : "+s"(ka), "+s"(bx), "+s"(vcu), "+s"(gw)); unsigned char* ws = *(unsigned char* const __attribute__((address_space(4)))*)(ka + 192)
#define KIN(i) (*(const float* const __attribute__((address_space(4)))*)(ka + 8 * (i)))
#define KOUT (*(float* const __attribute__((address_space(4)))*)(ka + 184))
    const int gw_k = vcu_k * 8 + wave, NGW = G * 8;

    if ((PHMASK & 1) && IN(0)) for (int rep_ = 0; rep_ < ((REP_J) == 100 ? 2 : 1); ++rep_) {
        const int lane = TID_NOW & 63;
        KA_DECL; const float* x_in = KIN(0); const float* mem_in = KIN(1); const float* pre_mix_g = KIN(3); const float* mem_norm_g = KIN(4); bf16* MEMN = (bf16*)KOUT; bf16* H = (bf16*)(ws + WS_H);
        LAS float* scr = (LAS float*)(lds + wave * 16384);
        if ((gw & 7) == 0 && (gw >> 3) < 8) {
            const int t = gw >> 3, l = t >> 2, kv = (t >> 1) & 1, nh = t & 1, n = 64 * nh + lane;
            const float* pos = KIN(kv ? 10 : 7) + (size_t)l * 2048; const float* w1 = KIN(kv ? 11 : 8) + (size_t)l * 2048 * 128;
            float acc = 0.f;
#pragma unroll 8
            for (int k = 0; k < 2048; ++k) acc += pos[k] * w1[(size_t)k * 128 + n];
            ((float*)(ws + WS_W + l * WL_STRIDE + (kv ? WL_POSV : WL_POSK)))[n] = acc;
        }
        for (int l = 0; l < 2; ++l) {
            unsigned char* wl = ws + WS_W + l * WL_STRIDE;
#pragma unroll 1
            for (int mi = 0; mi < 12; ++mi) {
                int kind = 0, Ksrc = 0, ldw = 0, Ndst = 0, ldt = 0, kdst = 0; const float* W = nullptr; const float* W2 = nullptr; bf16* WT = nullptr;
                switch (mi) {
                    case 0: kind = 1; W = KIN(6) + (size_t)l * 1024 * INW; Ksrc = 1024; ldw = INW; Ndst = NIN; WT = (bf16*)(wl + WL_IN); ldt = 1024; break;
                    case 1: kind = 2; W = KIN(20) + (size_t)l * 1024 * DFF; W2 = KIN(21) + (size_t)l * 1024 * DFF; Ksrc = 1024; ldw = DFF; Ndst = NGU; WT = (bf16*)(wl + WL_GU); ldt = 1024; break;
                    case 2: W = KIN(22) + (size_t)l * DFF * 1024; Ksrc = DFF; ldw = 1024; Ndst = 1024; WT = (bf16*)(wl + WL_DN); ldt = DFF; break;
                    case 3: W = KIN(14) + (size_t)l * 512 * 1024; Ksrc = 512; ldw = 1024; Ndst = 1024; WT = (bf16*)(wl + WL_BR); ldt = 1024; kdst = 0; break;
                    case 4: W = KIN(15) + (size_t)l * 256 * 1024; Ksrc = 256; ldw = 1024; Ndst = 1024; WT = (bf16*)(wl + WL_BR); ldt = 1024; kdst = 512; break;
                    case 5: W = KIN(16) + (size_t)l * 256 * 1024; Ksrc = 256; ldw = 1024; Ndst = 1024; WT = (bf16*)(wl + WL_BR); ldt = 1024; kdst = 768; break;
                    case 6: W = KIN(17) + (size_t)l * 1024 * 1024; Ksrc = 1024; ldw = 1024; Ndst = 1024; WT = (bf16*)(wl + WL_MIX); ldt = 1024; break;
                    case 7: W = KIN(13) + (size_t)l * 1024 * 512; Ksrc = 1024; ldw = 512; Ndst = 512; WT = (bf16*)(wl + WL_MKV); ldt = 1024; break;
                    case 8: W = KIN(8) + (size_t)l * 2048 * 128; Ksrc = 2048; ldw = 128; Ndst = 128; WT = (bf16*)(wl + WL_W1K); ldt = 2048; break;
                    case 9: W = KIN(11) + (size_t)l * 2048 * 128; Ksrc = 2048; ldw = 128; Ndst = 128; WT = (bf16*)(wl + WL_W1V); ldt = 2048; break;
                    case 10: W = KIN(9) + (size_t)l * 128 * 64; Ksrc = 128; ldw = 64; Ndst = 64; WT = (bf16*)(wl + WL_W2K); ldt = 128; break;
                    default: W = KIN(12) + (size_t)l * 128 * 64; Ksrc = 128; ldw = 64; Ndst = 64; WT = (bf16*)(wl + WL_W2V); ldt = 128; break;
                }
                tr_matrix(kind, W, W2, Ksrc, ldw, Ndst, WT, ldt, kdst, scr, gw, NGW, lane);
            }
        }
        for (int m0 = 4 * gw; m0 < 2 * NMEM; m0 += 4 * NGW) { const int l = m0 / NMEM, r = m0 % NMEM;
            const float* xr[4] = {mem_in + (size_t)r * DM, mem_in + (size_t)(r + 1) * DM, mem_in + (size_t)(r + 2) * DM, mem_in + (size_t)(r + 3) * DM};
            bf16* orow[4] = {MEMN + (size_t)m0 * DM, MEMN + (size_t)(m0 + 1) * DM, MEMN + (size_t)(m0 + 2) * DM, MEMN + (size_t)(m0 + 3) * DM};
            rms_rows_bf16<4>(xr, mem_norm_g + l * DM, orow, lane); }
        for (int m0 = 4 * gw; m0 < NTOK; m0 += 4 * NGW) {
            const float* xr[4] = {x_in + (size_t)m0 * DM, x_in + (size_t)(m0 + 1) * DM, x_in + (size_t)(m0 + 2) * DM, x_in + (size_t)(m0 + 3) * DM};
            bf16* orow[4] = {H + (size_t)m0 * DM, H + (size_t)(m0 + 1) * DM, H + (size_t)(m0 + 2) * DM, H + (size_t)(m0 + 3) * DM};
            rms_rows_bf16<4>(xr, pre_mix_g, orow, lane); }
    }
    SEAM(0);

#pragma unroll 1
    for (int l = 0; l < 2; ++l) {
        const int pb = 1 + 9 * l;
        if (INJ(0)) for (int rep_ = 0; rep_ < NREP(0); ++rep_) {
            KA_DECL; unsigned char* wl = ws + WS_W + l * WL_STRIDE; bf16* H = (bf16*)(ws + WS_H); bf16* PA = (bf16*)(ws + WS_PA); bf16* GT = (bf16*)(ws + WS_GT); bf16* MEMN = (bf16*)KOUT; bf16* MEMKV = (bf16*)(ws + WS_MEMKV);
            { pg8::Gemm g{H, (const bf16*)(wl + WL_IN), NTOK, NIN, 1024, 1024, 1024}; pg8::StaticOrder S; S.init(NTOK, NIN, G, bx);
              pg8::EpiProj E{PA, GT}; pg8::gemm_phase<pg8::EpiProj, pg8::StaticOrder, true, true>(lds, g, S, E, wave); }
            if (l == 0) {
#pragma unroll 1
                for (int l2 = 0; l2 < 2; ++l2) { pg8::Gemm g{MEMN + (size_t)l2 * NMEM * DM, (const bf16*)(ws + WS_W + l2 * WL_STRIDE + WL_MKV), NMEM, 512, 1024, 1024, 1024};
                    pg8::StaticOrder S; S.init(NMEM, 512, G, bx); pg8::EpiPlain E{MEMKV + (size_t)l2 * NMEM * 512, 512};
                    pg8::gemm_phase<pg8::EpiPlain, pg8::StaticOrder, true, true>(lds, g, S, E, wave); }
            }
        }
        SEAM(pb + 0);
        if (INJ(1)) for (int rep_ = 0; rep_ < NREP(1); ++rep_) {
            int tid_p = TID_NOW; asm volatile("" : "+v"(tid_p));
            KA_DECL; unsigned char* wl = ws + WS_W + l * WL_STRIDE; bf16* PA = (bf16*)(ws + WS_PA); bf16* KC = (bf16*)(ws + WS_KC); bf16* VC = (bf16*)(ws + WS_VC); float* KMEAN = (float*)(ws + WS_KMEAN);
            for (int u = bx; u < 256; u += G) {
                if (u < 128) compress_unit(u, lds, PA, wl, KC, VC, tid_p);
                else kmean_unit((u - 128) >> 3, (u - 128) & 7, lds, PA, KMEAN, tid_p);
            }
        }
        SEAM(pb + 1);
        if (INJ(2)) for (int rep_ = 0; rep_ < NREP(2); ++rep_) {
            int tid_p = TID_NOW; asm volatile("" : "+v"(tid_p));
            KA_DECL; const float* rel_bias = KIN(2); bf16* H = (bf16*)(ws + WS_H); bf16* PA = (bf16*)(ws + WS_PA); bf16* KC = (bf16*)(ws + WS_KC); bf16* VC = (bf16*)(ws + WS_VC); float* KMEAN = (float*)(ws + WS_KMEAN); bf16* MEMKV = (bf16*)(ws + WS_MEMKV);
            attn_tables(lds, rel_bias, tid_p);
            if (ATT_EN & 1) for (int rp_ = 0; rp_ < ((REP_J) == 20 ? 2 : 1); ++rp_)
#pragma unroll 1
            for (int P = vcu; P < 512; P += G) { const int bg = P >> 4, s = P & 15;
#pragma unroll 1
                for (int k = 0; k < 2; ++k) nsa_unit(bg >> 1, bg & 1, k ? 31 - s : s, lds, PA, KC, VC, H, tid_p); }
            if (ATT_EN & 2) for (int rp_ = 0; rp_ < ((REP_J) == 21 ? 2 : 1); ++rp_)
#pragma unroll 1
            for (int M = vcu; M < 256; M += G) { const int bh = M >> 2, s = M & 3;
#pragma unroll 1
                for (int k = 0; k < 2; ++k) moba_unit(bh >> 2, bh & 3, k ? 7 - s : s, lds, PA, KMEAN, H, tid_p); }
            if (ATT_EN & 4) for (int rp_ = 0; rp_ < ((REP_J) == 22 ? 2 : 1); ++rp_)
#pragma unroll 1
            for (int u = vcu; u < 512; u += G) { const int bh = u >> 3; mem_unit(bh >> 2, bh & 3, u & 7, lds, PA, MEMKV + (size_t)l * NMEM * 512, H, tid_p); }
        }
        SEAM(pb + 2);
        if (INJ(3)) for (int rep_ = 0; rep_ < NREP(3); ++rep_) {
            KA_DECL; unsigned char* wl = ws + WS_W + l * WL_STRIDE; bf16* H = (bf16*)(ws + WS_H); bf16* MERGED = (bf16*)(ws + WS_PA); bf16* GT = (bf16*)(ws + WS_GT);
#pragma unroll 1
            for (int br = 0; br < 3; ++br) { const int koff = br == 0 ? 0 : (br == 1 ? 512 : 768), K = br == 0 ? 512 : 256;
                pg8::Gemm g{H + koff, (const bf16*)(wl + WL_BR) + koff, NTOK, 1024, K, 1024, 1024}; pg8::StaticOrder S; S.init(NTOK, 1024, G, bx);
                pg8::EpiMerge E{MERGED, 1024, GT + br * 1024, NGT, br == 0 ? 1 : 0};
                pg8::gemm_phase<pg8::EpiMerge, pg8::StaticOrder, true, true>(lds, g, S, E, wave);
                VM_WAIT(); __syncthreads(); }
        }
        SEAM(pb + 3);
        if (INJ(4)) for (int rep_ = 0; rep_ < NREP(4); ++rep_) {
            KA_DECL; unsigned char* wl = ws + WS_W + l * WL_STRIDE; bf16* MERGED = (bf16*)(ws + WS_PA); bf16* YB = (bf16*)(ws + WS_GT);
            pg8::Gemm g{MERGED, (const bf16*)(wl + WL_MIX), NTOK, 1024, 1024, 1024, 1024}; pg8::StaticOrder S; S.init(NTOK, 1024, G, bx);
            pg8::EpiPlain E{YB, 1024}; pg8::gemm_phase<pg8::EpiPlain, pg8::StaticOrder, true, true>(lds, g, S, E, wave);
        }
        SEAM(pb + 4);
        if (INJ(5)) for (int rep_ = 0; rep_ < (((REP_J) == 5 && l == 0) ? 2 : 1); ++rep_) {
            int lane_p = TID_NOW & 63; asm volatile("" : "+v"(lane_p));
            KA_DECL; float* xres = KOUT; const float* post_mix_g = KIN(5); const float* pre_ffn_g = KIN(18); bf16* YB = (bf16*)(ws + WS_GT); bf16* H = (bf16*)(ws + WS_H);
            const float* xin = l == 0 ? KIN(0) : xres;
            for (int m0 = 2 * gw; m0 < NTOK; m0 += 2 * NGW) {
                const bf16* sr[2] = {YB + (size_t)m0 * DM, YB + (size_t)(m0 + 1) * DM}; const float* xi[2] = {xin + (size_t)m0 * DM, xin + (size_t)(m0 + 1) * DM};
                float* xo[2] = {xres + (size_t)m0 * DM, xres + (size_t)(m0 + 1) * DM}; bf16* ho[2] = {H + (size_t)m0 * DM, H + (size_t)(m0 + 1) * DM};
                norm_res_norm<2>(sr, post_mix_g + l * DM, xi, xo, pre_ffn_g + l * DM, ho, true, lane_p); }
        }
        SEAM(pb + 5);
        if (INJ(6)) for (int rep_ = 0; rep_ < NREP(6); ++rep_) {
            KA_DECL; unsigned char* wl = ws + WS_W + l * WL_STRIDE; bf16* H = (bf16*)(ws + WS_H); bf16* UB = (bf16*)(ws + WS_GT);
            pg8::Gemm g{H, (const bf16*)(wl + WL_GU), NTOK, NGU, 1024, 1024, 1024}; pg8::StaticOrder S; S.init(NTOK, NGU, G, bx);
            pg8::EpiSwiGLU E{UB, DFF}; pg8::gemm_phase<pg8::EpiSwiGLU, pg8::StaticOrder, true, true>(lds, g, S, E, wave);
        }
        SEAM(pb + 6);
        if (INJ(7)) for (int rep_ = 0; rep_ < NREP(7); ++rep_) {
            KA_DECL; unsigned char* wl = ws + WS_W + l * WL_STRIDE; bf16* UB = (bf16*)(ws + WS_GT); bf16* FB = (bf16*)(ws + WS_PA);
            pg8::Gemm g{UB, (const bf16*)(wl + WL_DN), NTOK, 1024, DFF, DFF, DFF}; pg8::StaticOrder S; S.init(NTOK, 1024, G, bx);
            pg8::EpiPlain E{FB, 1024}; pg8::gemm_phase<pg8::EpiPlain, pg8::StaticOrder, true, true>(lds, g, S, E, wave);
        }
        SEAM(pb + 7);
        if (INJ(8)) {
            int lane_p = TID_NOW & 63; asm volatile("" : "+v"(lane_p));
            KA_DECL; float* xres = KOUT; const float* post_ffn_g = KIN(19); const float* pre_mix_g = KIN(3); bf16* FB = (bf16*)(ws + WS_PA); bf16* H = (bf16*)(ws + WS_H);
            for (int m0 = 2 * gw; m0 < NTOK; m0 += 2 * NGW) {
                const bf16* sr[2] = {FB + (size_t)m0 * DM, FB + (size_t)(m0 + 1) * DM}; const float* xi[2] = {xres + (size_t)m0 * DM, xres + (size_t)(m0 + 1) * DM};
                float* xo[2] = {xres + (size_t)m0 * DM, xres + (size_t)(m0 + 1) * DM}; bf16* ho[2] = {H + (size_t)m0 * DM, H + (size_t)(m0 + 1) * DM};
                norm_res_norm<2>(sr, post_ffn_g + l * DM, xi, xo, pre_mix_g + DM, ho, l == 0, lane_p); }
        }
        SEAM(pb + 8);
    }
#undef IN
#undef INJ
#undef SEAM
}

extern "C" void kernel_launch(void* const* d_in, const int* in_sizes, int n_in, void* d_out, int out_size, void* d_ws, size_t ws_size, hipStream_t stream) {
    static int grid = 0;
    if (grid == 0) {
        if (n_in != 23 || in_sizes[0] != NTOK * DM || out_size != NTOK * DM || ws_size < WS_END) { fprintf(stderr, "kernel_launch: unexpected shapes (n_in %d, in0 %d, out %d, ws %zu); nothing launched\n", n_in, n_in > 0 ? in_sizes[0] : -1, out_size, ws_size); grid = -1; return; }
        int dev = 0, cus = 0, per_cu = 0;
        if (hipGetDevice(&dev) != hipSuccess || hipDeviceGetAttribute(&cus, hipDeviceAttributeMultiprocessorCount, dev) != hipSuccess) { grid = -1; return; }
        if (hipFuncSetAttribute((const void*)fwd_kernel, hipFuncAttributeMaxDynamicSharedMemorySize, LDS_BYTES) != hipSuccess) { fprintf(stderr, "kernel_launch: hipFuncSetAttribute failed\n"); grid = -1; return; }
        if (hipOccupancyMaxActiveBlocksPerMultiprocessor(&per_cu, (const void*)fwd_kernel, 512, LDS_BYTES) != hipSuccess || per_cu < 1) fprintf(stderr, "kernel_launch: occupancy query reports %d\n", per_cu);
        (void)hipGetLastError();
        grid = cus;
    }
    if (grid < 0) return;
    if (hipMemsetAsync((char*)d_ws + WS_CTL, 0, CTL_ZERO_BYTES, stream) != hipSuccess) return;
    Args a{};
    for (int i = 0; i < 23; ++i) a.in[i] = (const float*)d_in[i];
    a.out = (float*)d_out; a.ws = (unsigned char*)d_ws;
#if MK_MULTI_LAUNCH
    for (int p = 0; p < N_PHASES; ++p) { a.ph_lo = p; a.ph_hi = p + 1; hipLaunchKernelGGL(fwd_kernel, dim3(grid), dim3(512), LDS_BYTES, stream, a); }
#else
    a.ph_lo = 0; a.ph_hi = N_PHASES;
    hipLaunchKernelGGL(fwd_kernel, dim3(grid), dim3(512), LDS_BYTES, stream, a);
#endif
    const hipError_t le = hipPeekAtLastError();
    if (le != hipSuccess) fprintf(stderr, "kernel_launch: launch failed: %s\n", hipGetErrorName(le));
}
```

```cpp
#include <hip/hip_runtime.h>
#include <cstdio>
#include <cstdint>

#define LAS __attribute__((address_space(3)))
#define GAS __attribute__((address_space(1)))
typedef unsigned short bf16;
typedef short bf16x8 __attribute__((ext_vector_type(8)));
typedef short s16x4 __attribute__((ext_vector_type(4)));
typedef float f32x2 __attribute__((ext_vector_type(2)));
typedef float f32x4 __attribute__((ext_vector_type(4)));
typedef float f32x16 __attribute__((ext_vector_type(16)));
typedef unsigned u32x2 __attribute__((ext_vector_type(2)));
typedef unsigned u32x4 __attribute__((ext_vector_type(4)));

constexpr int BATCH = 16, SEQ = 2048, DM = 1024, NTOK = BATCH * SEQ;
constexpr int NPA = 2560;
constexpr int NGT = 3072;
constexpr int NIN = NPA + NGT;
constexpr int INW = 5400;
constexpr int DFF = 2816, NGU = 2 * DFF;
constexpr int MEML = 256, NMEM = BATCH * MEML;
constexpr int PA_QN = 0, PA_KC = 512, PA_VC = 640, PA_KS = 768, PA_VS = 896, PA_KW = 1024, PA_VW = 1152;
constexpr int PA_QM = 1280, PA_KM = 1536, PA_VM = 1792, PA_QX = 2048, PA_GN = 2304;
constexpr float RMS_EPS = 1e-6f;
constexpr float LOG2E = 1.4426950408889634f;
constexpr float C2 = 0.125f * LOG2E;
constexpr float NEGB = -1e30f;

constexpr size_t MiB = 1u << 20;
constexpr size_t WS_CTL = 0, CTL_ZERO_BYTES = 1 * MiB;
constexpr size_t WS_W = 1 * MiB;
constexpr size_t WL_STRIDE = 35 * MiB;
constexpr size_t WL_IN = 0, WL_GU = 11 * MiB, WL_DN = 22 * MiB, WL_BR = 28 * MiB, WL_MIX = 30 * MiB, WL_MKV = 32 * MiB, WL_W1K = 33 * MiB, WL_W1V = 33 * MiB + 512 * 1024;
constexpr size_t WL_SM = 34 * MiB;
constexpr size_t WL_W2K = WL_SM, WL_W2V = WL_SM + 16384, WL_POSK = WL_SM + 32768, WL_POSV = WL_SM + 32768 + 512;
constexpr size_t WS_MEMKV = 71 * MiB;
constexpr size_t WS_KC = 79 * MiB, WS_VC = 79 * MiB + 512 * 1024;
constexpr size_t WS_KMEAN = 80 * MiB;
constexpr size_t WS_H = 81 * MiB;
constexpr size_t WS_PA = 145 * MiB;
constexpr size_t WS_GT = 305 * MiB;
constexpr size_t WS_END = 497 * MiB;
static_assert(WL_DN + (size_t)DM * DFF * 2 <= WL_BR && WS_W + 2 * WL_STRIDE <= WS_MEMKV && WS_H + (size_t)NTOK * DM * 2 <= WS_PA && WS_PA + (size_t)NTOK * NPA * 2 <= WS_GT && WS_GT + (size_t)NTOK * NGT * 2 <= WS_END, "ws map");
constexpr int CW_TMO = 0, CW_BAR = 4096;
constexpr int CW_CMAX = 16384;
constexpr size_t WL_SBIN = WL_SM + 65536, WL_SBGU = WL_SM + 98304;
constexpr size_t WS_SA = WS_KMEAN + 512 * 1024;
static_assert((CW_CMAX + 4 * NIN) * 4 <= (int)CTL_ZERO_BYTES && WL_SBGU + NIN * 4 <= WL_STRIDE && WS_SA + NTOK * 4 <= WS_H, "int8 side tables");

constexpr int RING_BYTES = 131072;
constexpr int MISC_OFF = 156672;
constexpr int LDS_BYTES = 157696;
constexpr int A_KV = 0, A_CMP = 49152, A_TAB = 81920, A_CTAB = 117760, A_IMP = 121984, A_SC = A_CMP, A_SEL = A_CMP + 16384, A_KMEAN = A_IMP, A_MG = A_IMP + 2048;
constexpr int TABN = 448, CTABN = 132;
static_assert(A_IMP + 4 * 64 * 33 * 4 <= MISC_OFF && A_TAB + 20 * TABN * 4 <= A_CTAB && A_CTAB + 8 * CTABN * 4 <= A_IMP, "lds map");

__device__ __forceinline__ unsigned f2bf(float f) { unsigned u = __builtin_bit_cast(unsigned, f); return (u + 0x7fffu + ((u >> 16) & 1u)) >> 16; }
__device__ __forceinline__ unsigned pk2(float lo, float hi) { return f2bf(lo) | (f2bf(hi) << 16); }
__device__ __forceinline__ float bflo(unsigned w) { return __builtin_bit_cast(float, w << 16); }
__device__ __forceinline__ float bfhi(unsigned w) { return __builtin_bit_cast(float, w & 0xffff0000u); }
__device__ __forceinline__ float fast_sigmoid(float v) { return __builtin_amdgcn_rcpf(1.0f + __builtin_amdgcn_exp2f(-LOG2E * v)); }

namespace pg8 {
#define PG8_LAS __attribute__((address_space(3)))
typedef unsigned short bf16_t;
constexpr int BM = 256, BK = 64, HALF = 128, HTB = HALF * BK * 2  , STAGE_BYTES = 8 * HTB, NXCD = 8, WGM = 8;

__host__ __device__ __forceinline__ int lds_byte(int r, int c) { const int st = (r >> 4) * 2 + (c >> 5), rr = r & 15, cc = c & 31, ob = rr * 64 + cc * 2; return st * 1024 + (ob ^ (((ob >> 9) & 1) << 5)); }
__host__ __device__ __forceinline__ void stage_rc(int b, int& R, int& C) { const int st = b / 1024, sb = b % 1024, swz = sb ^ (((sb >> 9) & 1) << 5); R = (st >> 1) * 16 + swz / 64; C = (st & 1) * 32 + (swz % 64) / 2; }
__host__ __device__ __forceinline__ int perm32(int rho) { const int n = rho >> 4, i = rho & 15; return 8 * (i >> 2) + 4 * n + (i & 3); }

struct Unit { int pm, pn; };
struct Gemm { const bf16_t* A; const bf16_t* Bt; int M, N, K, lda, ldb; };

struct StaticOrder {
    int nM, nN, nwg, G, c;
    __host__ __device__ void init(int M, int N, int G_, int c_) { nM = M / BM; nN = N / BM; nwg = nM * nN; G = G_; c = c_; }
    __host__ __device__ bool next(int i, Unit& u) const {
        const long L = (long)i * G + c; if (L >= nwg) return false;
        int wgid = (int)L; { const int q = nwg / NXCD, r = nwg % NXCD, xcd = wgid % NXCD, off = wgid / NXCD; wgid = (xcd < r ? xcd * (q + 1) : r * (q + 1) + (xcd - r) * q) + off; }
        const int nig = WGM * nN, gid = wgid / nig, fm = gid * WGM, gsz = (nM - fm) < WGM ? (nM - fm) : WGM;
        u.pm = fm + ((wgid % nig) % gsz); u.pn = (wgid % nig) / gsz; return true;
    }
    __device__ __forceinline__ void a_ready(const Unit&) const {}
    __device__ __forceinline__ void done(const Unit&) const {}
};

__device__ __forceinline__ unsigned cvt_pk_bf16(float lo, float hi) { unsigned r; asm volatile("v_cvt_pk_bf16_f32 %0, %1, %2" : "=v"(r) : "v"(lo), "v"(hi)); return r; }
__device__ __forceinline__ u32x4 pack8(const f32x4& v0, const f32x4& v1) { u32x4 w; w.x = cvt_pk_bf16(v0[0], v0[1]); w.y = cvt_pk_bf16(v0[2], v0[3]); w.z = cvt_pk_bf16(v1[0], v1[1]); w.w = cvt_pk_bf16(v1[2], v1[3]); return w; }
__device__ __forceinline__ void unpack8(const u32x4& w, f32x4& v0, f32x4& v1) { v0 = (f32x4){bflo(w.x), bfhi(w.x), bflo(w.y), bfhi(w.y)}; v1 = (f32x4){bflo(w.z), bfhi(w.z), bflo(w.w), bfhi(w.w)}; }

typedef int i32x4 __attribute__((ext_vector_type(4)));
template <bool I8> __device__ __forceinline__ f32x4 mma16(bf16x8 b, bf16x8 a, f32x4 c) {
    if constexpr (I8) return __builtin_bit_cast(f32x4, __builtin_amdgcn_mfma_i32_16x16x64_i8(__builtin_bit_cast(i32x4, b), __builtin_bit_cast(i32x4, a), __builtin_bit_cast(i32x4, c), 0, 0, 0));
    else return __builtin_amdgcn_mfma_f32_16x16x32_bf16(b, a, c, 0, 0, 0);
}
__device__ __forceinline__ f32x4 i2f4(const f32x4& a) { const i32x4 i = __builtin_bit_cast(i32x4, a); return (f32x4){(float)i[0], (float)i[1], (float)i[2], (float)i[3]}; }
struct EpiPlain {
    static constexpr bool PERM = true, AFTER_DRAIN = false, SEG = false;
    bf16_t* O; int ldc;
    __device__ __forceinline__ void operator()(const f32x4 (&acc)[2][2][4][2], const Unit& u, int wr, int wc, int fr, int fq) const {
        const int row0 = u.pm * BM + wr * 64 + fr, col0 = u.pn * BM + wc * 32 + 8 * fq;
#pragma unroll
        for (int ai = 0; ai < 2; ++ai)
#pragma unroll
            for (int m = 0; m < 4; ++m) { bf16_t* rowp = O + (size_t)(row0 + ai * HALF + m * 16) * ldc + col0;
#pragma unroll
                for (int bj = 0; bj < 2; ++bj) *(u32x4*)(rowp + bj * HALF) = pack8(acc[ai][bj][m][0], acc[ai][bj][m][1]); }
    }
};
struct EpiProj {
    static constexpr bool PERM = true, AFTER_DRAIN = false, SEG = false;
    bf16_t* PA; bf16_t* GT; const float* sa; const float* sb;
    __device__ __forceinline__ void operator()(const f32x4 (&acc)[2][2][4][2], const Unit& u, int wr, int wc, int fr, int fq) const {
        const int pn = u.pn; bf16_t* base; int ldc, colt; float sc = 1.f; bool sig = false;
        if (pn < 10) { base = PA; ldc = NPA; colt = pn * BM; if (pn < 2 || pn == 5 || pn == 8) sc = C2; if (pn == 9) sig = true; }
        else { base = GT; ldc = NGT; colt = (pn - 10) * BM; sig = true; }
        const int row0 = u.pm * BM + wr * 64 + fr, col0 = colt + wc * 32 + 8 * fq;
        f32x4 sbv[2][2];
#pragma unroll
        for (int bj = 0; bj < 2; ++bj) { const float* sp = sb + pn * BM + bj * HALF + wc * 32 + 8 * fq; sbv[bj][0] = *(const f32x4*)sp * sc; sbv[bj][1] = *(const f32x4*)(sp + 4) * sc; }
#pragma unroll
        for (int ai = 0; ai < 2; ++ai)
#pragma unroll
            for (int m = 0; m < 4; ++m) { const int row = row0 + ai * HALF + m * 16; bf16_t* rowp = base + (size_t)row * ldc + col0; const float sar = sa[row];
#pragma unroll
                for (int bj = 0; bj < 2; ++bj) { f32x4 v0 = i2f4(acc[ai][bj][m][0]) * sbv[bj][0] * sar, v1 = i2f4(acc[ai][bj][m][1]) * sbv[bj][1] * sar;
                    if (sig) {
#pragma unroll
                        for (int e = 0; e < 4; ++e) { v0[e] = fast_sigmoid(v0[e]); v1[e] = fast_sigmoid(v1[e]); } }
                    *(u32x4*)(rowp + bj * HALF) = pack8(v0, v1); } }
    }
};
struct EpiMerge {
    static constexpr bool PERM = true, AFTER_DRAIN = false, SEG = false;
    bf16_t* O; int ldc; const bf16_t* G; int ldg; int first;
    __device__ __forceinline__ void operator()(const f32x4 (&acc)[2][2][4][2], const Unit& u, int wr, int wc, int fr, int fq) const {
        const int row0 = u.pm * BM + wr * 64 + fr, col0 = u.pn * BM + wc * 32 + 8 * fq;
#pragma unroll
        for (int ai = 0; ai < 2; ++ai)
#pragma unroll
            for (int mp = 0; mp < 2; ++mp) {
                u32x4 gw[2][2], ow[2][2];
#pragma unroll
                for (int mi = 0; mi < 2; ++mi) { const size_t r = (size_t)(row0 + ai * HALF + (2 * mp + mi) * 16);
#pragma unroll
                    for (int bj = 0; bj < 2; ++bj) { gw[mi][bj] = *(const u32x4*)(G + r * ldg + col0 + bj * HALF); ow[mi][bj] = first ? (u32x4){0u, 0u, 0u, 0u} : *(const u32x4*)(O + r * ldc + col0 + bj * HALF); } }
                asm volatile("" ::: "memory");
#pragma unroll
                for (int mi = 0; mi < 2; ++mi) { const int m = 2 * mp + mi; const size_t r = (size_t)(row0 + ai * HALF + m * 16);
#pragma unroll
                    for (int bj = 0; bj < 2; ++bj) { f32x4 g0, g1, o0, o1; unpack8(gw[mi][bj], g0, g1); unpack8(ow[mi][bj], o0, o1);
                        *(u32x4*)(O + r * ldc + col0 + bj * HALF) = pack8(acc[ai][bj][m][0] * g0 + o0, acc[ai][bj][m][1] * g1 + o1); } }
                asm volatile("" ::: "memory");
            }
    }
};
struct EpiSwiGLU {
    static constexpr bool PERM = true, AFTER_DRAIN = false, SEG = false;
    bf16_t* U; int ldc; const float* sa; const float* sb;
    __device__ __forceinline__ void operator()(const f32x4 (&acc)[2][2][4][2], const Unit& u, int wr, int wc, int fr, int fq) const {
        const int row0 = u.pm * BM + wr * 64 + fr, col0 = u.pn * HALF + wc * 32 + 8 * fq;
        f32x4 sbv[2][2];
#pragma unroll
        for (int bj = 0; bj < 2; ++bj) { const float* sp = sb + u.pn * BM + bj * HALF + wc * 32 + 8 * fq; sbv[bj][0] = *(const f32x4*)sp; sbv[bj][1] = *(const f32x4*)(sp + 4); }
#pragma unroll
        for (int ai = 0; ai < 2; ++ai)
#pragma unroll
            for (int m = 0; m < 4; ++m) { const int row = row0 + ai * HALF + m * 16; bf16_t* rowp = U + (size_t)row * ldc + col0; const float sar = sa[row];
                const f32x4 ga = i2f4(acc[ai][0][m][0]) * sbv[0][0] * sar, gb = i2f4(acc[ai][0][m][1]) * sbv[0][1] * sar;
                const f32x4 ua = i2f4(acc[ai][1][m][0]) * sbv[1][0] * sar, ub = i2f4(acc[ai][1][m][1]) * sbv[1][1] * sar;
                f32x4 v0, v1;
#pragma unroll
                for (int e = 0; e < 4; ++e) { v0[e] = ga[e] * fast_sigmoid(ga[e]) * ua[e]; v1[e] = gb[e] * fast_sigmoid(gb[e]) * ub[e]; }
                *(u32x4*)rowp = pack8(v0, v1); }
    }
};

template <class Epi, class Sched, bool ALIGN_EPI = false, bool SP2 = false, bool I8 = false>
__device__ __forceinline__ void gemm_phase(PG8_LAS unsigned char* lds, const Gemm g, const Sched& S, const Epi& E, int wave_in) {
    unsigned z_ = 0u; asm volatile("" : "+s"(z_));
    int tid_ = wave_in * 64 + (int)__builtin_amdgcn_mbcnt_hi(~0u, __builtin_amdgcn_mbcnt_lo(~0u, z_)); asm volatile("" : "+v"(tid_));
    const int tid = tid_, wid = __builtin_amdgcn_readfirstlane(tid >> 6), lane = tid & 63, wr = wid >> 2, wc = wid & 3, fr = lane & 15, fq = lane >> 4;
    const int K = g.K, nt = K / BK;
    unsigned voffA[2], voffB[2];
#pragma unroll
    for (int i = 0; i < 2; ++i) { int R, C; stage_rc(tid * 16 + i * 8192, R, C); const int Rb = Epi::PERM ? ((R & ~31) + perm32(R & 31)) : R;
        voffA[i] = (unsigned)(R * g.lda + C) * 2u; voffB[i] = (unsigned)(Rb * g.ldb + C) * 2u; }
    const size_t kstep = (size_t)(BK * 2);
    const size_t hstepA = (size_t)HALF * g.lda * 2, hstepB = (size_t)HALF * g.ldb * 2;
    const size_t tstepA = 2 * hstepA, tstepB = 2 * hstepB;
    const unsigned ldsw = (unsigned)wid * 1024u;
    const int aoff = lds_byte(wr * 64 + fr, fq * 8), boff = lds_byte(wc * 32 + fr, fq * 8);
#define PG8_SA(b, h) (((b) * 2 + (h)) * HTB)
#define PG8_SB(b, h) ((4 + (b) * 2 + (h)) * HTB)
#define PG8_STAGE(bufoff, gbase, voff) do { _Pragma("unroll") for (int _i = 0; _i < 2; ++_i) \
        __builtin_amdgcn_global_load_lds((const unsigned*)((const char*)(gbase) + (voff)[_i]), (PG8_LAS unsigned*)(lds + (bufoff) + ldsw + _i * 8192), 16, 0, 0); } while (0)
#define PG8_LDA(dst, b, h) do { _Pragma("unroll") for (int m = 0; m < 4; ++m) _Pragma("unroll") for (int k = 0; k < 2; ++k) dst[m][k] = *(const PG8_LAS bf16x8*)(lds + PG8_SA(b, h) + aoff + m * 2048 + k * 1024); } while (0)
#define PG8_LDB(dst, b, h) do { _Pragma("unroll") for (int n = 0; n < 2; ++n) _Pragma("unroll") for (int k = 0; k < 2; ++k) dst[n][k] = *(const PG8_LAS bf16x8*)(lds + PG8_SB(b, h) + boff + n * 2048 + k * 1024); } while (0)
#define PG8_MMA(ai, bj, At, Bt) do { __builtin_amdgcn_s_setprio(1); _Pragma("unroll") for (int m = 0; m < 4; ++m) _Pragma("unroll") for (int n = 0; n < 2; ++n) _Pragma("unroll") for (int k = 0; k < 2; ++k) \
        acc[ai][bj][m][n] = mma16<I8>(Bt[n][k], At[m][k], acc[ai][bj][m][n]); __builtin_amdgcn_s_setprio(0); } while (0)
#define PG8_WAIT_V(n) asm volatile("s_waitcnt vmcnt(" #n ")" ::: "memory")
#define PG8_WAIT_L(n) asm volatile("s_waitcnt lgkmcnt(" #n ")" ::: "memory")
#define PG8_BAR __builtin_amdgcn_s_barrier()
#define PG8_SCHED __builtin_amdgcn_sched_barrier(0)
    Unit cur, nxt; int ui = 0;
    if (!S.next(0, cur)) return;
    f32x4 acc[2][2][4][2];
#pragma unroll
    for (int a = 0; a < 2; ++a)
#pragma unroll
        for (int b = 0; b < 2; ++b)
#pragma unroll
            for (int m = 0; m < 4; ++m)
#pragma unroll
                for (int n = 0; n < 2; ++n) acc[a][b][m][n] = (f32x4){0.f, 0.f, 0.f, 0.f};
    bf16x8 At[4][2], B0[2][2], B1[2][2];
    const char* cA = (const char*)g.A + (size_t)cur.pm * tstepA; const char* cB = (const char*)g.Bt + (size_t)cur.pn * tstepB;
    S.a_ready(cur);
    if constexpr (SP2) {
        PG8_STAGE(PG8_SB(0, 0), cB, voffB); PG8_STAGE(PG8_SB(0, 1), cB + hstepB, voffB); PG8_STAGE(PG8_SA(0, 0), cA, voffA); PG8_STAGE(PG8_SA(0, 1), cA + hstepA, voffA);
        if (wr == 1) PG8_BAR;
        PG8_WAIT_V(2); PG8_BAR;
        PG8_STAGE(PG8_SB(1, 0), cB + kstep, voffB); PG8_STAGE(PG8_SA(1, 0), cA + kstep, voffA); PG8_STAGE(PG8_SB(1, 1), cB + hstepB + kstep, voffB);
        PG8_WAIT_V(6); PG8_BAR;
    } else {
        PG8_STAGE(PG8_SB(0, 0), cB, voffB); PG8_STAGE(PG8_SA(0, 0), cA, voffA); PG8_STAGE(PG8_SB(0, 1), cB + hstepB, voffB); PG8_STAGE(PG8_SA(0, 1), cA + hstepA, voffA);
        if (wr == 1) PG8_BAR;
        PG8_WAIT_V(4); PG8_BAR;
        PG8_STAGE(PG8_SB(1, 0), cB + kstep, voffB); PG8_STAGE(PG8_SA(1, 0), cA + kstep, voffA); PG8_STAGE(PG8_SB(1, 1), cB + hstepB + kstep, voffB);
        PG8_WAIT_V(6); PG8_BAR;
    }
    for (;;) {
        const bool has_next = S.next(ui + 1, nxt);
        const char* nA = has_next ? (const char*)g.A + (size_t)nxt.pm * tstepA : cA; const char* nB = has_next ? (const char*)g.Bt + (size_t)nxt.pn * tstepB : cB;
        for (int t = 0; t < nt; t += 2) {
            const bool last = (t == nt - 2);
            const char* a1 = cA + (size_t)(t + 1) * kstep;
            const char* a2 = last ? nA : cA + (size_t)(t + 2) * kstep; const char* b2 = last ? nB : cB + (size_t)(t + 2) * kstep;
            const char* a3 = a2 + kstep; const char* b3 = b2 + kstep;
            if (last && has_next) S.a_ready(nxt);
            if constexpr (Epi::SEG) { if (t == E.seg1) E.rescale(acc, cur, wr, wc, fr, fq, 0); else if (t == E.seg2) E.rescale(acc, cur, wr, wc, fr, fq, 1); }
            if constexpr (SP2) {
            PG8_LDB(B0, 0, 0); PG8_LDB(B1, 0, 1); PG8_SCHED; PG8_LDA(At, 0, 0); PG8_STAGE(PG8_SA(1, 1), a1 + hstepA, voffA);
            PG8_WAIT_V(8); PG8_WAIT_L(0); PG8_BAR; PG8_MMA(0, 0, At, B0); PG8_MMA(0, 1, At, B1); PG8_BAR; PG8_SCHED;
            PG8_LDA(At, 0, 1); PG8_STAGE(PG8_SB(0, 0), b2, voffB); PG8_STAGE(PG8_SB(0, 1), b2 + hstepB, voffB); PG8_STAGE(PG8_SA(0, 0), a2, voffA);
            PG8_WAIT_V(8); PG8_WAIT_L(0); PG8_BAR; PG8_MMA(1, 0, At, B0); PG8_MMA(1, 1, At, B1); PG8_BAR; PG8_SCHED;
            PG8_LDB(B0, 1, 0); PG8_LDB(B1, 1, 1); PG8_SCHED; PG8_LDA(At, 1, 0); PG8_STAGE(PG8_SA(0, 1), a2 + hstepA, voffA);
            PG8_WAIT_V(8); PG8_WAIT_L(0); PG8_BAR; PG8_MMA(0, 0, At, B0); PG8_MMA(0, 1, At, B1); PG8_BAR; PG8_SCHED;
            PG8_LDA(At, 1, 1); PG8_STAGE(PG8_SB(1, 0), b3, voffB); PG8_STAGE(PG8_SB(1, 1), b3 + hstepB, voffB); PG8_STAGE(PG8_SA(1, 0), a3, voffA);
            PG8_WAIT_V(8); PG8_WAIT_L(0); PG8_BAR; PG8_MMA(1, 0, At, B0); PG8_MMA(1, 1, At, B1); PG8_BAR; PG8_SCHED;
            } else {
            PG8_LDB(B0, 0, 0); PG8_SCHED; PG8_LDA(At, 0, 0); PG8_STAGE(PG8_SA(1, 1), a1 + hstepA, voffA);
            PG8_WAIT_L(8); PG8_BAR; PG8_WAIT_L(0); PG8_MMA(0, 0, At, B0); PG8_BAR; PG8_SCHED;
            PG8_LDB(B1, 0, 1); PG8_STAGE(PG8_SB(0, 0), b2, voffB);
            PG8_BAR; PG8_WAIT_L(0); PG8_MMA(0, 1, At, B1); PG8_BAR;
            PG8_LDA(At, 0, 1); PG8_STAGE(PG8_SA(0, 0), a2, voffA);
            PG8_BAR; PG8_WAIT_L(0); PG8_MMA(1, 0, At, B0); PG8_BAR; PG8_SCHED;
            PG8_STAGE(PG8_SB(0, 1), b2 + hstepB, voffB);
            PG8_WAIT_V(6); PG8_BAR; PG8_MMA(1, 1, At, B1); PG8_BAR;
            PG8_LDB(B0, 1, 0); PG8_SCHED; PG8_LDA(At, 1, 0); PG8_STAGE(PG8_SA(0, 1), a2 + hstepA, voffA);
            PG8_WAIT_L(8); PG8_BAR; PG8_WAIT_L(0); PG8_MMA(0, 0, At, B0); PG8_BAR; PG8_SCHED;
            PG8_LDB(B1, 1, 1); PG8_STAGE(PG8_SB(1, 0), b3, voffB);
            PG8_BAR; PG8_WAIT_L(0); PG8_MMA(0, 1, At, B1); PG8_BAR;
            PG8_LDA(At, 1, 1); PG8_STAGE(PG8_SA(1, 0), a3, voffA);
            PG8_BAR; PG8_WAIT_L(0); PG8_MMA(1, 0, At, B0); PG8_BAR; PG8_SCHED;
            PG8_STAGE(PG8_SB(1, 1), b3 + hstepB, voffB);
            PG8_WAIT_V(6); PG8_BAR; PG8_MMA(1, 1, At, B1); PG8_BAR;
            }
        }
        if constexpr (ALIGN_EPI) { if (wr == 0) PG8_BAR; }
        if constexpr (!Epi::AFTER_DRAIN) { E(acc, cur, wr, wc, fr, fq); S.done(cur); }
        if (!has_next) break;
#pragma unroll
        for (int a = 0; a < 2; ++a)
#pragma unroll
            for (int b = 0; b < 2; ++b)
#pragma unroll
                for (int m = 0; m < 4; ++m)
#pragma unroll
                    for (int n = 0; n < 2; ++n) acc[a][b][m][n] = (f32x4){0.f, 0.f, 0.f, 0.f};
        cur = nxt; cA = nA; cB = nB; ++ui;
        if constexpr (ALIGN_EPI) { if (wr == 1) PG8_BAR; }
    }
    PG8_WAIT_V(0);
    if constexpr (!ALIGN_EPI) { if (wr == 0) PG8_BAR; }
    PG8_BAR;
    if constexpr (Epi::AFTER_DRAIN) { E.fused(acc, cur, wr, wc, fr, fq, lds, wid, lane); S.done(cur); }
#undef PG8_SA
#undef PG8_SB
#undef PG8_STAGE
#undef PG8_LDA
#undef PG8_LDB
#undef PG8_MMA
#undef PG8_WAIT_V
#undef PG8_WAIT_L
#undef PG8_BAR
#undef PG8_SCHED
}

}

typedef GAS unsigned gu32;
#define RLX_AGENT __ATOMIC_RELAXED, __HIP_MEMORY_SCOPE_AGENT
#define XB_TMO      128
#define XB_XCNT(j)  (256  + 64 * (j))
#define XB_XSUB(j)  (1280 + 64 * (j))
#define XB_XGEN(j)  (2304 + 64 * (j))
#define XB_TOP      3328
#define XB_TOPGEN   3392
#define XCD_BAR_WORDS 3456
#define XB_SPIN_CAP (1u << 18)

__device__ __forceinline__ unsigned xb_ld(unsigned* p)              { return __hip_atomic_load(p, __ATOMIC_RELAXED, __HIP_MEMORY_SCOPE_AGENT); }
__device__ __forceinline__ unsigned xb_add(unsigned* p, unsigned v) { return __hip_atomic_fetch_add(p, v, __ATOMIC_RELAXED, __HIP_MEMORY_SCOPE_AGENT); }
__device__ __forceinline__ unsigned xb_xcc_id() { return (unsigned)__builtin_amdgcn_s_getreg((3 << 11) | 20) & 0xFu; }
#define XB_SPIN(cond, bar) do { unsigned _sp = 0; while (cond) { __builtin_amdgcn_s_sleep(1); \
    if ((++_sp & 255u) == 0u) { if (xb_ld(&(bar)[XB_TMO])) break; if (_sp > XB_SPIN_CAP) { atomicAdd(&(bar)[XB_TMO], 1u); break; } } } } while (0)

struct XcdBarrier {
    unsigned* bar; unsigned x;
    volatile LAS unsigned* st;
};

__device__ __forceinline__ XcdBarrier xcd_barrier_post(unsigned* bar, volatile LAS unsigned* st) {
    XcdBarrier b; b.bar = bar; b.x = xb_xcc_id(); b.st = st;
    if (threadIdx.x == 0) (void)xb_add(&bar[XB_XCNT(b.x)], 1u);
    return b;
}
__device__ __forceinline__ void xcd_barrier_complete(unsigned* bar, unsigned x, unsigned& nloc, unsigned& nx) {
    const unsigned G = gridDim.x * gridDim.y * gridDim.z;
    unsigned sum, cnt, mine, sp = 0u;
    for (;;) {
        sum = 0u; cnt = 0u; mine = 0u;
#pragma unroll
        for (unsigned j = 0; j < 16; ++j) { const unsigned c = xb_ld(&bar[XB_XCNT(j)]); sum += c; cnt += (c > 0u) ? 1u : 0u; mine = (j == x) ? c : mine; }
        if (sum == G) break;
        __builtin_amdgcn_s_sleep(1);
        if ((++sp & 255u) == 0u) { if (xb_ld(&bar[XB_TMO])) break; if (sp > XB_SPIN_CAP) { atomicAdd(&bar[XB_TMO], 1u); break; } }
    }
    nloc = mine > 0u ? mine : 1u; nx = cnt > 0u ? cnt : 1u;
}

__device__ __forceinline__ void xcd_barrier(const XcdBarrier& b) {
    asm volatile("s_waitcnt vmcnt(0)" ::: "memory");
    __syncthreads();
    if (threadIdx.x == 0) {
        unsigned* bar = b.bar;
        __builtin_amdgcn_s_waitcnt(0);
        unsigned nloc = b.st[0], nx = b.st[1];
        if (nloc == 0u) { xcd_barrier_complete(bar, b.x, nloc, nx); b.st[0] = nloc; b.st[1] = nx; }
        const unsigned old = xb_add(&bar[XB_XSUB(b.x)], 1u);
        const unsigned gen = old / nloc;
        if (old + 1u == (gen + 1u) * nloc) {
            __builtin_amdgcn_fence(__ATOMIC_RELEASE, "agent");
            asm volatile("s_waitcnt vmcnt(0)" ::: "memory");
            const unsigned og = xb_add(&bar[XB_TOP], 1u);
            const unsigned tg = og / nx;
            if (og + 1u == (tg + 1u) * nx) xb_add(&bar[XB_TOPGEN], 1u);
            else XB_SPIN(xb_ld(&bar[XB_TOPGEN]) == tg, bar);
            __builtin_amdgcn_fence(__ATOMIC_ACQUIRE, "agent");
            xb_add(&bar[XB_XGEN(b.x)], 1u);
            asm volatile("s_waitcnt vmcnt(0)" ::: "memory");
        } else {
            XB_SPIN(xb_ld(&bar[XB_XGEN(b.x)]) == gen, bar);
            __builtin_amdgcn_fence(__ATOMIC_ACQUIRE, "agent");
            asm volatile("s_waitcnt vmcnt(0)" ::: "memory");
        }
    }
    __syncthreads();
}

#define LDS_WAIT() asm volatile("s_waitcnt lgkmcnt(0)" ::: "memory")
#define VM_WAIT() asm volatile("s_waitcnt vmcnt(0)" ::: "memory")
#define MFMA32 __builtin_amdgcn_mfma_f32_32x32x16_bf16
__device__ __forceinline__ float wave_sum(float v) {
#pragma unroll
    for (int o = 1; o < 64; o <<= 1) v += __shfl_xor(v, o);
    return v;
}
__device__ __forceinline__ float wave_max(float v) {
#pragma unroll
    for (int o = 1; o < 64; o <<= 1) v = fmaxf(v, __shfl_xor(v, o));
    return v;
}
__device__ __forceinline__ unsigned q8x4(const f32x4& y, float inv) {
    int a = __float2int_rn(y.x * inv), b = __float2int_rn(y.y * inv), c = __float2int_rn(y.z * inv), d = __float2int_rn(y.w * inv);
    a = a < -127 ? -127 : (a > 127 ? 127 : a); b = b < -127 ? -127 : (b > 127 ? 127 : b); c = c < -127 ? -127 : (c > 127 ? 127 : c); d = d < -127 ? -127 : (d > 127 ? 127 : d);
    return (unsigned)(a & 255) | ((unsigned)(b & 255) << 8) | ((unsigned)(c & 255) << 16) | ((unsigned)(d & 255) << 24);
}
__device__ __forceinline__ float amax4(const f32x4& y) { return fmaxf(fmaxf(fabsf(y.x), fabsf(y.y)), fmaxf(fabsf(y.z), fabsf(y.w))); }
__device__ __forceinline__ float swap_max(float m) { auto rr = __builtin_amdgcn_permlane32_swap(__float_as_uint(m), __float_as_uint(m), false, false); return fmaxf(__uint_as_float(rr[0]), __uint_as_float(rr[1])); }
__device__ __forceinline__ float swap_sum(float m) { auto rr = __builtin_amdgcn_permlane32_swap(__float_as_uint(m), __float_as_uint(m), false, false); return __uint_as_float(rr[0]) + __uint_as_float(rr[1]); }
__device__ __forceinline__ int crow(int r, int hi) { return (r & 3) + 8 * (r >> 2) + 4 * hi; }
__device__ __forceinline__ int t5_bucket(int dist) {
    if (dist < 16) return dist;
    int b = 16;
    b += (dist >= 19); b += (dist >= 21); b += (dist >= 24); b += (dist >= 27); b += (dist >= 31); b += (dist >= 35); b += (dist >= 40); b += (dist >= 46);
    b += (dist >= 52); b += (dist >= 59); b += (dist >= 67); b += (dist >= 77); b += (dist >= 87); b += (dist >= 99); b += (dist >= 113);
    return b;
}
__device__ __forceinline__ float gelu_tanh(float x) { const float u = 0.7978845608028654f * (x + 0.044715f * x * x * x); return x * __builtin_amdgcn_rcpf(1.0f + __builtin_amdgcn_exp2f(-2.0f * LOG2E * u)); }

__device__ __forceinline__ void tr_item(const float* W, int ldw, bf16* WT, int ldt, int kdst, LAS float* scr, int k0, int n0, int sc, int lane, unsigned* cmax) {
    float tv[32];
    const float* wp = W + (size_t)(k0 + (lane >> 5)) * ldw + (sc >= 0 ? sc : 0);
#pragma unroll
    for (int i = 0; i < 32; ++i) tv[i] = wp[(size_t)(2 * i) * ldw];
#pragma unroll
    for (int i = 0; i < 32; ++i) { const int kk = 2 * i + (lane >> 5); scr[kk * 33 + (lane & 31)] = sc >= 0 ? tv[i] : 0.f; }
    LDS_WAIT(); asm volatile("" ::: "memory");
    const int c = lane & 7;
#pragma unroll
    for (int j = 0; j < 4; ++j) { const int n = (lane >> 3) + 8 * j; const LAS float* s = scr + (8 * c) * 33 + n;
        u32x4 o; o.x = pk2(s[0 * 33], s[1 * 33]); o.y = pk2(s[2 * 33], s[3 * 33]); o.z = pk2(s[4 * 33], s[5 * 33]); o.w = pk2(s[6 * 33], s[7 * 33]);
        *(u32x4*)(WT + (size_t)(n0 + n) * ldt + kdst + k0 + 8 * c) = o;
        if (cmax) { float mx = fmaxf(fmaxf(fmaxf(bflo(o.x), bfhi(o.x)), fmaxf(bflo(o.y), bfhi(o.y))), fmaxf(fmaxf(bflo(o.z), bfhi(o.z)), fmaxf(bflo(o.w), bfhi(o.w))));
            float mn = fminf(fminf(fminf(bflo(o.x), bfhi(o.x)), fminf(bflo(o.y), bfhi(o.y))), fminf(fminf(bflo(o.z), bfhi(o.z)), fminf(bflo(o.w), bfhi(o.w))));
            mx = fmaxf(mx, -mn);
            mx = fmaxf(mx, __shfl_xor(mx, 1)); mx = fmaxf(mx, __shfl_xor(mx, 2)); mx = fmaxf(mx, __shfl_xor(mx, 4));
            if (c == 0) atomicMax(cmax + n0 + n, __float_as_uint(mx)); } }
    LDS_WAIT(); asm volatile("" ::: "memory");
}
__device__ __forceinline__ void tr_matrix(int kind, const float* W, const float* W2, int Ksrc, int ldw, int Ndst, bf16* WT, int ldt, int kdst, LAS float* scr, int gw, int NGW, int lane, unsigned* cmax) {
    const int nblk = Ndst / 32, nitems = (Ksrc / 64) * nblk;
    for (int it = gw; it < nitems; it += NGW) {
        const int kb = it / nblk, nb = it % nblk, n0 = 32 * nb, n = n0 + (lane & 31);
        const float* src = W; int sc = n;
        if (kind == 1) { sc = n < 1280 ? n : (n < 2304 ? n + 24 : (n < 2328 ? n - 1024 : (n < 2560 ? -1 : n - 232))); }
        else if (kind == 2) { const int pn = n >> 8, w = n & 255; if (w < 128) sc = 128 * pn + w; else { sc = 128 * pn + w - 128; src = W2; } }
        tr_item(src, ldw, WT, ldt, kdst, scr, 64 * kb, n0, sc, lane, cmax);
    }
}

template <int NR>
__device__ __forceinline__ void rms_rows_bf16(const float* const (&xrow)[NR], const float* g, bf16* const (&orow)[NR], int lane) {
    f32x4 v[NR][4];
#pragma unroll
    for (int r = 0; r < NR; ++r) { const f32x4* xr = (const f32x4*)xrow[r] + lane;
#pragma unroll
        for (int j = 0; j < 4; ++j) v[r][j] = xr[64 * j]; }
    const f32x4* gr = (const f32x4*)g + lane; f32x4 gv[4];
#pragma unroll
    for (int j = 0; j < 4; ++j) gv[j] = gr[64 * j];
#pragma unroll
    for (int r = 0; r < NR; ++r) { float s = 0.f;
#pragma unroll
        for (int j = 0; j < 4; ++j) s += (v[r][j].x * v[r][j].x + v[r][j].y * v[r][j].y) + (v[r][j].z * v[r][j].z + v[r][j].w * v[r][j].w);
        const float rs = rsqrtf(wave_sum(s) * (1.f / DM) + RMS_EPS);
        u32x2* o8 = (u32x2*)orow[r] + lane;
#pragma unroll
        for (int j = 0; j < 4; ++j) { u32x2 w; w.x = pk2(v[r][j].x * rs * gv[j].x, v[r][j].y * rs * gv[j].y); w.y = pk2(v[r][j].z * rs * gv[j].z, v[r][j].w * rs * gv[j].w); o8[64 * j] = w; } }
}
template <int NR>
__device__ __forceinline__ void rms_rows_i8(const float* const (&xrow)[NR], const float* g, unsigned char* const (&orow)[NR], float* const (&sap)[NR], int lane) {
    f32x4 v[NR][4];
#pragma unroll
    for (int r = 0; r < NR; ++r) { const f32x4* xr = (const f32x4*)xrow[r] + lane;
#pragma unroll
        for (int j = 0; j < 4; ++j) v[r][j] = xr[64 * j]; }
    const f32x4* gr = (const f32x4*)g + lane; f32x4 gv[4];
#pragma unroll
    for (int j = 0; j < 4; ++j) gv[j] = gr[64 * j];
#pragma unroll
    for (int r = 0; r < NR; ++r) { float s = 0.f;
#pragma unroll
        for (int j = 0; j < 4; ++j) s += (v[r][j].x * v[r][j].x + v[r][j].y * v[r][j].y) + (v[r][j].z * v[r][j].z + v[r][j].w * v[r][j].w);
        const float rs = rsqrtf(wave_sum(s) * (1.f / DM) + RMS_EPS);
        float am = 0.f;
#pragma unroll
        for (int j = 0; j < 4; ++j) { v[r][j] = v[r][j] * rs * gv[j]; am = fmaxf(am, amax4(v[r][j])); }
        am = wave_max(am); const float inv = am > 0.f ? 127.f / am : 0.f;
        unsigned* o4 = (unsigned*)orow[r] + lane;
#pragma unroll
        for (int j = 0; j < 4; ++j) o4[64 * j] = q8x4(v[r][j], inv);
        if (lane == 0) *sap[r] = am > 0.f ? am * (1.f / 127.f) : 1.f; }
}
template <int NR>
__device__ __forceinline__ void norm_res_norm(const bf16* const (&srow)[NR], const float* gA, const float* const (&xin)[NR], float* const (&xout)[NR], const float* gB, unsigned char* const (&hout)[NR], float* const (&sap)[NR], bool has_h, int lane) {
    u32x2 sw[NR][4]; f32x4 xv[NR][4];
#pragma unroll
    for (int r = 0; r < NR; ++r) { const u32x2* sr = (const u32x2*)srow[r] + lane; const f32x4* xi = (const f32x4*)xin[r] + lane;
#pragma unroll
        for (int j = 0; j < 4; ++j) { sw[r][j] = sr[64 * j]; xv[r][j] = xi[64 * j]; } }
    const f32x4* ga = (const f32x4*)gA + lane; f32x4 gav[4];
#pragma unroll
    for (int j = 0; j < 4; ++j) gav[j] = ga[64 * j];
#pragma unroll
    for (int r = 0; r < NR; ++r) { f32x4 v[4]; float s = 0.f;
#pragma unroll
        for (int j = 0; j < 4; ++j) { const u32x2 w = sw[r][j]; v[j] = (f32x4){bflo(w.x), bfhi(w.x), bflo(w.y), bfhi(w.y)}; s += (v[j].x * v[j].x + v[j].y * v[j].y) + (v[j].z * v[j].z + v[j].w * v[j].w); }
        const float rA = rsqrtf(wave_sum(s) * (1.f / DM) + RMS_EPS);
        f32x4* xo = (f32x4*)xout[r] + lane; float s2 = 0.f;
#pragma unroll
        for (int j = 0; j < 4; ++j) { v[j] = xv[r][j] + v[j] * rA * gav[j]; xo[64 * j] = v[j]; s2 += (v[j].x * v[j].x + v[j].y * v[j].y) + (v[j].z * v[j].z + v[j].w * v[j].w); }
        if (has_h) {
            const float rB = rsqrtf(wave_sum(s2) * (1.f / DM) + RMS_EPS);
            const f32x4* gb = (const f32x4*)gB + lane; unsigned* o4 = (unsigned*)hout[r] + lane; float am = 0.f;
#pragma unroll
            for (int j = 0; j < 4; ++j) { v[j] = v[j] * rB * gb[64 * j]; am = fmaxf(am, amax4(v[j])); }
            am = wave_max(am); const float inv = am > 0.f ? 127.f / am : 0.f;
#pragma unroll
            for (int j = 0; j < 4; ++j) o4[64 * j] = q8x4(v[j], inv);
            if (lane == 0) *sap[r] = am > 0.f ? am * (1.f / 127.f) : 1.f;
        } }
}

__device__ __forceinline__ void compress_unit(int u, LAS unsigned char* lds, const bf16* PA, const unsigned char* wl, bf16* KC, bf16* VC, int tid) {
    const int lane = tid & 63, wid = __builtin_amdgcn_readfirstlane(tid >> 6), r32 = lane & 31, hi = lane >> 5;
    const int half = u & 1, kv = (u >> 1) & 1, g = (u >> 2) & 1, b = u >> 3;
    const bf16* w1t = (const bf16*)(wl + (kv ? WL_W1V : WL_W1K));
    const bf16* w2t = (const bf16*)(wl + (kv ? WL_W2V : WL_W2K));
    const float* posb = (const float*)(wl + (kv ? WL_POSV : WL_POSK));
    const bf16* Asrc = PA + (size_t)b * SEQ * NPA + (kv ? PA_VC : PA_KC) + g * 64;
    bf16* Out = (kv ? VC : KC) + (size_t)((b * 2 + g) * 128) * 64;
    LAS bf16* H1 = (LAS bf16*)lds;
    {
        const int ctile = wid & 1, ntile = wid >> 1;
        const int c = 64 * half + 32 * ctile + r32;
        const bf16* wrow = w1t + (size_t)(32 * ntile + r32) * 2048 + 8 * hi;
        f32x16 acc = {};
        for (int jj = 0; jj < 32; ++jj) {
            int tok = 16 * c + jj; tok = tok > SEQ - 1 ? SEQ - 1 : tok;
            const bf16* arow = Asrc + (size_t)tok * NPA + 8 * hi;
#pragma unroll
            for (int q = 0; q < 4; ++q) {
                const bf16x8 af = *(const bf16x8*)(wrow + jj * 64 + q * 16);
                const bf16x8 bfr = *(const bf16x8*)(arow + q * 16);
                acc = MFMA32(af, bfr, acc, 0, 0, 0);
            }
        }
#pragma unroll
        for (int k4 = 0; k4 < 4; ++k4) { const int n0 = 32 * ntile + 8 * k4 + 4 * hi; const f32x4 pb = *(const f32x4*)(posb + n0);
            u32x2 w; w.x = pk2(gelu_tanh(acc[4 * k4 + 0] + pb.x), gelu_tanh(acc[4 * k4 + 1] + pb.y)); w.y = pk2(gelu_tanh(acc[4 * k4 + 2] + pb.z), gelu_tanh(acc[4 * k4 + 3] + pb.w));
            *(LAS u32x2*)(H1 + (32 * ctile + r32) * 136 + n0) = w; }
    }
    __syncthreads();
    if (wid < 4) {
        const int ct2 = wid & 1, dt = wid >> 1;
        f32x16 a2 = {};
#pragma unroll
        for (int ks = 0; ks < 8; ++ks) {
            const bf16x8 af = *(const bf16x8*)(w2t + (size_t)(32 * dt + r32) * 128 + 16 * ks + 8 * hi);
            const bf16x8 bfr = *(const LAS bf16x8*)(H1 + (32 * ct2 + r32) * 136 + 16 * ks + 8 * hi);
            a2 = MFMA32(af, bfr, a2, 0, 0, 0);
        }
#pragma unroll
        for (int k4 = 0; k4 < 4; ++k4) { u32x2 w; w.x = pk2(a2[4 * k4 + 0], a2[4 * k4 + 1]); w.y = pk2(a2[4 * k4 + 2], a2[4 * k4 + 3]);
            *(u32x2*)(Out + (size_t)(64 * half + 32 * ct2 + r32) * 64 + 32 * dt + 8 * k4 + 4 * hi) = w; }
    }
    __syncthreads();
}
__device__ __forceinline__ void kmean_unit(int b, int n, LAS unsigned char* lds, const bf16* PA, float* KMEAN, int tid) {
    const int chunk = tid & 31, tg = tid >> 5;
    const bf16* src = PA + ((size_t)b * SEQ + 256 * n + 16 * tg) * NPA + PA_KM + 8 * chunk;
    f32x4 s0 = {0.f, 0.f, 0.f, 0.f}, s1 = {0.f, 0.f, 0.f, 0.f};
#pragma unroll 4
    for (int t = 0; t < 16; ++t) { const u32x4 w = *(const u32x4*)(src + (size_t)t * NPA); f32x4 a, c; pg8::unpack8(w, a, c); s0 += a; s1 += c; }
    LAS float* red = (LAS float*)lds;
    *(LAS f32x4*)(red + tg * 256 + 8 * chunk) = s0; *(LAS f32x4*)(red + tg * 256 + 8 * chunk + 4) = s1;
    __syncthreads();
    if (tid < 256) { float s = 0.f;
#pragma unroll
        for (int t = 0; t < 16; ++t) s += red[t * 256 + tid];
        KMEAN[((size_t)(b * 4 + (tid >> 6)) * 8 + n) * 64 + (tid & 63)] = s * (1.f / 256.f); }
    __syncthreads();
}

__device__ __forceinline__ void glds16(const void* gsrc, unsigned lds_dst) { unsigned keep;
    asm volatile("s_mov_b32 %0, m0\n\ts_mov_b32 m0, %2\n\ts_nop 0\n\tglobal_load_lds_dwordx4 %1, off\n\ts_mov_b32 m0, %0" : "=&s"(keep) : "v"(gsrc), "s"(lds_dst) : "memory"); }
__device__ __forceinline__ void stage_kv(LAS unsigned char* buf, const bf16* kptr, const bf16* vptr, int pitch, int wid, int lane) {
    const int kkey = 8 * wid + (lane >> 3);
    const bf16* ks = kptr + (size_t)kkey * pitch + (((lane & 7) ^ ((kkey >> 1) & 7)) * 8);
    const bf16* vs = vptr + (size_t)(16 * (wid & 3) + (lane >> 2)) * pitch + (wid >> 2) * 32 + (lane & 3) * 8;
    const unsigned dst = (unsigned)__builtin_amdgcn_readfirstlane((int)(unsigned)(uintptr_t)buf + wid * 1024);
    glds16(ks, dst); glds16(vs, dst + 8192u);
}
typedef __bf16 bf16x2_t __attribute__((ext_vector_type(2)));
__device__ __forceinline__ unsigned cvtpk_s(float lo, float hi) { f32x2 v = {lo, hi}; bf16x2_t b = __builtin_convertvector(v, bf16x2_t); return __builtin_bit_cast(unsigned, b); }
__device__ __forceinline__ bf16x8 pack_p(const f32x16& p, int s) {
    u32x4 w; w.x = cvtpk_s(p[8 * s + 0], p[8 * s + 1]); w.y = cvtpk_s(p[8 * s + 2], p[8 * s + 3]); w.z = cvtpk_s(p[8 * s + 4], p[8 * s + 5]); w.w = cvtpk_s(p[8 * s + 6], p[8 * s + 7]);
    return __builtin_bit_cast(bf16x8, w);
}
__device__ __forceinline__ bf16x8 vfrag(const LAS unsigned char* p) {
    const s16x4 lo = __builtin_bit_cast(s16x4, __builtin_amdgcn_ds_read_tr16_b64_v4i16((LAS s16x4*)p));
    const s16x4 hi = __builtin_bit_cast(s16x4, __builtin_amdgcn_ds_read_tr16_b64_v4i16((LAS s16x4*)(p + 512)));
    return (bf16x8){lo[0], lo[1], lo[2], lo[3], hi[0], hi[1], hi[2], hi[3]};
}
#define RING_WAIT_BAR(n) do { asm volatile("s_waitcnt vmcnt(" #n ")" ::: "memory"); __builtin_amdgcn_s_barrier(); asm volatile("" ::: "memory"); } while (0)
#define RING_STEP_SYNC(j, ns) do { if ((j) + 1 < (ns)) RING_WAIT_BAR(2); else RING_WAIT_BAR(0); } while (0)
__device__ __forceinline__ float max3f(float a, float b, float c) { float r; asm("v_max3_f32 %0, %1, %2, %3" : "=v"(r) : "v"(a), "v"(b), "v"(c)); return r; }
#define LOADED4(q) asm volatile("" :: "v"((q)[0]), "v"((q)[1]), "v"((q)[2]), "v"((q)[3]))
#define LOADED1(x) asm volatile("" :: "v"(x))
struct WState { f32x16 o0, o1; float m, l; int first; };
typedef unsigned u32x8 __attribute__((ext_vector_type(8)));
struct OtPk { u32x8 a, b; };
__device__ __forceinline__ void ot_set(OtPk& t, const f32x16& o0, const f32x16& o1, float sc) {
#pragma unroll
    for (int i = 0; i < 8; ++i) { t.a[i] = cvtpk_s(o0[2 * i] * sc, o0[2 * i + 1] * sc); t.b[i] = cvtpk_s(o1[2 * i] * sc, o1[2 * i + 1] * sc); }
}
__device__ __forceinline__ void ot_add(OtPk& t, const f32x16& o0, const f32x16& o1, float sc) {
#pragma unroll
    for (int i = 0; i < 8; ++i) { t.a[i] = cvtpk_s(bflo(t.a[i]) + o0[2 * i] * sc, bfhi(t.a[i]) + o0[2 * i + 1] * sc); t.b[i] = cvtpk_s(bflo(t.b[i]) + o1[2 * i] * sc, bfhi(t.b[i]) + o1[2 * i + 1] * sc); }
}
__device__ __forceinline__ void ot_store(bf16* op, const OtPk& t) {
#pragma unroll
    for (int k4 = 0; k4 < 4; ++k4) { u32x2 w0 = {t.a[2 * k4], t.a[2 * k4 + 1]}, w1 = {t.b[2 * k4], t.b[2 * k4 + 1]}; *(u32x2*)(op + 8 * k4) = w0; *(u32x2*)(op + 32 + 8 * k4) = w1; }
}
__device__ __forceinline__ void ws_reset(WState& S) { S.o0 = f32x16{}; S.o1 = f32x16{}; S.m = 0.f; S.l = 0.f; S.first = 1; }
__device__ __forceinline__ void attn_qk(WState& S, const bf16x8 (&q)[4], const LAS unsigned char* buf, float cadd, bool near, const LAS float* nearp, int r32, int hi, bf16x8 (&pa)[4]) {
    const float ci = cadd - S.m;
    f32x16 p0, p1;
#pragma unroll
    for (int r = 0; r < 16; ++r) { p0[r] = ci; p1[r] = ci; }
    const LAS unsigned char* kb = buf + r32 * 128; const int ksw = (r32 >> 1) & 7;
#pragma unroll
    for (int ks = 0; ks < 4; ++ks) {
        const int ko = ((2 * ks + hi) ^ ksw) * 16;
        const bf16x8 k0f = *(const LAS bf16x8*)(kb + ko), k1f = *(const LAS bf16x8*)(kb + ko + 4096);
        p0 = MFMA32(k0f, q[ks], p0, 0, 0, 0); p1 = MFMA32(k1f, q[ks], p1, 0, 0, 0);
    }
    asm volatile("s_nop 15\n\ts_nop 7" : "+v"(p0), "+v"(p1));
    if (near) {
#pragma unroll
        for (int r = 0; r < 16; ++r) { const int c = (r & 3) + 8 * (r >> 2); p0[r] += nearp[63 - c]; }
        __builtin_amdgcn_sched_barrier(0);
#pragma unroll
        for (int r = 0; r < 16; ++r) { const int c = (r & 3) + 8 * (r >> 2); p1[r] += nearp[31 - c]; }
    }
    __builtin_amdgcn_sched_barrier(0);
    float rm = max3f(p0[0], p1[0], p0[1]), rm2 = max3f(p1[1], p0[2], p1[2]);
#pragma unroll
    for (int r = 3; r < 15; r += 2) { rm = max3f(rm, p0[r], p1[r]); rm2 = max3f(rm2, p0[r + 1], p1[r + 1]); }
    rm = max3f(rm, p0[15], p1[15]); rm = max3f(rm, rm2, rm2);
    rm = swap_max(rm);
    if (S.first || __any(rm > 5.0f)) {
        const float d = S.first ? rm : fmaxf(rm, 0.f);
        const float f = S.first ? 1.f : __builtin_amdgcn_exp2f(-d);
        S.m += d; S.first = 0; S.l *= f; S.o0 *= f; S.o1 *= f;
#pragma unroll
        for (int r = 0; r < 16; ++r) { p0[r] -= d; p1[r] -= d; }
    }
    float ls = 0.f;
#pragma unroll
    for (int r = 0; r < 16; ++r) { p0[r] = __builtin_amdgcn_exp2f(p0[r]); p1[r] = __builtin_amdgcn_exp2f(p1[r]); ls += p0[r] + p1[r]; }
    S.l += ls;
    pa[0] = pack_p(p0, 0); pa[1] = pack_p(p0, 1); pa[2] = pack_p(p1, 0); pa[3] = pack_p(p1, 1);
}
__device__ __forceinline__ void attn_pv(WState& S, const LAS unsigned char* buf, const bf16x8 (&pa)[4], int hi, int lane) {
    const LAS unsigned char* vb = buf + 8192 + ((lane >> 4) & 1) * 32 + (lane & 3) * 8 + (4 * hi + ((lane & 15) >> 2)) * 64;
#pragma unroll
    for (int s4 = 0; s4 < 4; ++s4) {
        const bf16x8 v0 = vfrag(vb + s4 * 1024), v1 = vfrag(vb + 4096 + s4 * 1024);
        S.o0 = MFMA32(v0, pa[s4], S.o0, 0, 0, 0); S.o1 = MFMA32(v1, pa[s4], S.o1, 0, 0, 0);
    }
}
#define STAG_LOOP(NS, ISSUE, QKBLOCK) do { bf16x8 pa[4]; int have = 0; (void)grpB; \
    _Pragma("unroll 1") for (int j = 0; j < (NS); ++j) { \
        RING_STEP_SYNC(j, NS); \
        if (j + 2 < (NS)) { ISSUE(j + 2); } \
        { QKBLOCK(j); } \
        if (have) attn_pv(S, kvb + (j % 3) * 16384, pa, hi, lane); have = 0; \
    } } while (0)

__device__ __forceinline__ void store_ot(bf16* op  , const f32x16& o0, const f32x16& o1) {
#pragma unroll
    for (int k4 = 0; k4 < 4; ++k4) {
        u32x2 w0, w1; w0.x = pk2(o0[4 * k4 + 0], o0[4 * k4 + 1]); w0.y = pk2(o0[4 * k4 + 2], o0[4 * k4 + 3]); w1.x = pk2(o1[4 * k4 + 0], o1[4 * k4 + 1]); w1.y = pk2(o1[4 * k4 + 2], o1[4 * k4 + 3]);
        *(u32x2*)(op + 8 * k4) = w0; *(u32x2*)(op + 32 + 8 * k4) = w1;
    }
}
__device__ __forceinline__ void attn_tables(LAS unsigned char* lds, const float* rel_bias, int tid) {
    LAS float* tab = (LAS float*)(lds + A_TAB);
    for (int e = tid; e < 20 * TABN; e += 512) { const int t = e / TABN, i = e % TABN, dist = i - 96, head = t < 8 ? t : t - 8; const bool win = t >= 8 && t < 16;
        float v = NEGB; if (dist >= 0 && !(win && dist >= 256)) { const int bk = dist >= 128 ? 31 : t5_bucket(dist); v = rel_bias[bk * 12 + head] * LOG2E; }
        tab[e] = v; }
    LAS float* ct = (LAS float*)(lds + A_CTAB);
    for (int e = tid; e < 8 * CTABN; e += 512) { const int hd = e / CTABN, i = e % CTABN; float v = NEGB;
        if (i >= 1 && i <= 129) { const int dist = i - 1; const int bk = dist >= 128 ? 31 : t5_bucket(dist); v = rel_bias[bk * 12 + hd] * LOG2E; }
        ct[e] = v; }
    __syncthreads();
}

__device__ __forceinline__ void nsa_unit(int b, int g, int qb, LAS unsigned char* lds, const bf16* PA, const bf16* KC, const bf16* VC, bf16* OC, int tid) {
    const int lane = tid & 63, wid = __builtin_amdgcn_readfirstlane(tid >> 6), r32 = lane & 31, hi = lane >> 5;
    const int hh = wid & 3, wq = wid >> 2, head = g * 4 + hh, tq0 = 64 * qb + 32 * wq;
    const size_t row = (size_t)b * SEQ + tq0 + r32;
    bf16x8 q[4];
    { const bf16* qp = PA + row * NPA + PA_QN + head * 64 + 8 * hi;
#pragma unroll
      for (int ks = 0; ks < 4; ++ks) q[ks] = *(const bf16x8*)(qp + 16 * ks); }
    const bf16* gp = PA + row * NPA + PA_GN + head * 3;
    const float g0 = bflo(gp[0]), g1 = bflo(gp[1]), g2 = bflo(gp[2]);
    const bf16* Kc = KC + (size_t)((b * 2 + g) * 128) * 64; const bf16* Vc = VC + (size_t)((b * 2 + g) * 128) * 64;
    const bf16* Ks = PA + (size_t)b * SEQ * NPA + PA_KS + g * 64; const bf16* Vs = PA + (size_t)b * SEQ * NPA + PA_VS + g * 64;
    const bf16* Kw = PA + (size_t)b * SEQ * NPA + PA_KW + g * 64; const bf16* Vw = PA + (size_t)b * SEQ * NPA + PA_VW + g * 64;
    LAS unsigned char* kvb = lds + A_KV; LAS unsigned char* cmpb = lds + A_CMP;
    const int nsel = qb + 1, nwin = qb + 1 < 5 ? qb + 1 : 5, ns = nsel + nwin;
#define NSA_ISSUE(j) do { const int j_ = (j); const bool w_ = j_ >= nsel; const int n_ = w_ ? qb - (j_ - nsel) : qb - j_; \
        stage_kv(kvb + (j_ % 3) * 16384, (w_ ? Kw : Ks) + (size_t)(64 * n_) * NPA, (w_ ? Vw : Vs) + (size_t)(64 * n_) * NPA, NPA, wid, lane); } while (0)
    stage_kv(cmpb, Kc, Vc, 64, wid, lane); stage_kv(cmpb + 16384, Kc + 64 * 64, Vc + 64 * 64, 64, wid, lane);
    NSA_ISSUE(0);
    if (ns > 1) { NSA_ISSUE(1); RING_WAIT_BAR(4); } else RING_WAIT_BAR(2);
    OtPk ot;
    {
        f32x16 sc[4];
#pragma unroll
        for (int ph = 0; ph < 4; ++ph) sc[ph] = f32x16{};
#pragma unroll
        for (int t = 0; t < 2; ++t) { const LAS unsigned char* kb = cmpb + t * 16384 + r32 * 128; const int ksw = (r32 >> 1) & 7;
#pragma unroll
            for (int ks = 0; ks < 4; ++ks) { const int ko = ((2 * ks + hi) ^ ksw) * 16; const bf16x8 k0f = *(const LAS bf16x8*)(kb + ko), k1f = *(const LAS bf16x8*)(kb + ko + 4096);
                sc[2 * t] = MFMA32(k0f, q[ks], sc[2 * t], 0, 0, 0); sc[2 * t + 1] = MFMA32(k1f, q[ks], sc[2 * t + 1], 0, 0, 0); } }
        __builtin_amdgcn_sched_barrier(0);
        const LAS float* ct = (const LAS float*)(lds + A_CTAB) + head * CTABN;
        const int E0 = tq0 + r32 - 31 - 64 * hi;
        float m = NEGB;
#pragma unroll
        for (int ph = 0; ph < 4; ++ph)
#pragma unroll
            for (int k4 = 0; k4 < 4; ++k4) { int base = E0 - 16 * (32 * ph + 8 * k4); asm volatile("" : "+v"(base));
#pragma unroll
                for (int i = 0; i < 4; ++i) { int dist = base - 16 * i; dist = dist < -1 ? -1 : (dist > 128 ? 128 : dist);
                    sc[ph][4 * k4 + i] += ct[dist + 1]; m = fmaxf(m, sc[ph][4 * k4 + i]); } }
        m = swap_max(m);
        const bool valid = m > -1e29f;
        float l = 0.f;
#pragma unroll
        for (int ph = 0; ph < 4; ++ph)
#pragma unroll
            for (int r = 0; r < 16; ++r) { const float e = valid ? __builtin_amdgcn_exp2f(sc[ph][r] - m) : 0.f; sc[ph][r] = e; l += e; }
        l = swap_sum(l);
        const float inv = valid ? 1.0f / l : 0.f;
#pragma unroll
        for (int ph = 0; ph < 4; ++ph) sc[ph] *= inv;
        {
            LAS float* impw = (LAS float*)(lds + A_IMP) + (hh * 64 + 32 * wq + r32) * 33;
            float prevhi = 0.f;
#pragma unroll
            for (int i = 0; i < 16; ++i) { const int ph = i >> 2, k = i & 3;
                const float av = sc[ph][4 * k] + sc[ph][4 * k + 1] + sc[ph][4 * k + 2] + 0.5f * sc[ph][4 * k + 3], bv = 0.5f * sc[ph][4 * k + 3];
                auto rr = __builtin_amdgcn_permlane32_swap(__float_as_uint(bv), __float_as_uint(bv), false, false);
                const float lo_i = __uint_as_float(rr[0]), hi_i = __uint_as_float(rr[1]);
                impw[2 * k + hi + 8 * ph] = av + (hi ? lo_i : prevhi); prevhi = hi_i; }
        }
        __builtin_amdgcn_sched_barrier(0);
        f32x16 o0 = f32x16{}, o1 = f32x16{};
#pragma unroll
        for (int ph = 0; ph < 4; ++ph)
#pragma unroll
            for (int s = 0; s < 2; ++s) { const bf16x8 pa = pack_p(sc[ph], s);
                const LAS unsigned char* vb = cmpb + (ph >> 1) * 16384 + 8192 + ((lane >> 4) & 1) * 32 + (lane & 3) * 8 + (4 * hi + ((lane & 15) >> 2)) * 64 + (2 * (ph & 1) + s) * 1024;
                const bf16x8 v0 = vfrag(vb), v1 = vfrag(vb + 4096);
                o0 = MFMA32(v0, pa, o0, 0, 0, 0); o1 = MFMA32(v1, pa, o1, 0, 0, 0); }
        ot_set(ot, o0, o1, g0);
    }
    __syncthreads();
    {
        const LAS float* impb = (const LAS float*)(lds + A_IMP); LAS float* scb = (LAS float*)(lds + A_SC); LAS unsigned* selb = (LAS unsigned*)(lds + A_SEL);
#pragma unroll 1
        for (int it = 0; it < 4; ++it) { const int e = tid + 512 * it, tok = e >> 5, n = e & 31;
            float s = (impb[(0 * 64 + tok) * 33 + n] + impb[(1 * 64 + tok) * 33 + n]) + (impb[(2 * 64 + tok) * 33 + n] + impb[(3 * 64 + tok) * 33 + n]);
            const bool forced = (n == 0) | (n == qb) | (n == qb - 1);
            s = forced ? 1e4f : (n <= qb ? s : NEGB);
            scb[tok * 33 + n] = s;
            LDS_WAIT();
            int rank = 0;
#pragma unroll 8
            for (int mm = 0; mm < 32; ++mm) { const float sm = scb[tok * 33 + mm]; rank += ((sm > s) | ((sm == s) & (mm < n))) ? 1 : 0; }
            const bool sel = (rank < 8) && (s > -5e29f);
            const unsigned long long bal = __ballot(sel);
            if ((lane & 31) == 0) selb[tok] = (unsigned)(bal >> (lane & 32));
        }
    }
    __syncthreads();
    const unsigned mymask = ((const LAS unsigned*)(lds + A_SEL))[32 * wq + r32];
    const LAS float* tabC = (const LAS float*)(lds + A_TAB) + head * TABN; const LAS float* tabW = (const LAS float*)(lds + A_TAB) + (8 + head) * TABN;
    const float cfar = tabC[96 + 128];
    WState S; ws_reset(S);
    LOADED4(q); LOADED1(g1); LOADED1(g2);
    const int grpB = wq;
#define NSA_QK(j) do { \
        if ((j) == nsel) { const float lt = swap_sum(S.l); ot_add(ot, S.o0, S.o1, g1 / lt); ws_reset(S); } \
        const bool win = (j) >= nsel; const int n = win ? qb - ((j) - nsel) : qb - (j); const int a = (tq0 - 64 * n) >> 5; \
        const LAS unsigned char* buf = kvb + ((j) % 3) * 16384; const int D0 = tq0 + r32 - 64 * n - 4 * hi; \
        if (!win) { const bool near = a < 6; const float cadd = (((mymask >> n) & 1u) ? 0.f : NEGB) + (near ? 0.f : cfar); attn_qk(S, q, buf, cadd, near, tabC + (D0 + 33), r32, hi, pa); have = 1; } \
        else if (a < 10) { const bool far = (a == 6) | (a == 7); attn_qk(S, q, buf, far ? cfar : 0.f, !far, tabW + (D0 + 33), r32, hi, pa); have = 1; } } while (0)
    STAG_LOOP(ns, NSA_ISSUE, NSA_QK);
#undef NSA_QK
    { const float lt = swap_sum(S.l); ot_add(ot, S.o0, S.o1, g2 / lt); }
    ot_store(OC + row * DM + head * 64 + 4 * hi, ot);
    __syncthreads();
#undef NSA_ISSUE
}

__device__ __forceinline__ void moba_unit(int b, int h, int ob, LAS unsigned char* lds, const bf16* PA, const float* KMEAN, bf16* OC, int tid) {
    const int lane = tid & 63, wid = __builtin_amdgcn_readfirstlane(tid >> 6), r32 = lane & 31, hi = lane >> 5;
    const int tq0 = 256 * ob + 32 * wid;
    const size_t row = (size_t)b * SEQ + tq0 + r32;
    bf16x8 q[4];
    { const bf16* qp = PA + row * NPA + PA_QM + h * 64 + 8 * hi;
#pragma unroll
      for (int ks = 0; ks < 4; ++ks) q[ks] = *(const bf16x8*)(qp + 16 * ks); }
    const bf16* Km = PA + (size_t)b * SEQ * NPA + PA_KM + h * 64; const bf16* Vm = PA + (size_t)b * SEQ * NPA + PA_VM + h * 64;
    LAS unsigned char* kvb = lds + A_KV;
    const int ns = 4 * (ob + 1);
#define MOBA_ISSUE(j) do { const int j_ = (j); const int n_ = ns - 1 - j_; stage_kv(kvb + (j_ % 3) * 16384, Km + (size_t)(64 * n_) * NPA, Vm + (size_t)(64 * n_) * NPA, NPA, wid, lane); } while (0)
    MOBA_ISSUE(0); MOBA_ISSUE(1);
    LAS float* km = (LAS float*)(lds + A_KMEAN); LAS float* mg = (LAS float*)(lds + A_MG);
    km[tid] = KMEAN[(size_t)(b * 4 + h) * 512 + tid];
    __syncthreads();
    {
        const int tok = tid >> 1, hf = tid & 1; const bf16* qrow = PA + ((size_t)b * SEQ + 256 * ob + tok) * NPA + PA_QM + h * 64;
        f32x4 acc = {0.f, 0.f, 0.f, 0.f};
#pragma unroll 1
        for (int c8 = 0; c8 < 8; ++c8) { const u32x4 w = *(const u32x4*)(qrow + 8 * c8); f32x4 qa, qb_; pg8::unpack8(w, qa, qb_);
#pragma unroll
            for (int i = 0; i < 4; ++i) { const LAS float* kp = km + (4 * hf + i) * 64 + 8 * c8; const f32x4 ka = *(const LAS f32x4*)kp, kb = *(const LAS f32x4*)(kp + 4);
                acc[i] += (qa.x * ka.x + qa.y * ka.y) + (qa.z * ka.z + qa.w * ka.w) + (qb_.x * kb.x + qb_.y * kb.y) + (qb_.z * kb.z + qb_.w * kb.w); } }
        *(LAS f32x4*)(mg + tok * 8 + 4 * hf) = acc;
    }
    __syncthreads();
    unsigned mymask = 0u;
    { const LAS float* gp = mg + (32 * wid + r32) * 8; const f32x4 ga = *(const LAS f32x4*)gp, gb = *(const LAS f32x4*)(gp + 4);
      const float gt[8] = {ga.x, ga.y, ga.z, ga.w, gb.x, gb.y, gb.z, gb.w};
#pragma unroll
      for (int n = 0; n < 8; ++n) { int rank = 0;
#pragma unroll
          for (int mm = 0; mm < 8; ++mm) rank += ((mm < ob) & ((gt[mm] > gt[n]) | ((gt[mm] == gt[n]) & (mm < n)))) ? 1 : 0;
          if ((n < ob) & (rank < 3)) mymask |= 1u << n; } }
    const LAS float* tabM = (const LAS float*)(lds + A_TAB) + (16 + h) * TABN;
    const float cfar = tabM[96 + 128];
    WState S; ws_reset(S);
    LOADED4(q);
    const int grpB = wid >> 2;
#define MOBA_QK(j) do { const int n = ns - 1 - (j), blk = n >> 2; \
        if (tq0 + 31 - 64 * n >= 0) { const int a = (tq0 - 64 * n) >> 5; const bool near = a < 6; float cadd = near ? 0.f : cfar; \
            if (blk < ob) cadd += ((mymask >> blk) & 1u) ? 0.f : NEGB; \
            const int D0 = tq0 + r32 - 64 * n - 4 * hi; \
            attn_qk(S, q, kvb + ((j) % 3) * 16384, cadd, near, tabM + (D0 + 33), r32, hi, pa); have = 1; } } while (0)
    STAG_LOOP(ns, MOBA_ISSUE, MOBA_QK);
#undef MOBA_QK
    { const float lt = swap_sum(S.l); const float scl = 1.0f / lt; S.o0 *= scl; S.o1 *= scl; }
    store_ot(OC + row * DM + 512 + h * 64 + 4 * hi, S.o0, S.o1);
    __syncthreads();
#undef MOBA_ISSUE
}

__device__ __forceinline__ void mem_unit(int b, int h, int tb, LAS unsigned char* lds, const bf16* PA, const bf16* MKV, bf16* OC, int tid) {
    const int lane = tid & 63, wid = __builtin_amdgcn_readfirstlane(tid >> 6), r32 = lane & 31, hi = lane >> 5;
    const int tq0 = 256 * tb + 32 * wid;
    const size_t row = (size_t)b * SEQ + tq0 + r32;
    bf16x8 q[4];
    { const bf16* qp = PA + row * NPA + PA_QX + h * 64 + 8 * hi;
#pragma unroll
      for (int ks = 0; ks < 4; ++ks) q[ks] = *(const bf16x8*)(qp + 16 * ks); }
    const bf16* Kx = MKV + (size_t)b * MEML * 512 + h * 64; const bf16* Vx = Kx + 256;
    LAS unsigned char* kvb = lds + A_KV;
    stage_kv(kvb, Kx, Vx, 512, wid, lane); stage_kv(kvb + 16384, Kx + (size_t)64 * 512, Vx + (size_t)64 * 512, 512, wid, lane);
    WState S; ws_reset(S);
    LOADED4(q);
    const int grpB = wid >> 2;
#define MEM_ISSUE(j) stage_kv(kvb + ((j) % 3) * 16384, Kx + (size_t)(64 * (j)) * 512, Vx + (size_t)(64 * (j)) * 512, 512, wid, lane)
#define MEM_QK(j) do { attn_qk(S, q, kvb + ((j) % 3) * 16384, 0.f, false, (const LAS float*)(lds + A_TAB), r32, hi, pa); have = 1; } while (0)
    STAG_LOOP(4, MEM_ISSUE, MEM_QK);
#undef MEM_QK
#undef MEM_ISSUE
    { const float lt = swap_sum(S.l); const float scl = 1.0f / lt; S.o0 *= scl; S.o1 *= scl; }
    store_ot(OC + row * DM + 768 + h * 64 + 4 * hi, S.o0, S.o1);
    __syncthreads();
}

#ifndef MK_MULTI_LAUNCH
#define MK_MULTI_LAUNCH 0
#endif
constexpr int N_PHASES = 20;
__device__ __forceinline__ int lane_now() { unsigned z = 0u; asm volatile("" : "+s"(z)); return (int)__builtin_amdgcn_mbcnt_hi(~0u, __builtin_amdgcn_mbcnt_lo(~0u, z)); }
struct Args { const float* in[23]; float* out; unsigned char* ws; int ph_lo, ph_hi; };

__global__ void __launch_bounds__(512, 2) fwd_kernel(Args args) {
    extern __shared__ __attribute__((aligned(16))) unsigned char lds_raw[];
    LAS unsigned char* lds = (LAS unsigned char*)lds_raw;
    volatile LAS unsigned* MISC = (volatile LAS unsigned*)(lds + MISC_OFF);
    const int wave = __builtin_amdgcn_readfirstlane((int)threadIdx.x >> 6);
#define TID_NOW (wave * 64 + lane_now())
    const int G = gridDim.x, bx_k = blockIdx.x; const int vcu_k = (G % 8 == 0) ? (bx_k % 8) * (G / 8) + bx_k / 8 : bx_k;
    unsigned* ctl = (unsigned*)(args.ws + WS_CTL);
    for (int u = threadIdx.x; u < (LDS_BYTES - MISC_OFF) / 4; u += 512) MISC[u] = 0u;
    __syncthreads();
    const int lo = args.ph_lo, hi = args.ph_hi;
    XcdBarrier bar; bar.bar = ctl + CW_BAR; bar.x = 0; bar.st = nullptr;
    if (hi - lo > 1) bar = xcd_barrier_post(ctl + CW_BAR, MISC + 8);
#ifndef ATT_EN
#define ATT_EN 7
#endif
#ifndef REP_J
#define REP_J -1
#endif
#define NREP(j) ((REP_J) == (j) ? 2 : 1)
#ifndef PHMASK
#define PHMASK 0x3ff
#endif
#define IN(k) (lo <= (k) && (k) < hi)
#define INJ(j) (((PHMASK >> ((j) + 1)) & 1) && IN(pb + (j)))
#define SEAM(k) do { if (IN(k) && IN((k) + 1)) xcd_barrier(bar); } while (0)
    typedef const __attribute__((address_space(4))) unsigned char* kaptr_t;
#define KA_DECL kaptr_t ka = (kaptr_t)__builtin_amdgcn_kernarg_segment_ptr(); int bx = bx_k, vcu = vcu_k, gw = gw_k; asm volatile("" : "+s"(ka), "+s"(bx), "+s"(vcu), "+s"(gw)); unsigned char* ws = *(unsigned char* const __attribute__((address_space(4)))*)(ka + 192)
#define KIN(i) (*(const float* const __attribute__((address_space(4)))*)(ka + 8 * (i)))
#define KOUT (*(float* const __attribute__((address_space(4)))*)(ka + 184))
    const int gw_k = vcu_k * 8 + wave, NGW = G * 8;

    if ((PHMASK & 1) && IN(0)) for (int rep_ = 0; rep_ < ((REP_J) == 100 ? 2 : 1); ++rep_) {
        const int lane = TID_NOW & 63;
        KA_DECL; const float* x_in = KIN(0); const float* mem_in = KIN(1); const float* pre_mix_g = KIN(3); const float* mem_norm_g = KIN(4); bf16* MEMN = (bf16*)KOUT; unsigned char* H8 = ws + WS_H; float* SA = (float*)(ws + WS_SA); unsigned* CMAX = (unsigned*)(ws + WS_CTL) + CW_CMAX;
        LAS float* scr = (LAS float*)(lds + wave * 16384);
        if ((gw & 7) == 0 && (gw >> 3) < 8) {
            const int t = gw >> 3, l = t >> 2, kv = (t >> 1) & 1, nh = t & 1, n = 64 * nh + lane;
            const float* pos = KIN(kv ? 10 : 7) + (size_t)l * 2048; const float* w1 = KIN(kv ? 11 : 8) + (size_t)l * 2048 * 128;
            float acc = 0.f;
#pragma unroll 8
            for (int k = 0; k < 2048; ++k) acc += pos[k] * w1[(size_t)k * 128 + n];
            ((float*)(ws + WS_W + l * WL_STRIDE + (kv ? WL_POSV : WL_POSK)))[n] = acc;
        }
        for (int l = 0; l < 2; ++l) {
            unsigned char* wl = ws + WS_W + l * WL_STRIDE;
#pragma unroll 1
            for (int mi = 0; mi < 12; ++mi) {
                int kind = 0, Ksrc = 0, ldw = 0, Ndst = 0, ldt = 0, kdst = 0; const float* W = nullptr; const float* W2 = nullptr; bf16* WT = nullptr;
                switch (mi) {
                    case 0: kind = 1; W = KIN(6) + (size_t)l * 1024 * INW; Ksrc = 1024; ldw = INW; Ndst = NIN; WT = (bf16*)(wl + WL_IN); ldt = 1024; break;
                    case 1: kind = 2; W = KIN(20) + (size_t)l * 1024 * DFF; W2 = KIN(21) + (size_t)l * 1024 * DFF; Ksrc = 1024; ldw = DFF; Ndst = NGU; WT = (bf16*)(wl + WL_GU); ldt = 1024; break;
                    case 2: W = KIN(22) + (size_t)l * DFF * 1024; Ksrc = DFF; ldw = 1024; Ndst = 1024; WT = (bf16*)(wl + WL_DN); ldt = DFF; break;
                    case 3: W = KIN(14) + (size_t)l * 512 * 1024; Ksrc = 512; ldw = 1024; Ndst = 1024; WT = (bf16*)(wl + WL_BR); ldt = 1024; kdst = 0; break;
                    case 4: W = KIN(15) + (size_t)l * 256 * 1024; Ksrc = 256; ldw = 1024; Ndst = 1024; WT = (bf16*)(wl + WL_BR); ldt = 1024; kdst = 512; break;
                    case 5: W = KIN(16) + (size_t)l * 256 * 1024; Ksrc = 256; ldw = 1024; Ndst = 1024; WT = (bf16*)(wl + WL_BR); ldt = 1024; kdst = 768; break;
                    case 6: W = KIN(17) + (size_t)l * 1024 * 1024; Ksrc = 1024; ldw = 1024; Ndst = 1024; WT = (bf16*)(wl + WL_MIX); ldt = 1024; break;
                    case 7: W = KIN(13) + (size_t)l * 1024 * 512; Ksrc = 1024; ldw = 512; Ndst = 512; WT = (bf16*)(wl + WL_MKV); ldt = 1024; break;
                    case 8: W = KIN(8) + (size_t)l * 2048 * 128; Ksrc = 2048; ldw = 128; Ndst = 128; WT = (bf16*)(wl + WL_W1K); ldt = 2048; break;
                    case 9: W = KIN(11) + (size_t)l * 2048 * 128; Ksrc = 2048; ldw = 128; Ndst = 128; WT = (bf16*)(wl + WL_W1V); ldt = 2048; break;
                    case 10: W = KIN(9) + (size_t)l * 128 * 64; Ksrc = 128; ldw = 64; Ndst = 64; WT = (bf16*)(wl + WL_W2K); ldt = 128; break;
                    default: W = KIN(12) + (size_t)l * 128 * 64; Ksrc = 128; ldw = 64; Ndst = 64; WT = (bf16*)(wl + WL_W2V); ldt = 128; break;
                }
                tr_matrix(kind, W, W2, Ksrc, ldw, Ndst, WT, ldt, kdst, scr, gw, NGW, lane, mi < 2 ? CMAX + (l * 2 + mi) * NIN : (unsigned*)nullptr);
            }
        }
        for (int m0 = 4 * gw; m0 < 2 * NMEM; m0 += 4 * NGW) { const int l = m0 / NMEM, r = m0 % NMEM;
            const float* xr[4] = {mem_in + (size_t)r * DM, mem_in + (size_t)(r + 1) * DM, mem_in + (size_t)(r + 2) * DM, mem_in + (size_t)(r + 3) * DM};
            bf16* orow[4] = {MEMN + (size_t)m0 * DM, MEMN + (size_t)(m0 + 1) * DM, MEMN + (size_t)(m0 + 2) * DM, MEMN + (size_t)(m0 + 3) * DM};
            rms_rows_bf16<4>(xr, mem_norm_g + l * DM, orow, lane); }
        for (int m0 = 4 * gw; m0 < NTOK; m0 += 4 * NGW) {
            const float* xr[4] = {x_in + (size_t)m0 * DM, x_in + (size_t)(m0 + 1) * DM, x_in + (size_t)(m0 + 2) * DM, x_in + (size_t)(m0 + 3) * DM};
            unsigned char* orow[4] = {H8 + (size_t)m0 * DM, H8 + (size_t)(m0 + 1) * DM, H8 + (size_t)(m0 + 2) * DM, H8 + (size_t)(m0 + 3) * DM};
            float* sap[4] = {SA + m0, SA + m0 + 1, SA + m0 + 2, SA + m0 + 3};
            rms_rows_i8<4>(xr, pre_mix_g, orow, sap, lane); }
    }
    SEAM(0);
    if ((PHMASK & 1) && IN(1)) {
        const int lane = TID_NOW & 63;
        KA_DECL; const unsigned* CMAX = (const unsigned*)(ws + WS_CTL) + CW_CMAX;
        for (int r = gw; r < 4 * NIN; r += NGW) { const int lm = r / NIN, n = r % NIN, l = lm >> 1, mat = lm & 1;
            unsigned char* wl = ws + WS_W + l * WL_STRIDE; unsigned char* rowp = wl + (mat ? WL_GU : WL_IN) + (size_t)n * 2048;
            const u32x4 w0 = *((const u32x4*)rowp + 2 * lane), w1 = *((const u32x4*)rowp + 2 * lane + 1);
            const float am = __uint_as_float(CMAX[r]); const float inv = am > 0.f ? 127.f / am : 0.f;
            f32x4 a, b, c, d; pg8::unpack8(w0, a, b); pg8::unpack8(w1, c, d);
            u32x4 o; o.x = q8x4(a, inv); o.y = q8x4(b, inv); o.z = q8x4(c, inv); o.w = q8x4(d, inv);
            asm volatile("" ::: "memory");
            *((u32x4*)rowp + lane) = o;
            if (lane == 0) ((float*)(wl + (mat ? WL_SBGU : WL_SBIN)))[n] = am > 0.f ? am * (1.f / 127.f) : 1.f; }
    }
    SEAM(1);

#pragma unroll 1
    for (int l = 0; l < 2; ++l) {
        const int pb = 2 + 9 * l;
        if (INJ(0)) for (int rep_ = 0; rep_ < NREP(0); ++rep_) {
            KA_DECL; unsigned char* wl = ws + WS_W + l * WL_STRIDE; bf16* H = (bf16*)(ws + WS_H); bf16* PA = (bf16*)(ws + WS_PA); bf16* GT = (bf16*)(ws + WS_GT); bf16* MEMN = (bf16*)KOUT; bf16* MEMKV = (bf16*)(ws + WS_MEMKV);
            { pg8::Gemm g{H, (const bf16*)(wl + WL_IN), NTOK, NIN, 512, 512, 1024}; pg8::StaticOrder S; S.init(NTOK, NIN, G, bx);
              pg8::EpiProj E{PA, GT, (const float*)(ws + WS_SA), (const float*)(wl + WL_SBIN)}; pg8::gemm_phase<pg8::EpiProj, pg8::StaticOrder, true, true, true>(lds, g, S, E, wave); }
            if (l == 0) {
#pragma unroll 1
                for (int l2 = 0; l2 < 2; ++l2) { pg8::Gemm g{MEMN + (size_t)l2 * NMEM * DM, (const bf16*)(ws + WS_W + l2 * WL_STRIDE + WL_MKV), NMEM, 512, 1024, 1024, 1024};
                    pg8::StaticOrder S; S.init(NMEM, 512, G, bx); pg8::EpiPlain E{MEMKV + (size_t)l2 * NMEM * 512, 512};
                    pg8::gemm_phase<pg8::EpiPlain, pg8::StaticOrder, true, true>(lds, g, S, E, wave); }
            }
        }
        SEAM(pb + 0);
        if (INJ(1)) for (int rep_ = 0; rep_ < NREP(1); ++rep_) {
            int tid_p = TID_NOW; asm volatile("" : "+v"(tid_p));
            KA_DECL; unsigned char* wl = ws + WS_W + l * WL_STRIDE; bf16* PA = (bf16*)(ws + WS_PA); bf16* KC = (bf16*)(ws + WS_KC); bf16* VC = (bf16*)(ws + WS_VC); float* KMEAN = (float*)(ws + WS_KMEAN);
            for (int u = bx; u < 256; u += G) {
                if (u < 128) compress_unit(u, lds, PA, wl, KC, VC, tid_p);
                else kmean_unit((u - 128) >> 3, (u - 128) & 7, lds, PA, KMEAN, tid_p);
            }
        }
        SEAM(pb + 1);
        if (INJ(2)) for (int rep_ = 0; rep_ < NREP(2); ++rep_) {
            int tid_p = TID_NOW; asm volatile("" : "+v"(tid_p));
            KA_DECL; const float* rel_bias = KIN(2); bf16* H = (bf16*)(ws + WS_H); bf16* PA = (bf16*)(ws + WS_PA); bf16* KC = (bf16*)(ws + WS_KC); bf16* VC = (bf16*)(ws + WS_VC); float* KMEAN = (float*)(ws + WS_KMEAN); bf16* MEMKV = (bf16*)(ws + WS_MEMKV);
            attn_tables(lds, rel_bias, tid_p);
            if (ATT_EN & 1) for (int rp_ = 0; rp_ < ((REP_J) == 20 ? 2 : 1); ++rp_)
#pragma unroll 1
            for (int P = vcu; P < 512; P += G) { const int bg = P >> 4, s = P & 15;
#pragma unroll 1
                for (int k = 0; k < 2; ++k) nsa_unit(bg >> 1, bg & 1, k ? 31 - s : s, lds, PA, KC, VC, H, tid_p); }
            if (ATT_EN & 2) for (int rp_ = 0; rp_ < ((REP_J) == 21 ? 2 : 1); ++rp_)
#pragma unroll 1
            for (int M = vcu; M < 256; M += G) { const int bh = M >> 2, s = M & 3;
#pragma unroll 1
                for (int k = 0; k < 2; ++k) moba_unit(bh >> 2, bh & 3, k ? 7 - s : s, lds, PA, KMEAN, H, tid_p); }
            if (ATT_EN & 4) for (int rp_ = 0; rp_ < ((REP_J) == 22 ? 2 : 1); ++rp_)
#pragma unroll 1
            for (int u = vcu; u < 512; u += G) { const int bh = u >> 3; mem_unit(bh >> 2, bh & 3, u & 7, lds, PA, MEMKV + (size_t)l * NMEM * 512, H, tid_p); }
        }
        SEAM(pb + 2);
        if (INJ(3)) for (int rep_ = 0; rep_ < NREP(3); ++rep_) {
            KA_DECL; unsigned char* wl = ws + WS_W + l * WL_STRIDE; bf16* H = (bf16*)(ws + WS_H); bf16* MERGED = (bf16*)(ws + WS_PA); bf16* GT = (bf16*)(ws + WS_GT);
#pragma unroll 1
            for (int br = 0; br < 3; ++br) { const int koff = br == 0 ? 0 : (br == 1 ? 512 : 768), K = br == 0 ? 512 : 256;
                pg8::Gemm g{H + koff, (const bf16*)(wl + WL_BR) + koff, NTOK, 1024, K, 1024, 1024}; pg8::StaticOrder S; S.init(NTOK, 1024, G, bx);
                pg8::EpiMerge E{MERGED, 1024, GT + br * 1024, NGT, br == 0 ? 1 : 0};
                pg8::gemm_phase<pg8::EpiMerge, pg8::StaticOrder, true, true>(lds, g, S, E, wave);
                VM_WAIT(); __syncthreads(); }
        }
        SEAM(pb + 3);
        if (INJ(4)) for (int rep_ = 0; rep_ < NREP(4); ++rep_) {
            KA_DECL; unsigned char* wl = ws + WS_W + l * WL_STRIDE; bf16* MERGED = (bf16*)(ws + WS_PA); bf16* YB = (bf16*)(ws + WS_GT);
            pg8::Gemm g{MERGED, (const bf16*)(wl + WL_MIX), NTOK, 1024, 1024, 1024, 1024}; pg8::StaticOrder S; S.init(NTOK, 1024, G, bx);
            pg8::EpiPlain E{YB, 1024}; pg8::gemm_phase<pg8::EpiPlain, pg8::StaticOrder, true, true>(lds, g, S, E, wave);
        }
        SEAM(pb + 4);
        if (INJ(5)) for (int rep_ = 0; rep_ < (((REP_J) == 5 && l == 0) ? 2 : 1); ++rep_) {
            int lane_p = TID_NOW & 63; asm volatile("" : "+v"(lane_p));
            KA_DECL; float* xres = KOUT; const float* post_mix_g = KIN(5); const float* pre_ffn_g = KIN(18); bf16* YB = (bf16*)(ws + WS_GT); unsigned char* H8 = ws + WS_H; float* SA = (float*)(ws + WS_SA);
            const float* xin = l == 0 ? KIN(0) : xres;
            for (int m0 = 2 * gw; m0 < NTOK; m0 += 2 * NGW) {
                const bf16* sr[2] = {YB + (size_t)m0 * DM, YB + (size_t)(m0 + 1) * DM}; const float* xi[2] = {xin + (size_t)m0 * DM, xin + (size_t)(m0 + 1) * DM};
                float* xo[2] = {xres + (size_t)m0 * DM, xres + (size_t)(m0 + 1) * DM}; unsigned char* ho[2] = {H8 + (size_t)m0 * DM, H8 + (size_t)(m0 + 1) * DM}; float* sap[2] = {SA + m0, SA + m0 + 1};
                norm_res_norm<2>(sr, post_mix_g + l * DM, xi, xo, pre_ffn_g + l * DM, ho, sap, true, lane_p); }
        }
        SEAM(pb + 5);
        if (INJ(6)) for (int rep_ = 0; rep_ < NREP(6); ++rep_) {
            KA_DECL; unsigned char* wl = ws + WS_W + l * WL_STRIDE; bf16* H = (bf16*)(ws + WS_H); bf16* UB = (bf16*)(ws + WS_GT);
            pg8::Gemm g{H, (const bf16*)(wl + WL_GU), NTOK, NGU, 512, 512, 1024}; pg8::StaticOrder S; S.init(NTOK, NGU, G, bx);
            pg8::EpiSwiGLU E{UB, DFF, (const float*)(ws + WS_SA), (const float*)(wl + WL_SBGU)}; pg8::gemm_phase<pg8::EpiSwiGLU, pg8::StaticOrder, true, true, true>(lds, g, S, E, wave);
        }
        SEAM(pb + 6);
        if (INJ(7)) for (int rep_ = 0; rep_ < NREP(7); ++rep_) {
            KA_DECL; unsigned char* wl = ws + WS_W + l * WL_STRIDE; bf16* UB = (bf16*)(ws + WS_GT); bf16* FB = (bf16*)(ws + WS_PA);
            pg8::Gemm g{UB, (const bf16*)(wl + WL_DN), NTOK, 1024, DFF, DFF, DFF}; pg8::StaticOrder S; S.init(NTOK, 1024, G, bx);
            pg8::EpiPlain E{FB, 1024}; pg8::gemm_phase<pg8::EpiPlain, pg8::StaticOrder, true, true>(lds, g, S, E, wave);
        }
        SEAM(pb + 7);
        if (INJ(8)) {
            int lane_p = TID_NOW & 63; asm volatile("" : "+v"(lane_p));
            KA_DECL; float* xres = KOUT; const float* post_ffn_g = KIN(19); const float* pre_mix_g = KIN(3); bf16* FB = (bf16*)(ws + WS_PA); unsigned char* H8 = ws + WS_H; float* SA = (float*)(ws + WS_SA);
            for (int m0 = 2 * gw; m0 < NTOK; m0 += 2 * NGW) {
                const bf16* sr[2] = {FB + (size_t)m0 * DM, FB + (size_t)(m0 + 1) * DM}; const float* xi[2] = {xres + (size_t)m0 * DM, xres + (size_t)(m0 + 1) * DM};
                float* xo[2] = {xres + (size_t)m0 * DM, xres + (size_t)(m0 + 1) * DM}; unsigned char* ho[2] = {H8 + (size_t)m0 * DM, H8 + (size_t)(m0 + 1) * DM}; float* sap[2] = {SA + m0, SA + m0 + 1};
                norm_res_norm<2>(sr, post_ffn_g + l * DM, xi, xo, pre_mix_g + DM, ho, sap, l == 0, lane_p); }
        }
        SEAM(pb + 8);
    }
#undef IN
#undef INJ
#undef SEAM
}

extern "C" void kernel_launch(void* const* d_in, const int* in_sizes, int n_in, void* d_out, int out_size, void* d_ws, size_t ws_size, hipStream_t stream) {
    static int grid = 0;
    if (grid == 0) {
        if (n_in != 23 || in_sizes[0] != NTOK * DM || out_size != NTOK * DM || ws_size < WS_END) { fprintf(stderr, "kernel_launch: unexpected shapes (n_in %d, in0 %d, out %d, ws %zu); nothing launched\n", n_in, n_in > 0 ? in_sizes[0] : -1, out_size, ws_size); grid = -1; return; }
        int dev = 0, cus = 0, per_cu = 0;
        if (hipGetDevice(&dev) != hipSuccess || hipDeviceGetAttribute(&cus, hipDeviceAttributeMultiprocessorCount, dev) != hipSuccess) { grid = -1; return; }
        if (hipFuncSetAttribute((const void*)fwd_kernel, hipFuncAttributeMaxDynamicSharedMemorySize, LDS_BYTES) != hipSuccess) { fprintf(stderr, "kernel_launch: hipFuncSetAttribute failed\n"); grid = -1; return; }
        if (hipOccupancyMaxActiveBlocksPerMultiprocessor(&per_cu, (const void*)fwd_kernel, 512, LDS_BYTES) != hipSuccess || per_cu < 1) fprintf(stderr, "kernel_launch: occupancy query reports %d\n", per_cu);
        (void)hipGetLastError();
        grid = cus;
    }
    if (grid < 0) return;
    if (hipMemsetAsync((char*)d_ws + WS_CTL, 0, CTL_ZERO_BYTES, stream) != hipSuccess) return;
    Args a{};
    for (int i = 0; i < 23; ++i) a.in[i] = (const float*)d_in[i];
    a.out = (float*)d_out; a.ws = (unsigned char*)d_ws;
#if MK_MULTI_LAUNCH
    for (int p = 0; p < N_PHASES; ++p) { a.ph_lo = p; a.ph_hi = p + 1; hipLaunchKernelGGL(fwd_kernel, dim3(grid), dim3(512), LDS_BYTES, stream, a); }
#else
    a.ph_lo = 0; a.ph_hi = N_PHASES;
    hipLaunchKernelGGL(fwd_kernel, dim3(grid), dim3(512), LDS_BYTES, stream, a);
#endif
    const hipError_t le = hipPeekAtLastError();
    if (le != hipSuccess) fprintf(stderr, "kernel_launch: launch failed: %s\n", hipGetErrorName(le));
}
```

```cpp
#include <hip/hip_runtime.h>
#include <cstdio>
#include <cstdint>

#define LAS __attribute__((address_space(3)))
#define GAS __attribute__((address_space(1)))
typedef unsigned short bf16;
typedef short bf16x8 __attribute__((ext_vector_type(8)));
typedef short s16x4 __attribute__((ext_vector_type(4)));
typedef float f32x2 __attribute__((ext_vector_type(2)));
typedef float f32x4 __attribute__((ext_vector_type(4)));
typedef float f32x16 __attribute__((ext_vector_type(16)));
typedef unsigned u32x2 __attribute__((ext_vector_type(2)));
typedef unsigned u32x4 __attribute__((ext_vector_type(4)));

constexpr int BATCH = 16, SEQ = 2048, DM = 1024, NTOK = BATCH * SEQ;
constexpr int NPA = 2560;
constexpr int NGT = 3072;
constexpr int NIN = NPA + NGT;
constexpr int INW = 5400;
constexpr int DFF = 2816, NGU = 2 * DFF;
constexpr int MEML = 256, NMEM = BATCH * MEML;
constexpr int PA_QN = 0, PA_KC = 512, PA_VC = 640, PA_KS = 768, PA_VS = 896, PA_KW = 1024, PA_VW = 1152;
constexpr int PA_QM = 1280, PA_KM = 1536, PA_VM = 1792, PA_QX = 2048, PA_GN = 2304;
constexpr float RMS_EPS = 1e-6f;
constexpr float LOG2E = 1.4426950408889634f;
constexpr float C2 = 0.125f * LOG2E;
constexpr float NEGB = -1e30f;

constexpr size_t MiB = 1u << 20;
constexpr size_t WS_CTL = 0, CTL_ZERO_BYTES = 1 * MiB;
constexpr size_t WS_W = 1 * MiB;
constexpr size_t WL_STRIDE = 35 * MiB;
constexpr size_t WL_IN = 0, WL_GU = 11 * MiB, WL_DN = 22 * MiB, WL_BR = 28 * MiB, WL_MIX = 30 * MiB, WL_MKV = 32 * MiB, WL_W1K = 33 * MiB, WL_W1V = 33 * MiB + 512 * 1024;
constexpr size_t WL_SM = 34 * MiB;
constexpr size_t WL_W2K = WL_SM, WL_W2V = WL_SM + 16384, WL_POSK = WL_SM + 32768, WL_POSV = WL_SM + 32768 + 512;
constexpr size_t WS_MEMKV = 71 * MiB;
constexpr size_t WS_KC = 79 * MiB, WS_VC = 79 * MiB + 512 * 1024;
constexpr size_t WS_KMEAN = 80 * MiB;
constexpr size_t WS_H = 81 * MiB;
constexpr size_t WS_PA = 145 * MiB;
constexpr size_t WS_GT = 305 * MiB;
constexpr size_t WS_MKV2 = 497 * MiB;
constexpr size_t WS_END = 499 * MiB;
static_assert(WL_DN + (size_t)DM * DFF * 2 <= WL_BR && WS_W + 2 * WL_STRIDE <= WS_MEMKV && WS_H + (size_t)NTOK * DM * 2 <= WS_PA && WS_PA + (size_t)NTOK * NPA * 2 <= WS_GT && WS_GT + (size_t)NTOK * NGT * 2 <= WS_MKV2, "ws map");
constexpr int CW_TMO = 0, CW_BAR = 4096;
constexpr int CW_CMAX = 16384;
constexpr size_t WL_SBIN = WL_SM + 65536, WL_SBGU = WL_SM + 98304;
constexpr size_t WS_SA = WS_KMEAN + 512 * 1024;
static_assert((CW_CMAX + 4 * NIN) * 4 <= (int)CTL_ZERO_BYTES && WL_SBGU + NIN * 4 <= WL_STRIDE && WS_SA + NTOK * 4 <= WS_H, "int8 side tables");

constexpr int RING_BYTES = 131072;
constexpr int MISC_OFF = 156672;
constexpr int LDS_BYTES = 157696;
constexpr int A_KV = 0, A_CMP = 49152, A_TAB = 81920, A_CTAB = 117760, A_IMP = 121984, A_SC = A_CMP, A_SEL = A_CMP + 16384, A_KMEAN = A_IMP, A_MG = A_IMP + 2048;
constexpr int TABN = 448, CTABN = 132;
static_assert(A_IMP + 4 * 64 * 33 * 4 <= MISC_OFF && A_TAB + 20 * TABN * 4 <= A_CTAB && A_CTAB + 8 * CTABN * 4 <= A_IMP, "lds map");

__device__ __forceinline__ unsigned f2bf(float f) { unsigned u = __builtin_bit_cast(unsigned, f); return (u + 0x7fffu + ((u >> 16) & 1u)) >> 16; }
__device__ __forceinline__ unsigned pk2(float lo, float hi) { return f2bf(lo) | (f2bf(hi) << 16); }
__device__ __forceinline__ float bflo(unsigned w) { return __builtin_bit_cast(float, w << 16); }
__device__ __forceinline__ float bfhi(unsigned w) { return __builtin_bit_cast(float, w & 0xffff0000u); }
__device__ __forceinline__ float fast_sigmoid(float v) { return __builtin_amdgcn_rcpf(1.0f + __builtin_amdgcn_exp2f(-LOG2E * v)); }

namespace pg8 {
#define PG8_LAS __attribute__((address_space(3)))
typedef unsigned short bf16_t;
constexpr int BM = 256, BK = 64, HALF = 128, HTB = HALF * BK * 2  , STAGE_BYTES = 8 * HTB, NXCD = 8, WGM = 8;

__host__ __device__ __forceinline__ int lds_byte(int r, int c) { const int st = (r >> 4) * 2 + (c >> 5), rr = r & 15, cc = c & 31, ob = rr * 64 + cc * 2; return st * 1024 + (ob ^ (((ob >> 9) & 1) << 5)); }
__host__ __device__ __forceinline__ void stage_rc(int b, int& R, int& C) { const int st = b / 1024, sb = b % 1024, swz = sb ^ (((sb >> 9) & 1) << 5); R = (st >> 1) * 16 + swz / 64; C = (st & 1) * 32 + (swz % 64) / 2; }
__host__ __device__ __forceinline__ int perm32(int rho) { const int n = rho >> 4, i = rho & 15; return 8 * (i >> 2) + 4 * n + (i & 3); }

struct Unit { int pm, pn; };
struct Gemm { const bf16_t* A; const bf16_t* Bt; int M, N, K, lda, ldb; };

struct StaticOrder {
    int nM, nN, nwg, G, c;
    __host__ __device__ void init(int M, int N, int G_, int c_) { nM = M / BM; nN = N / BM; nwg = nM * nN; G = G_; c = c_; }
    __host__ __device__ bool next(int i, Unit& u) const {
        const long L = (long)i * G + c; if (L >= nwg) return false;
        int wgid = (int)L; { const int q = nwg / NXCD, r = nwg % NXCD, xcd = wgid % NXCD, off = wgid / NXCD; wgid = (xcd < r ? xcd * (q + 1) : r * (q + 1) + (xcd - r) * q) + off; }
        const int nig = WGM * nN, gid = wgid / nig, fm = gid * WGM, gsz = (nM - fm) < WGM ? (nM - fm) : WGM;
        u.pm = fm + ((wgid % nig) % gsz); u.pn = (wgid % nig) / gsz; return true;
    }
    __device__ __forceinline__ void a_ready(const Unit&) const {}
    __device__ __forceinline__ void done(const Unit&) const {}
};

__device__ __forceinline__ unsigned cvt_pk_bf16(float lo, float hi) { unsigned r; asm volatile("v_cvt_pk_bf16_f32 %0, %1, %2" : "=v"(r) : "v"(lo), "v"(hi)); return r; }
__device__ __forceinline__ u32x4 pack8(const f32x4& v0, const f32x4& v1) { u32x4 w; w.x = cvt_pk_bf16(v0[0], v0[1]); w.y = cvt_pk_bf16(v0[2], v0[3]); w.z = cvt_pk_bf16(v1[0], v1[1]); w.w = cvt_pk_bf16(v1[2], v1[3]); return w; }
__device__ __forceinline__ void unpack8(const u32x4& w, f32x4& v0, f32x4& v1) { v0 = (f32x4){bflo(w.x), bfhi(w.x), bflo(w.y), bfhi(w.y)}; v1 = (f32x4){bflo(w.z), bfhi(w.z), bflo(w.w), bfhi(w.w)}; }

typedef int i32x4 __attribute__((ext_vector_type(4)));
template <bool I8> __device__ __forceinline__ f32x4 mma16(bf16x8 b, bf16x8 a, f32x4 c) {
    if constexpr (I8) return __builtin_bit_cast(f32x4, __builtin_amdgcn_mfma_i32_16x16x64_i8(__builtin_bit_cast(i32x4, b), __builtin_bit_cast(i32x4, a), __builtin_bit_cast(i32x4, c), 0, 0, 0));
    else return __builtin_amdgcn_mfma_f32_16x16x32_bf16(b, a, c, 0, 0, 0);
}
__device__ __forceinline__ f32x4 i2f4(const f32x4& a) { const i32x4 i = __builtin_bit_cast(i32x4, a); return (f32x4){(float)i[0], (float)i[1], (float)i[2], (float)i[3]}; }
__device__ __forceinline__ unsigned u8x4(const f32x4& v) { return (unsigned)(v[0] * 255.f + 0.5f) | ((unsigned)(v[1] * 255.f + 0.5f) << 8) | ((unsigned)(v[2] * 255.f + 0.5f) << 16) | ((unsigned)(v[3] * 255.f + 0.5f) << 24); }
__device__ __forceinline__ f32x4 u8tof(unsigned w) { return (f32x4){(float)(w & 255u), (float)((w >> 8) & 255u), (float)((w >> 16) & 255u), (float)(w >> 24)}; }
struct EpiPlain {
    static constexpr bool PERM = true, AFTER_DRAIN = false, SEG = false;
    bf16_t* O; int ldc;
    __device__ __forceinline__ void operator()(const f32x4 (&acc)[2][2][4][2], const Unit& u, int wr, int wc, int fr, int fq) const {
        const int row0 = u.pm * BM + wr * 64 + fr, col0 = u.pn * BM + wc * 32 + 8 * fq;
#pragma unroll
        for (int ai = 0; ai < 2; ++ai)
#pragma unroll
            for (int m = 0; m < 4; ++m) { bf16_t* rowp = O + (size_t)(row0 + ai * HALF + m * 16) * ldc + col0;
#pragma unroll
                for (int bj = 0; bj < 2; ++bj) *(u32x4*)(rowp + bj * HALF) = pack8(acc[ai][bj][m][0], acc[ai][bj][m][1]); }
    }
};
struct EpiProj {
    static constexpr bool PERM = true, AFTER_DRAIN = false, SEG = false;
    bf16_t* PA; bf16_t* GT; const float* sa; const float* sb;
    __device__ __forceinline__ void operator()(const f32x4 (&acc)[2][2][4][2], const Unit& u, int wr, int wc, int fr, int fq) const {
        const int pn = u.pn; bf16_t* base; int ldc, colt; float sc = 1.f; bool sig = false;
        if (pn < 10) { base = PA; ldc = NPA; colt = pn * BM; if (pn < 2 || pn == 5 || pn == 8) sc = C2; if (pn == 9) sig = true; }
        else { base = GT; ldc = NGT; colt = (pn - 10) * BM; sig = true; }
        const int row0 = u.pm * BM + wr * 64 + fr, col0 = colt + wc * 32 + 8 * fq;
        f32x4 sbv[2][2];
#pragma unroll
        for (int bj = 0; bj < 2; ++bj) { const float* sp = sb + pn * BM + bj * HALF + wc * 32 + 8 * fq; sbv[bj][0] = *(const f32x4*)sp * sc; sbv[bj][1] = *(const f32x4*)(sp + 4) * sc; }
#pragma unroll
        for (int ai = 0; ai < 2; ++ai)
#pragma unroll
            for (int m = 0; m < 4; ++m) { const int row = row0 + ai * HALF + m * 16; bf16_t* rowp = base + (size_t)row * ldc + col0; const float sar = sa[row];
#pragma unroll
                for (int bj = 0; bj < 2; ++bj) { f32x4 v0 = i2f4(acc[ai][bj][m][0]) * sbv[bj][0] * sar, v1 = i2f4(acc[ai][bj][m][1]) * sbv[bj][1] * sar;
                    if (sig) {
#pragma unroll
                        for (int e = 0; e < 4; ++e) { v0[e] = fast_sigmoid(v0[e]); v1[e] = fast_sigmoid(v1[e]); } }
                    if (pn >= 10) { u32x2 w; w.x = u8x4(v0); w.y = u8x4(v1); *(u32x2*)((unsigned char*)GT + (size_t)row * NGT + col0 + bj * HALF) = w; }
                    else *(u32x4*)(rowp + bj * HALF) = pack8(v0, v1); } }
    }
};
struct EpiMerge1P {
    static constexpr bool PERM = true, AFTER_DRAIN = false, SEG = true;
    bf16_t* O; int ldc; const unsigned char* G8; int ldg; int seg1, seg2;
    __device__ __forceinline__ void rescale(f32x4 (&acc)[2][2][4][2], const Unit& u, int wr, int wc, int fr, int fq, int which) const {
        asm volatile("" ::: "memory");
        int row0 = u.pm * BM + wr * 64 + fr; const int col0 = u.pn * BM + wc * 32 + 8 * fq;
        asm volatile("" : "+v"(row0));
        const unsigned char* Ga = G8 + which * 1024 + col0;
#pragma unroll
        for (int ai = 0; ai < 2; ++ai)
#pragma unroll
          for (int mp = 0; mp < 2; ++mp) {
            u32x2 aw[2][2], bw[2][2];
#pragma unroll
            for (int mi = 0; mi < 2; ++mi) { const size_t r = (size_t)(row0 + ai * HALF + (2 * mp + mi) * 16);
#pragma unroll
                for (int bj = 0; bj < 2; ++bj) { aw[mi][bj] = *(const u32x2*)(Ga + r * ldg + bj * HALF); bw[mi][bj] = *(const u32x2*)(Ga + r * ldg + 1024 + bj * HALF); } }
#pragma unroll
            for (int mi = 0; mi < 2; ++mi)
#pragma unroll
                for (int bj = 0; bj < 2; ++bj) { const int m = 2 * mp + mi; f32x4 a0 = u8tof(aw[mi][bj].x), a1 = u8tof(aw[mi][bj].y), b0 = u8tof(bw[mi][bj].x), b1 = u8tof(bw[mi][bj].y);
#pragma unroll
                    for (int e = 0; e < 4; ++e) { const float na0 = which ? fmaxf(a0[e], 0.5f) : a0[e], na1 = which ? fmaxf(a1[e], 0.5f) : a1[e];
                        acc[ai][bj][m][0][e] *= na0 * __builtin_amdgcn_rcpf(fmaxf(b0[e], 0.5f)); acc[ai][bj][m][1][e] *= na1 * __builtin_amdgcn_rcpf(fmaxf(b1[e], 0.5f)); }
                    asm volatile("" : "+v"(acc[ai][bj][m][0]), "+v"(acc[ai][bj][m][1])); }
            asm volatile("" ::: "memory");
          }
    }
    __device__ __forceinline__ void operator()(const f32x4 (&acc)[2][2][4][2], const Unit& u, int wr, int wc, int fr, int fq) const {
        const int row0 = u.pm * BM + wr * 64 + fr, col0 = u.pn * BM + wc * 32 + 8 * fq;
#pragma unroll
        for (int ai = 0; ai < 2; ++ai) {
            u32x2 gw[4][2];
#pragma unroll
            for (int m = 0; m < 4; ++m) { const size_t r = (size_t)(row0 + ai * HALF + m * 16);
#pragma unroll
                for (int bj = 0; bj < 2; ++bj) gw[m][bj] = *(const u32x2*)(G8 + r * ldg + 2048 + col0 + bj * HALF); }
#pragma unroll
            for (int m = 0; m < 4; ++m) { const size_t r = (size_t)(row0 + ai * HALF + m * 16);
#pragma unroll
                for (int bj = 0; bj < 2; ++bj) { f32x4 g0 = u8tof(gw[m][bj].x), g1 = u8tof(gw[m][bj].y);
#pragma unroll
                    for (int e = 0; e < 4; ++e) { g0[e] = fmaxf(g0[e], 0.5f) * (1.f / 255.f); g1[e] = fmaxf(g1[e], 0.5f) * (1.f / 255.f); }
                    *(u32x4*)(O + r * ldc + col0 + bj * HALF) = pack8(acc[ai][bj][m][0] * g0, acc[ai][bj][m][1] * g1); } }
        }
    }
};
struct EpiSwiGLU {
    static constexpr bool PERM = true, AFTER_DRAIN = false, SEG = false;
    bf16_t* U; int ldc; const float* sa; const float* sb;
    __device__ __forceinline__ void operator()(const f32x4 (&acc)[2][2][4][2], const Unit& u, int wr, int wc, int fr, int fq) const {
        const int row0 = u.pm * BM + wr * 64 + fr, col0 = u.pn * HALF + wc * 32 + 8 * fq;
        f32x4 sbv[2][2];
#pragma unroll
        for (int bj = 0; bj < 2; ++bj) { const float* sp = sb + u.pn * BM + bj * HALF + wc * 32 + 8 * fq; sbv[bj][0] = *(const f32x4*)sp; sbv[bj][1] = *(const f32x4*)(sp + 4); }
#pragma unroll
        for (int ai = 0; ai < 2; ++ai)
#pragma unroll
            for (int m = 0; m < 4; ++m) { const int row = row0 + ai * HALF + m * 16; bf16_t* rowp = U + (size_t)row * ldc + col0; const float sar = sa[row];
                const f32x4 ga = i2f4(acc[ai][0][m][0]) * sbv[0][0] * sar, gb = i2f4(acc[ai][0][m][1]) * sbv[0][1] * sar;
                const f32x4 ua = i2f4(acc[ai][1][m][0]) * sbv[1][0] * sar, ub = i2f4(acc[ai][1][m][1]) * sbv[1][1] * sar;
                f32x4 v0, v1;
#pragma unroll
                for (int e = 0; e < 4; ++e) { v0[e] = ga[e] * fast_sigmoid(ga[e]) * ua[e]; v1[e] = gb[e] * fast_sigmoid(gb[e]) * ub[e]; }
                *(u32x4*)rowp = pack8(v0, v1); }
    }
};

template <class Epi, class Sched, bool ALIGN_EPI = false, bool SP2 = false, bool I8 = false>
__device__ __forceinline__ void gemm_phase(PG8_LAS unsigned char* lds, const Gemm g, const Sched& S, const Epi& E, int wave_in) {
    unsigned z_ = 0u; asm volatile("" : "+s"(z_));
    int tid_ = wave_in * 64 + (int)__builtin_amdgcn_mbcnt_hi(~0u, __builtin_amdgcn_mbcnt_lo(~0u, z_)); asm volatile("" : "+v"(tid_));
    const int tid = tid_, wid = __builtin_amdgcn_readfirstlane(tid >> 6), lane = tid & 63, wr = wid >> 2, wc = wid & 3, fr = lane & 15, fq = lane >> 4;
    const int K = g.K, nt = K / BK;
    unsigned voffA[2], voffB[2];
#pragma unroll
    for (int i = 0; i < 2; ++i) { int R, C; stage_rc(tid * 16 + i * 8192, R, C); const int Rb = Epi::PERM ? ((R & ~31) + perm32(R & 31)) : R;
        voffA[i] = (unsigned)(R * g.lda + C) * 2u; voffB[i] = (unsigned)(Rb * g.ldb + C) * 2u; }
    const size_t kstep = (size_t)(BK * 2);
    const size_t hstepA = (size_t)HALF * g.lda * 2, hstepB = (size_t)HALF * g.ldb * 2;
    const size_t tstepA = 2 * hstepA, tstepB = 2 * hstepB;
    const unsigned ldsw = (unsigned)wid * 1024u;
    const int aoff = lds_byte(wr * 64 + fr, fq * 8), boff = lds_byte(wc * 32 + fr, fq * 8);
#define PG8_SA(b, h) (((b) * 2 + (h)) * HTB)
#define PG8_SB(b, h) ((4 + (b) * 2 + (h)) * HTB)
#define PG8_STAGE(bufoff, gbase, voff) do { _Pragma("unroll") for (int _i = 0; _i < 2; ++_i) \
        __builtin_amdgcn_global_load_lds((const unsigned*)((const char*)(gbase) + (voff)[_i]), (PG8_LAS unsigned*)(lds + (bufoff) + ldsw + _i * 8192), 16, 0, 0); } while (0)
#define PG8_LDA(dst, b, h) do { _Pragma("unroll") for (int m = 0; m < 4; ++m) _Pragma("unroll") for (int k = 0; k < 2; ++k) dst[m][k] = *(const PG8_LAS bf16x8*)(lds + PG8_SA(b, h) + aoff + m * 2048 + k * 1024); } while (0)
#define PG8_LDB(dst, b, h) do { _Pragma("unroll") for (int n = 0; n < 2; ++n) _Pragma("unroll") for (int k = 0; k < 2; ++k) dst[n][k] = *(const PG8_LAS bf16x8*)(lds + PG8_SB(b, h) + boff + n * 2048 + k * 1024); } while (0)
#define PG8_MMA(ai, bj, At, Bt) do { __builtin_amdgcn_s_setprio(1); _Pragma("unroll") for (int m = 0; m < 4; ++m) _Pragma("unroll") for (int n = 0; n < 2; ++n) _Pragma("unroll") for (int k = 0; k < 2; ++k) \
        acc[ai][bj][m][n] = mma16<I8>(Bt[n][k], At[m][k], acc[ai][bj][m][n]); __builtin_amdgcn_s_setprio(0); } while (0)
#define PG8_WAIT_V(n) asm volatile("s_waitcnt vmcnt(" #n ")" ::: "memory")
#define PG8_WAIT_L(n) asm volatile("s_waitcnt lgkmcnt(" #n ")" ::: "memory")
#define PG8_BAR __builtin_amdgcn_s_barrier()
#define PG8_SCHED __builtin_amdgcn_sched_barrier(0)
    Unit cur, nxt; int ui = 0;
    if (!S.next(0, cur)) return;
    f32x4 acc[2][2][4][2];
#pragma unroll
    for (int a = 0; a < 2; ++a)
#pragma unroll
        for (int b = 0; b < 2; ++b)
#pragma unroll
            for (int m = 0; m < 4; ++m)
#pragma unroll
                for (int n = 0; n < 2; ++n) acc[a][b][m][n] = (f32x4){0.f, 0.f, 0.f, 0.f};
    bf16x8 At[4][2], B0[2][2], B1[2][2];
    const char* cA = (const char*)g.A + (size_t)cur.pm * tstepA; const char* cB = (const char*)g.Bt + (size_t)cur.pn * tstepB;
    S.a_ready(cur);
    if constexpr (SP2) {
        PG8_STAGE(PG8_SB(0, 0), cB, voffB); PG8_STAGE(PG8_SB(0, 1), cB + hstepB, voffB); PG8_STAGE(PG8_SA(0, 0), cA, voffA); PG8_STAGE(PG8_SA(0, 1), cA + hstepA, voffA);
        if (wr == 1) PG8_BAR;
        PG8_WAIT_V(2); PG8_BAR;
        PG8_STAGE(PG8_SB(1, 0), cB + kstep, voffB); PG8_STAGE(PG8_SA(1, 0), cA + kstep, voffA); PG8_STAGE(PG8_SB(1, 1), cB + hstepB + kstep, voffB);
        PG8_WAIT_V(6); PG8_BAR;
    } else {
        PG8_STAGE(PG8_SB(0, 0), cB, voffB); PG8_STAGE(PG8_SA(0, 0), cA, voffA); PG8_STAGE(PG8_SB(0, 1), cB + hstepB, voffB); PG8_STAGE(PG8_SA(0, 1), cA + hstepA, voffA);
        if (wr == 1) PG8_BAR;
        PG8_WAIT_V(4); PG8_BAR;
        PG8_STAGE(PG8_SB(1, 0), cB + kstep, voffB); PG8_STAGE(PG8_SA(1, 0), cA + kstep, voffA); PG8_STAGE(PG8_SB(1, 1), cB + hstepB + kstep, voffB);
        PG8_WAIT_V(6); PG8_BAR;
    }
    for (;;) {
        const bool has_next = S.next(ui + 1, nxt);
        const char* nA = has_next ? (const char*)g.A + (size_t)nxt.pm * tstepA : cA; const char* nB = has_next ? (const char*)g.Bt + (size_t)nxt.pn * tstepB : cB;
        for (int t = 0; t < nt; t += 2) {
            const bool last = (t == nt - 2);
            const char* a1 = cA + (size_t)(t + 1) * kstep;
            const char* a2 = last ? nA : cA + (size_t)(t + 2) * kstep; const char* b2 = last ? nB : cB + (size_t)(t + 2) * kstep;
            const char* a3 = a2 + kstep; const char* b3 = b2 + kstep;
            if (last && has_next) S.a_ready(nxt);
            if constexpr (Epi::SEG) { __builtin_amdgcn_sched_barrier(0); if (t == E.seg1 || t == E.seg2) E.rescale(acc, cur, wr, wc, fr, fq, t == E.seg1 ? 0 : 1); __builtin_amdgcn_sched_barrier(0); }
            if constexpr (SP2) {
            PG8_LDB(B0, 0, 0); PG8_LDB(B1, 0, 1); PG8_SCHED; PG8_LDA(At, 0, 0); PG8_STAGE(PG8_SA(1, 1), a1 + hstepA, voffA);
            PG8_WAIT_V(8); PG8_WAIT_L(0); PG8_BAR; PG8_MMA(0, 0, At, B0); PG8_MMA(0, 1, At, B1); PG8_BAR; PG8_SCHED;
            PG8_LDA(At, 0, 1); PG8_STAGE(PG8_SB(0, 0), b2, voffB); PG8_STAGE(PG8_SB(0, 1), b2 + hstepB, voffB); PG8_STAGE(PG8_SA(0, 0), a2, voffA);
            PG8_WAIT_V(8); PG8_WAIT_L(0); PG8_BAR; PG8_MMA(1, 0, At, B0); PG8_MMA(1, 1, At, B1); PG8_BAR; PG8_SCHED;
            PG8_LDB(B0, 1, 0); PG8_LDB(B1, 1, 1); PG8_SCHED; PG8_LDA(At, 1, 0); PG8_STAGE(PG8_SA(0, 1), a2 + hstepA, voffA);
            PG8_WAIT_V(8); PG8_WAIT_L(0); PG8_BAR; PG8_MMA(0, 0, At, B0); PG8_MMA(0, 1, At, B1); PG8_BAR; PG8_SCHED;
            PG8_LDA(At, 1, 1); PG8_STAGE(PG8_SB(1, 0), b3, voffB); PG8_STAGE(PG8_SB(1, 1), b3 + hstepB, voffB); PG8_STAGE(PG8_SA(1, 0), a3, voffA);
            PG8_WAIT_V(8); PG8_WAIT_L(0); PG8_BAR; PG8_MMA(1, 0, At, B0); PG8_MMA(1, 1, At, B1); PG8_BAR; PG8_SCHED;
            } else {
            PG8_LDB(B0, 0, 0); PG8_SCHED; PG8_LDA(At, 0, 0); PG8_STAGE(PG8_SA(1, 1), a1 + hstepA, voffA);
            PG8_WAIT_L(8); PG8_BAR; PG8_WAIT_L(0); PG8_MMA(0, 0, At, B0); PG8_BAR; PG8_SCHED;
            PG8_LDB(B1, 0, 1); PG8_STAGE(PG8_SB(0, 0), b2, voffB);
            PG8_BAR; PG8_WAIT_L(0); PG8_MMA(0, 1, At, B1); PG8_BAR;
            PG8_LDA(At, 0, 1); PG8_STAGE(PG8_SA(0, 0), a2, voffA);
            PG8_BAR; PG8_WAIT_L(0); PG8_MMA(1, 0, At, B0); PG8_BAR; PG8_SCHED;
            PG8_STAGE(PG8_SB(0, 1), b2 + hstepB, voffB);
            PG8_WAIT_V(6); PG8_BAR; PG8_MMA(1, 1, At, B1); PG8_BAR;
            PG8_LDB(B0, 1, 0); PG8_SCHED; PG8_LDA(At, 1, 0); PG8_STAGE(PG8_SA(0, 1), a2 + hstepA, voffA);
            PG8_WAIT_L(8); PG8_BAR; PG8_WAIT_L(0); PG8_MMA(0, 0, At, B0); PG8_BAR; PG8_SCHED;
            PG8_LDB(B1, 1, 1); PG8_STAGE(PG8_SB(1, 0), b3, voffB);
            PG8_BAR; PG8_WAIT_L(0); PG8_MMA(0, 1, At, B1); PG8_BAR;
            PG8_LDA(At, 1, 1); PG8_STAGE(PG8_SA(1, 0), a3, voffA);
            PG8_BAR; PG8_WAIT_L(0); PG8_MMA(1, 0, At, B0); PG8_BAR; PG8_SCHED;
            PG8_STAGE(PG8_SB(1, 1), b3 + hstepB, voffB);
            PG8_WAIT_V(6); PG8_BAR; PG8_MMA(1, 1, At, B1); PG8_BAR;
            }
        }
        if constexpr (ALIGN_EPI) { if (wr == 0) PG8_BAR; }
        if constexpr (!Epi::AFTER_DRAIN) { E(acc, cur, wr, wc, fr, fq); S.done(cur); }
        if (!has_next) break;
#pragma unroll
        for (int a = 0; a < 2; ++a)
#pragma unroll
            for (int b = 0; b < 2; ++b)
#pragma unroll
                for (int m = 0; m < 4; ++m)
#pragma unroll
                    for (int n = 0; n < 2; ++n) acc[a][b][m][n] = (f32x4){0.f, 0.f, 0.f, 0.f};
        cur = nxt; cA = nA; cB = nB; ++ui;
        if constexpr (ALIGN_EPI) { if (wr == 1) PG8_BAR; }
    }
    PG8_WAIT_V(0);
    if constexpr (!ALIGN_EPI) { if (wr == 0) PG8_BAR; }
    PG8_BAR;
    if constexpr (Epi::AFTER_DRAIN) { E.fused(acc, cur, wr, wc, fr, fq, lds, wid, lane); S.done(cur); }
#undef PG8_SA
#undef PG8_SB
#undef PG8_STAGE
#undef PG8_LDA
#undef PG8_LDB
#undef PG8_MMA
#undef PG8_WAIT_V
#undef PG8_WAIT_L
#undef PG8_BAR
#undef PG8_SCHED
}

}

typedef GAS unsigned gu32;
#define RLX_AGENT __ATOMIC_RELAXED, __HIP_MEMORY_SCOPE_AGENT
#define XB_TMO      128
#define XB_XCNT(j)  (256  + 64 * (j))
#define XB_XSUB(j)  (1280 + 64 * (j))
#define XB_XGEN(j)  (2304 + 64 * (j))
#define XB_TOP      3328
#define XB_TOPGEN   3392
#define XCD_BAR_WORDS 3456
#define XB_SPIN_CAP (1u << 18)

__device__ __forceinline__ unsigned xb_ld(unsigned* p)              { return __hip_atomic_load(p, __ATOMIC_RELAXED, __HIP_MEMORY_SCOPE_AGENT); }
__device__ __forceinline__ unsigned xb_add(unsigned* p, unsigned v) { return __hip_atomic_fetch_add(p, v, __ATOMIC_RELAXED, __HIP_MEMORY_SCOPE_AGENT); }
__device__ __forceinline__ unsigned xb_xcc_id() { return (unsigned)__builtin_amdgcn_s_getreg((3 << 11) | 20) & 0xFu; }
#define XB_SPIN(cond, bar) do { unsigned _sp = 0; while (cond) { __builtin_amdgcn_s_sleep(1); \
    if ((++_sp & 255u) == 0u) { if (xb_ld(&(bar)[XB_TMO])) break; if (_sp > XB_SPIN_CAP) { atomicAdd(&(bar)[XB_TMO], 1u); break; } } } } while (0)

struct XcdBarrier {
    unsigned* bar; unsigned x;
    volatile LAS unsigned* st;
};

__device__ __forceinline__ XcdBarrier xcd_barrier_post(unsigned* bar, volatile LAS unsigned* st) {
    XcdBarrier b; b.bar = bar; b.x = xb_xcc_id(); b.st = st;
    if (threadIdx.x == 0) (void)xb_add(&bar[XB_XCNT(b.x)], 1u);
    return b;
}
__device__ __forceinline__ void xcd_barrier_complete(unsigned* bar, unsigned x, unsigned& nloc, unsigned& nx) {
    const unsigned G = gridDim.x * gridDim.y * gridDim.z;
    unsigned sum, cnt, mine, sp = 0u;
    for (;;) {
        sum = 0u; cnt = 0u; mine = 0u;
#pragma unroll
        for (unsigned j = 0; j < 16; ++j) { const unsigned c = xb_ld(&bar[XB_XCNT(j)]); sum += c; cnt += (c > 0u) ? 1u : 0u; mine = (j == x) ? c : mine; }
        if (sum == G) break;
        __builtin_amdgcn_s_sleep(1);
        if ((++sp & 255u) == 0u) { if (xb_ld(&bar[XB_TMO])) break; if (sp > XB_SPIN_CAP) { atomicAdd(&bar[XB_TMO], 1u); break; } }
    }
    nloc = mine > 0u ? mine : 1u; nx = cnt > 0u ? cnt : 1u;
}

__device__ __forceinline__ void xcd_barrier(const XcdBarrier& b) {
    asm volatile("s_waitcnt vmcnt(0)" ::: "memory");
    __syncthreads();
    if (threadIdx.x == 0) {
        unsigned* bar = b.bar;
        __builtin_amdgcn_s_waitcnt(0);
        unsigned nloc = b.st[0], nx = b.st[1];
        if (nloc == 0u) { xcd_barrier_complete(bar, b.x, nloc, nx); b.st[0] = nloc; b.st[1] = nx; }
        const unsigned old = xb_add(&bar[XB_XSUB(b.x)], 1u);
        const unsigned gen = old / nloc;
        if (old + 1u == (gen + 1u) * nloc) {
            __builtin_amdgcn_fence(__ATOMIC_RELEASE, "agent");
            asm volatile("s_waitcnt vmcnt(0)" ::: "memory");
            const unsigned og = xb_add(&bar[XB_TOP], 1u);
            const unsigned tg = og / nx;
            if (og + 1u == (tg + 1u) * nx) xb_add(&bar[XB_TOPGEN], 1u);
            else XB_SPIN(xb_ld(&bar[XB_TOPGEN]) == tg, bar);
            __builtin_amdgcn_fence(__ATOMIC_ACQUIRE, "agent");
            xb_add(&bar[XB_XGEN(b.x)], 1u);
            asm volatile("s_waitcnt vmcnt(0)" ::: "memory");
        } else {
            XB_SPIN(xb_ld(&bar[XB_XGEN(b.x)]) == gen, bar);
            __builtin_amdgcn_fence(__ATOMIC_ACQUIRE, "agent");
            asm volatile("s_waitcnt vmcnt(0)" ::: "memory");
        }
    }
    __syncthreads();
}

#define LDS_WAIT() asm volatile("s_waitcnt lgkmcnt(0)" ::: "memory")
#define VM_WAIT() asm volatile("s_waitcnt vmcnt(0)" ::: "memory")
#define MFMA32 __builtin_amdgcn_mfma_f32_32x32x16_bf16
__device__ __forceinline__ float wave_sum(float v) {
#pragma unroll
    for (int o = 1; o < 64; o <<= 1) v += __shfl_xor(v, o);
    return v;
}
__device__ __forceinline__ float wave_max(float v) {
#pragma unroll
    for (int o = 1; o < 64; o <<= 1) v = fmaxf(v, __shfl_xor(v, o));
    return v;
}
__device__ __forceinline__ unsigned q8x4(const f32x4& y, float inv) {
    int a = __float2int_rn(y.x * inv), b = __float2int_rn(y.y * inv), c = __float2int_rn(y.z * inv), d = __float2int_rn(y.w * inv);
    a = a < -127 ? -127 : (a > 127 ? 127 : a); b = b < -127 ? -127 : (b > 127 ? 127 : b); c = c < -127 ? -127 : (c > 127 ? 127 : c); d = d < -127 ? -127 : (d > 127 ? 127 : d);
    return (unsigned)(a & 255) | ((unsigned)(b & 255) << 8) | ((unsigned)(c & 255) << 16) | ((unsigned)(d & 255) << 24);
}
__device__ __forceinline__ float amax4(const f32x4& y) { return fmaxf(fmaxf(fabsf(y.x), fabsf(y.y)), fmaxf(fabsf(y.z), fabsf(y.w))); }
__device__ __forceinline__ float swap_max(float m) { auto rr = __builtin_amdgcn_permlane32_swap(__float_as_uint(m), __float_as_uint(m), false, false); return fmaxf(__uint_as_float(rr[0]), __uint_as_float(rr[1])); }
__device__ __forceinline__ float swap_sum(float m) { auto rr = __builtin_amdgcn_permlane32_swap(__float_as_uint(m), __float_as_uint(m), false, false); return __uint_as_float(rr[0]) + __uint_as_float(rr[1]); }
__device__ __forceinline__ int crow(int r, int hi) { return (r & 3) + 8 * (r >> 2) + 4 * hi; }
__device__ __forceinline__ int t5_bucket(int dist) {
    if (dist < 16) return dist;
    int b = 16;
    b += (dist >= 19); b += (dist >= 21); b += (dist >= 24); b += (dist >= 27); b += (dist >= 31); b += (dist >= 35); b += (dist >= 40); b += (dist >= 46);
    b += (dist >= 52); b += (dist >= 59); b += (dist >= 67); b += (dist >= 77); b += (dist >= 87); b += (dist >= 99); b += (dist >= 113);
    return b;
}
__device__ __forceinline__ float gelu_tanh(float x) { const float u = 0.7978845608028654f * (x + 0.044715f * x * x * x); return x * __builtin_amdgcn_rcpf(1.0f + __builtin_amdgcn_exp2f(-2.0f * LOG2E * u)); }

__device__ __forceinline__ void tr_item(const float* W, int ldw, bf16* WT, int ldt, int kdst, LAS float* scr, int k0, int n0, int sc, int lane, unsigned* cmax, const float* kgain) {
    float tv[32];
    const float* wp = W + (size_t)(k0 + (lane >> 5)) * ldw + (sc >= 0 ? sc : 0);
#pragma unroll
    for (int i = 0; i < 32; ++i) tv[i] = wp[(size_t)(2 * i) * ldw];
    if (kgain) {
#pragma unroll
        for (int i = 0; i < 32; ++i) tv[i] *= kgain[k0 + 2 * i + (lane >> 5)]; }
#pragma unroll
    for (int i = 0; i < 32; ++i) { const int kk = 2 * i + (lane >> 5); scr[kk * 33 + (lane & 31)] = sc >= 0 ? tv[i] : 0.f; }
    LDS_WAIT(); asm volatile("" ::: "memory");
    const int c = lane & 7;
#pragma unroll
    for (int j = 0; j < 4; ++j) { const int n = (lane >> 3) + 8 * j; const LAS float* s = scr + (8 * c) * 33 + n;
        u32x4 o; o.x = pk2(s[0 * 33], s[1 * 33]); o.y = pk2(s[2 * 33], s[3 * 33]); o.z = pk2(s[4 * 33], s[5 * 33]); o.w = pk2(s[6 * 33], s[7 * 33]);
        *(u32x4*)(WT + (size_t)(n0 + n) * ldt + kdst + k0 + 8 * c) = o;
        if (cmax) { float mx = fmaxf(fmaxf(fmaxf(bflo(o.x), bfhi(o.x)), fmaxf(bflo(o.y), bfhi(o.y))), fmaxf(fmaxf(bflo(o.z), bfhi(o.z)), fmaxf(bflo(o.w), bfhi(o.w))));
            float mn = fminf(fminf(fminf(bflo(o.x), bfhi(o.x)), fminf(bflo(o.y), bfhi(o.y))), fminf(fminf(bflo(o.z), bfhi(o.z)), fminf(bflo(o.w), bfhi(o.w))));
            mx = fmaxf(mx, -mn);
            mx = fmaxf(mx, __shfl_xor(mx, 1)); mx = fmaxf(mx, __shfl_xor(mx, 2)); mx = fmaxf(mx, __shfl_xor(mx, 4));
            if (c == 0) atomicMax(cmax + n0 + n, __float_as_uint(mx)); } }
    LDS_WAIT(); asm volatile("" ::: "memory");
}
__device__ __forceinline__ void tr_matrix(int kind, const float* W, const float* W2, int Ksrc, int ldw, int Ndst, bf16* WT, int ldt, int kdst, LAS float* scr, int gw, int NGW, int lane, unsigned* cmax, const float* kgain) {
    const int nblk = Ndst / 32, nitems = (Ksrc / 64) * nblk;
    for (int it = gw; it < nitems; it += NGW) {
        const int kb = it / nblk, nb = it % nblk, n0 = 32 * nb, n = n0 + (lane & 31);
        const float* src = W; int sc = n;
        if (kind == 1) { sc = n < 1280 ? n : (n < 2304 ? n + 24 : (n < 2328 ? n - 1024 : (n < 2560 ? -1 : n - 232))); }
        else if (kind == 2) { const int pn = n >> 8, w = n & 255; if (w < 128) sc = 128 * pn + w; else { sc = 128 * pn + w - 128; src = W2; } }
        tr_item(src, ldw, WT, ldt, kdst, scr, 64 * kb, n0, sc, lane, cmax, kgain);
    }
}

template <int NR>
__device__ __forceinline__ void rms_rows_bf16(const float* const (&xrow)[NR], const float* g, bf16* const (&orow)[NR], int lane) {
    f32x4 v[NR][4];
#pragma unroll
    for (int r = 0; r < NR; ++r) { const f32x4* xr = (const f32x4*)xrow[r] + lane;
#pragma unroll
        for (int j = 0; j < 4; ++j) v[r][j] = xr[64 * j]; }
    const f32x4* gr = (const f32x4*)g + lane; f32x4 gv[4];
#pragma unroll
    for (int j = 0; j < 4; ++j) gv[j] = g ? gr[64 * j] : (f32x4){1.f, 1.f, 1.f, 1.f};
#pragma unroll
    for (int r = 0; r < NR; ++r) { float s = 0.f;
#pragma unroll
        for (int j = 0; j < 4; ++j) s += (v[r][j].x * v[r][j].x + v[r][j].y * v[r][j].y) + (v[r][j].z * v[r][j].z + v[r][j].w * v[r][j].w);
        const float rs = rsqrtf(wave_sum(s) * (1.f / DM) + RMS_EPS);
        u32x2* o8 = (u32x2*)orow[r] + lane;
#pragma unroll
        for (int j = 0; j < 4; ++j) { u32x2 w; w.x = pk2(v[r][j].x * rs * gv[j].x, v[r][j].y * rs * gv[j].y); w.y = pk2(v[r][j].z * rs * gv[j].z, v[r][j].w * rs * gv[j].w); o8[64 * j] = w; } }
}
template <int NR>
__device__ __forceinline__ void rms_rows_i8(const float* const (&xrow)[NR], const float* g, unsigned char* const (&orow)[NR], float* const (&sap)[NR], int lane) {
    f32x4 v[NR][4];
#pragma unroll
    for (int r = 0; r < NR; ++r) { const f32x4* xr = (const f32x4*)xrow[r] + lane;
#pragma unroll
        for (int j = 0; j < 4; ++j) v[r][j] = xr[64 * j]; }
    const f32x4* gr = (const f32x4*)g + lane; f32x4 gv[4];
#pragma unroll
    for (int j = 0; j < 4; ++j) gv[j] = gr[64 * j];
#pragma unroll
    for (int r = 0; r < NR; ++r) { float s = 0.f;
#pragma unroll
        for (int j = 0; j < 4; ++j) s += (v[r][j].x * v[r][j].x + v[r][j].y * v[r][j].y) + (v[r][j].z * v[r][j].z + v[r][j].w * v[r][j].w);
        const float rs = rsqrtf(wave_sum(s) * (1.f / DM) + RMS_EPS);
        float am = 0.f;
#pragma unroll
        for (int j = 0; j < 4; ++j) { v[r][j] = v[r][j] * rs * gv[j]; am = fmaxf(am, amax4(v[r][j])); }
        am = wave_max(am); const float inv = am > 0.f ? 127.f / am : 0.f;
        unsigned* o4 = (unsigned*)orow[r] + lane;
#pragma unroll
        for (int j = 0; j < 4; ++j) o4[64 * j] = q8x4(v[r][j], inv);
        if (lane == 0) *sap[r] = am > 0.f ? am * (1.f / 127.f) : 1.f; }
}
template <int NR, bool XIN_F32, bool XOUT_F32>
__device__ __forceinline__ void norm_res_norm(const bf16* const (&srow)[NR], const float* gA, const void* const (&xin)[NR], void* const (&xout)[NR], const float* gB, unsigned char* const (&hout)[NR], float* const (&sap)[NR], bool has_h, int lane) {
    u32x2 sw[NR][4]; f32x4 xv[NR][4];
#pragma unroll
    for (int r = 0; r < NR; ++r) { const u32x2* sr = (const u32x2*)srow[r] + lane;
#pragma unroll
        for (int j = 0; j < 4; ++j) { sw[r][j] = sr[64 * j];
            if constexpr (XIN_F32) xv[r][j] = ((const f32x4*)xin[r] + lane)[64 * j];
            else { const u32x2 w = ((const u32x2*)xin[r] + lane)[64 * j]; xv[r][j] = (f32x4){bflo(w.x), bfhi(w.x), bflo(w.y), bfhi(w.y)}; } } }
    const f32x4* ga = (const f32x4*)gA + lane; f32x4 gav[4];
#pragma unroll
    for (int j = 0; j < 4; ++j) gav[j] = ga[64 * j];
#pragma unroll
    for (int r = 0; r < NR; ++r) { f32x4 v[4]; float s = 0.f;
#pragma unroll
        for (int j = 0; j < 4; ++j) { const u32x2 w = sw[r][j]; v[j] = (f32x4){bflo(w.x), bfhi(w.x), bflo(w.y), bfhi(w.y)}; s += (v[j].x * v[j].x + v[j].y * v[j].y) + (v[j].z * v[j].z + v[j].w * v[j].w); }
        const float rA = rsqrtf(wave_sum(s) * (1.f / DM) + RMS_EPS);
        float s2 = 0.f;
#pragma unroll
        for (int j = 0; j < 4; ++j) { v[j] = xv[r][j] + v[j] * rA * gav[j];
            if constexpr (XOUT_F32) ((f32x4*)xout[r] + lane)[64 * j] = v[j];
            else { u32x2 w; w.x = pk2(v[j].x, v[j].y); w.y = pk2(v[j].z, v[j].w); ((u32x2*)xout[r] + lane)[64 * j] = w; }
            s2 += (v[j].x * v[j].x + v[j].y * v[j].y) + (v[j].z * v[j].z + v[j].w * v[j].w); }
        if (has_h) {
            const float rB = rsqrtf(wave_sum(s2) * (1.f / DM) + RMS_EPS);
            const f32x4* gb = (const f32x4*)gB + lane; unsigned* o4 = (unsigned*)hout[r] + lane; float am = 0.f;
#pragma unroll
            for (int j = 0; j < 4; ++j) { v[j] = v[j] * rB * gb[64 * j]; am = fmaxf(am, amax4(v[j])); }
            am = wave_max(am); const float inv = am > 0.f ? 127.f / am : 0.f;
#pragma unroll
            for (int j = 0; j < 4; ++j) o4[64 * j] = q8x4(v[j], inv);
            if (lane == 0) *sap[r] = am > 0.f ? am * (1.f / 127.f) : 1.f;
        } }
}

__device__ __forceinline__ void compress_unit(int u, LAS unsigned char* lds, const bf16* PA, const unsigned char* wl, bf16* KC, bf16* VC, int tid) {
    const int lane = tid & 63, wid = __builtin_amdgcn_readfirstlane(tid >> 6), r32 = lane & 31, hi = lane >> 5;
    const int half = u & 1, kv = (u >> 1) & 1, g = (u >> 2) & 1, b = u >> 3;
    const bf16* w1t = (const bf16*)(wl + (kv ? WL_W1V : WL_W1K));
    const bf16* w2t = (const bf16*)(wl + (kv ? WL_W2V : WL_W2K));
    const float* posb = (const float*)(wl + (kv ? WL_POSV : WL_POSK));
    const bf16* Asrc = PA + (size_t)b * SEQ * NPA + (kv ? PA_VC : PA_KC) + g * 64;
    bf16* Out = (kv ? VC : KC) + (size_t)((b * 2 + g) * 128) * 64;
    LAS bf16* H1 = (LAS bf16*)lds;
    {
        const int ctile = wid & 1, ntile = wid >> 1;
        const int c = 64 * half + 32 * ctile + r32;
        const bf16* wrow = w1t + (size_t)(32 * ntile + r32) * 2048 + 8 * hi;
        f32x16 acc = {};
        for (int jj = 0; jj < 32; ++jj) {
            int tok = 16 * c + jj; tok = tok > SEQ - 1 ? SEQ - 1 : tok;
            const bf16* arow = Asrc + (size_t)tok * NPA + 8 * hi;
#pragma unroll
            for (int q = 0; q < 4; ++q) {
                const bf16x8 af = *(const bf16x8*)(wrow + jj * 64 + q * 16);
                const bf16x8 bfr = *(const bf16x8*)(arow + q * 16);
                acc = MFMA32(af, bfr, acc, 0, 0, 0);
            }
        }
#pragma unroll
        for (int k4 = 0; k4 < 4; ++k4) { const int n0 = 32 * ntile + 8 * k4 + 4 * hi; const f32x4 pb = *(const f32x4*)(posb + n0);
            u32x2 w; w.x = pk2(gelu_tanh(acc[4 * k4 + 0] + pb.x), gelu_tanh(acc[4 * k4 + 1] + pb.y)); w.y = pk2(gelu_tanh(acc[4 * k4 + 2] + pb.z), gelu_tanh(acc[4 * k4 + 3] + pb.w));
            *(LAS u32x2*)(H1 + (32 * ctile + r32) * 136 + n0) = w; }
    }
    __syncthreads();
    if (wid < 4) {
        const int ct2 = wid & 1, dt = wid >> 1;
        f32x16 a2 = {};
#pragma unroll
        for (int ks = 0; ks < 8; ++ks) {
            const bf16x8 af = *(const bf16x8*)(w2t + (size_t)(32 * dt + r32) * 128 + 16 * ks + 8 * hi);
            const bf16x8 bfr = *(const LAS bf16x8*)(H1 + (32 * ct2 + r32) * 136 + 16 * ks + 8 * hi);
            a2 = MFMA32(af, bfr, a2, 0, 0, 0);
        }
#pragma unroll
        for (int k4 = 0; k4 < 4; ++k4) { u32x2 w; w.x = pk2(a2[4 * k4 + 0], a2[4 * k4 + 1]); w.y = pk2(a2[4 * k4 + 2], a2[4 * k4 + 3]);
            *(u32x2*)(Out + (size_t)(64 * half + 32 * ct2 + r32) * 64 + 32 * dt + 8 * k4 + 4 * hi) = w; }
    }
    __syncthreads();
}
__device__ __forceinline__ void kmean_unit(int b, int n, LAS unsigned char* lds, const bf16* PA, float* KMEAN, int tid) {
    const int chunk = tid & 31, tg = tid >> 5;
    const bf16* src = PA + ((size_t)b * SEQ + 256 * n + 16 * tg) * NPA + PA_KM + 8 * chunk;
    f32x4 s0 = {0.f, 0.f, 0.f, 0.f}, s1 = {0.f, 0.f, 0.f, 0.f};
#pragma unroll 4
    for (int t = 0; t < 16; ++t) { const u32x4 w = *(const u32x4*)(src + (size_t)t * NPA); f32x4 a, c; pg8::unpack8(w, a, c); s0 += a; s1 += c; }
    LAS float* red = (LAS float*)lds;
    *(LAS f32x4*)(red + tg * 256 + 8 * chunk) = s0; *(LAS f32x4*)(red + tg * 256 + 8 * chunk + 4) = s1;
    __syncthreads();
    if (tid < 256) { float s = 0.f;
#pragma unroll
        for (int t = 0; t < 16; ++t) s += red[t * 256 + tid];
        KMEAN[((size_t)(b * 4 + (tid >> 6)) * 8 + n) * 64 + (tid & 63)] = s * (1.f / 256.f); }
    __syncthreads();
}

__device__ __forceinline__ void glds16(const void* gsrc, unsigned lds_dst) { unsigned keep;
    asm volatile("s_mov_b32 %0, m0\n\ts_mov_b32 m0, %2\n\ts_nop 0\n\tglobal_load_lds_dwordx4 %1, off\n\ts_mov_b32 m0, %0" : "=&s"(keep) : "v"(gsrc), "s"(lds_dst) : "memory"); }
__device__ __forceinline__ void stage_kv(LAS unsigned char* buf, const bf16* kptr, const bf16* vptr, int pitch, int wid, int lane) {
    const int kkey = 8 * wid + (lane >> 3);
    const bf16* ks = kptr + (size_t)kkey * pitch + (((lane & 7) ^ ((kkey >> 1) & 7)) * 8);
    const bf16* vs = vptr + (size_t)(16 * (wid & 3) + (lane >> 2)) * pitch + (wid >> 2) * 32 + (lane & 3) * 8;
    const unsigned dst = (unsigned)__builtin_amdgcn_readfirstlane((int)(unsigned)(uintptr_t)buf + wid * 1024);
    glds16(ks, dst); glds16(vs, dst + 8192u);
}
typedef __bf16 bf16x2_t __attribute__((ext_vector_type(2)));
__device__ __forceinline__ unsigned cvtpk_s(float lo, float hi) { f32x2 v = {lo, hi}; bf16x2_t b = __builtin_convertvector(v, bf16x2_t); return __builtin_bit_cast(unsigned, b); }
__device__ __forceinline__ bf16x8 pack_p(const f32x16& p, int s) {
    u32x4 w; w.x = cvtpk_s(p[8 * s + 0], p[8 * s + 1]); w.y = cvtpk_s(p[8 * s + 2], p[8 * s + 3]); w.z = cvtpk_s(p[8 * s + 4], p[8 * s + 5]); w.w = cvtpk_s(p[8 * s + 6], p[8 * s + 7]);
    return __builtin_bit_cast(bf16x8, w);
}
__device__ __forceinline__ bf16x8 vfrag(const LAS unsigned char* p) {
    const s16x4 lo = __builtin_bit_cast(s16x4, __builtin_amdgcn_ds_read_tr16_b64_v4i16((LAS s16x4*)p));
    const s16x4 hi = __builtin_bit_cast(s16x4, __builtin_amdgcn_ds_read_tr16_b64_v4i16((LAS s16x4*)(p + 512)));
    return (bf16x8){lo[0], lo[1], lo[2], lo[3], hi[0], hi[1], hi[2], hi[3]};
}
#define RING_WAIT_BAR(n) do { asm volatile("s_waitcnt vmcnt(" #n ")" ::: "memory"); __builtin_amdgcn_s_barrier(); asm volatile("" ::: "memory"); } while (0)
#define RING_STEP_SYNC(j, ns) do { if ((j) + 1 < (ns)) RING_WAIT_BAR(2); else RING_WAIT_BAR(0); } while (0)
__device__ __forceinline__ float max3f(float a, float b, float c) { float r; asm("v_max3_f32 %0, %1, %2, %3" : "=v"(r) : "v"(a), "v"(b), "v"(c)); return r; }
#define LOADED4(q) asm volatile("" :: "v"((q)[0]), "v"((q)[1]), "v"((q)[2]), "v"((q)[3]))
#define LOADED1(x) asm volatile("" :: "v"(x))
struct WState { f32x16 o0, o1; float m, l; int first; };
typedef unsigned u32x8 __attribute__((ext_vector_type(8)));
struct OtPk { u32x8 a, b; };
__device__ __forceinline__ void ot_set(OtPk& t, const f32x16& o0, const f32x16& o1, float sc) {
#pragma unroll
    for (int i = 0; i < 8; ++i) { t.a[i] = cvtpk_s(o0[2 * i] * sc, o0[2 * i + 1] * sc); t.b[i] = cvtpk_s(o1[2 * i] * sc, o1[2 * i + 1] * sc); }
}
__device__ __forceinline__ void ot_add(OtPk& t, const f32x16& o0, const f32x16& o1, float sc) {
#pragma unroll
    for (int i = 0; i < 8; ++i) { t.a[i] = cvtpk_s(bflo(t.a[i]) + o0[2 * i] * sc, bfhi(t.a[i]) + o0[2 * i + 1] * sc); t.b[i] = cvtpk_s(bflo(t.b[i]) + o1[2 * i] * sc, bfhi(t.b[i]) + o1[2 * i + 1] * sc); }
}
__device__ __forceinline__ void ot_store(bf16* op, const OtPk& t) {
#pragma unroll
    for (int k4 = 0; k4 < 4; ++k4) { u32x2 w0 = {t.a[2 * k4], t.a[2 * k4 + 1]}, w1 = {t.b[2 * k4], t.b[2 * k4 + 1]}; *(u32x2*)(op + 8 * k4) = w0; *(u32x2*)(op + 32 + 8 * k4) = w1; }
}
__device__ __forceinline__ void ws_reset(WState& S) { S.o0 = f32x16{}; S.o1 = f32x16{}; S.m = 0.f; S.l = 0.f; S.first = 1; }
__device__ __forceinline__ void attn_qk(WState& S, const bf16x8 (&q)[4], const LAS unsigned char* buf, float cadd, bool near, const LAS float* nearp, int r32, int hi, bf16x8 (&pa)[4]) {
    const float ci = cadd - S.m;
    f32x16 p0, p1;
#pragma unroll
    for (int r = 0; r < 16; ++r) { p0[r] = ci; p1[r] = ci; }
    const LAS unsigned char* kb = buf + r32 * 128; const int ksw = (r32 >> 1) & 7;
#pragma unroll
    for (int ks = 0; ks < 4; ++ks) {
        const int ko = ((2 * ks + hi) ^ ksw) * 16;
        const bf16x8 k0f = *(const LAS bf16x8*)(kb + ko), k1f = *(const LAS bf16x8*)(kb + ko + 4096);
        p0 = MFMA32(k0f, q[ks], p0, 0, 0, 0); p1 = MFMA32(k1f, q[ks], p1, 0, 0, 0);
    }
    asm volatile("s_nop 15\n\ts_nop 7" : "+v"(p0), "+v"(p1));
    if (near) {
#pragma unroll
        for (int r = 0; r < 16; ++r) { const int c = (r & 3) + 8 * (r >> 2); p0[r] += nearp[63 - c]; }
        __builtin_amdgcn_sched_barrier(0);
#pragma unroll
        for (int r = 0; r < 16; ++r) { const int c = (r & 3) + 8 * (r >> 2); p1[r] += nearp[31 - c]; }
    }
    __builtin_amdgcn_sched_barrier(0);
    float rm = max3f(p0[0], p1[0], p0[1]), rm2 = max3f(p1[1], p0[2], p1[2]);
#pragma unroll
    for (int r = 3; r < 15; r += 2) { rm = max3f(rm, p0[r], p1[r]); rm2 = max3f(rm2, p0[r + 1], p1[r + 1]); }
    rm = max3f(rm, p0[15], p1[15]); rm = max3f(rm, rm2, rm2);
    rm = swap_max(rm);
    if (S.first || __any(rm > 5.0f)) {
        const float d = S.first ? rm : fmaxf(rm, 0.f);
        const float f = S.first ? 1.f : __builtin_amdgcn_exp2f(-d);
        S.m += d; S.first = 0; S.l *= f; S.o0 *= f; S.o1 *= f;
#pragma unroll
        for (int r = 0; r < 16; ++r) { p0[r] -= d; p1[r] -= d; }
    }
    float ls = 0.f;
#pragma unroll
    for (int r = 0; r < 16; ++r) { p0[r] = __builtin_amdgcn_exp2f(p0[r]); p1[r] = __builtin_amdgcn_exp2f(p1[r]); ls += p0[r] + p1[r]; }
    S.l += ls;
    pa[0] = pack_p(p0, 0); pa[1] = pack_p(p0, 1); pa[2] = pack_p(p1, 0); pa[3] = pack_p(p1, 1);
}
__device__ __forceinline__ void attn_pv(WState& S, const LAS unsigned char* buf, const bf16x8 (&pa)[4], int hi, int lane) {
    const LAS unsigned char* vb = buf + 8192 + ((lane >> 4) & 1) * 32 + (lane & 3) * 8 + (4 * hi + ((lane & 15) >> 2)) * 64;
#pragma unroll
    for (int s4 = 0; s4 < 4; ++s4) {
        const bf16x8 v0 = vfrag(vb + s4 * 1024), v1 = vfrag(vb + 4096 + s4 * 1024);
        S.o0 = MFMA32(v0, pa[s4], S.o0, 0, 0, 0); S.o1 = MFMA32(v1, pa[s4], S.o1, 0, 0, 0);
    }
}
#define STAG_LOOP(NS, ISSUE, QKBLOCK) do { bf16x8 pa[4]; int have = 0; (void)grpB; \
    _Pragma("unroll 1") for (int j = 0; j < (NS); ++j) { \
        RING_STEP_SYNC(j, NS); \
        if (j + 2 < (NS)) { ISSUE(j + 2); } \
        { QKBLOCK(j); } \
        if (have) attn_pv(S, kvb + (j % 3) * 16384, pa, hi, lane); have = 0; \
    } } while (0)

__device__ __forceinline__ void store_ot(bf16* op  , const f32x16& o0, const f32x16& o1) {
#pragma unroll
    for (int k4 = 0; k4 < 4; ++k4) {
        u32x2 w0, w1; w0.x = pk2(o0[4 * k4 + 0], o0[4 * k4 + 1]); w0.y = pk2(o0[4 * k4 + 2], o0[4 * k4 + 3]); w1.x = pk2(o1[4 * k4 + 0], o1[4 * k4 + 1]); w1.y = pk2(o1[4 * k4 + 2], o1[4 * k4 + 3]);
        *(u32x2*)(op + 8 * k4) = w0; *(u32x2*)(op + 32 + 8 * k4) = w1;
    }
}
__device__ __forceinline__ void attn_tables(LAS unsigned char* lds, const float* rel_bias, int tid) {
    LAS float* tab = (LAS float*)(lds + A_TAB);
    for (int e = tid; e < 20 * TABN; e += 512) { const int t = e / TABN, i = e % TABN, dist = i - 96, head = t < 8 ? t : t - 8; const bool win = t >= 8 && t < 16;
        float v = NEGB; if (dist >= 0 && !(win && dist >= 256)) { const int bk = dist >= 128 ? 31 : t5_bucket(dist); v = rel_bias[bk * 12 + head] * LOG2E; }
        tab[e] = v; }
    LAS float* ct = (LAS float*)(lds + A_CTAB);
    for (int e = tid; e < 8 * CTABN; e += 512) { const int hd = e / CTABN, i = e % CTABN; float v = NEGB;
        if (i >= 1 && i <= 129) { const int dist = i - 1; const int bk = dist >= 128 ? 31 : t5_bucket(dist); v = rel_bias[bk * 12 + hd] * LOG2E; }
        ct[e] = v; }
    __syncthreads();
}

__device__ __forceinline__ void nsa_unit(int b, int g, int qb, LAS unsigned char* lds, const bf16* PA, const bf16* KC, const bf16* VC, bf16* OC, int tid) {
    const int lane = tid & 63, wid = __builtin_amdgcn_readfirstlane(tid >> 6), r32 = lane & 31, hi = lane >> 5;
    const int hh = wid & 3, wq = wid >> 2, head = g * 4 + hh, tq0 = 64 * qb + 32 * wq;
    const size_t row = (size_t)b * SEQ + tq0 + r32;
    bf16x8 q[4];
    { const bf16* qp = PA + row * NPA + PA_QN + head * 64 + 8 * hi;
#pragma unroll
      for (int ks = 0; ks < 4; ++ks) q[ks] = *(const bf16x8*)(qp + 16 * ks); }
    const bf16* gp = PA + row * NPA + PA_GN + head * 3;
    const float g0 = bflo(gp[0]), g1 = bflo(gp[1]), g2 = bflo(gp[2]);
    const bf16* Kc = KC + (size_t)((b * 2 + g) * 128) * 64; const bf16* Vc = VC + (size_t)((b * 2 + g) * 128) * 64;
    const bf16* Ks = PA + (size_t)b * SEQ * NPA + PA_KS + g * 64; const bf16* Vs = PA + (size_t)b * SEQ * NPA + PA_VS + g * 64;
    const bf16* Kw = PA + (size_t)b * SEQ * NPA + PA_KW + g * 64; const bf16* Vw = PA + (size_t)b * SEQ * NPA + PA_VW + g * 64;
    LAS unsigned char* kvb = lds + A_KV; LAS unsigned char* cmpb = lds + A_CMP;
    const int nsel = qb + 1, nwin = qb + 1 < 5 ? qb + 1 : 5, ns = nsel + nwin;
#define NSA_ISSUE(j) do { const int j_ = (j); const bool w_ = j_ >= nsel; const int n_ = w_ ? qb - (j_ - nsel) : qb - j_; \
        stage_kv(kvb + (j_ % 3) * 16384, (w_ ? Kw : Ks) + (size_t)(64 * n_) * NPA, (w_ ? Vw : Vs) + (size_t)(64 * n_) * NPA, NPA, wid, lane); } while (0)
    stage_kv(cmpb, Kc, Vc, 64, wid, lane); stage_kv(cmpb + 16384, Kc + 64 * 64, Vc + 64 * 64, 64, wid, lane);
    NSA_ISSUE(0);
    if (ns > 1) { NSA_ISSUE(1); RING_WAIT_BAR(4); } else RING_WAIT_BAR(2);
    OtPk ot;
    {
        f32x16 sc[4];
#pragma unroll
        for (int ph = 0; ph < 4; ++ph) sc[ph] = f32x16{};
#pragma unroll
        for (int t = 0; t < 2; ++t) { const LAS unsigned char* kb = cmpb + t * 16384 + r32 * 128; const int ksw = (r32 >> 1) & 7;
#pragma unroll
            for (int ks = 0; ks < 4; ++ks) { const int ko = ((2 * ks + hi) ^ ksw) * 16; const bf16x8 k0f = *(const LAS bf16x8*)(kb + ko), k1f = *(const LAS bf16x8*)(kb + ko + 4096);
                sc[2 * t] = MFMA32(k0f, q[ks], sc[2 * t], 0, 0, 0); sc[2 * t + 1] = MFMA32(k1f, q[ks], sc[2 * t + 1], 0, 0, 0); } }
        __builtin_amdgcn_sched_barrier(0);
        const LAS float* ct = (const LAS float*)(lds + A_CTAB) + head * CTABN;
        const int E0 = tq0 + r32 - 31 - 64 * hi;
        float m = NEGB;
#pragma unroll
        for (int ph = 0; ph < 4; ++ph)
#pragma unroll
            for (int k4 = 0; k4 < 4; ++k4) { int base = E0 - 16 * (32 * ph + 8 * k4); asm volatile("" : "+v"(base));
#pragma unroll
                for (int i = 0; i < 4; ++i) { int dist = base - 16 * i; dist = dist < -1 ? -1 : (dist > 128 ? 128 : dist);
                    sc[ph][4 * k4 + i] += ct[dist + 1]; m = fmaxf(m, sc[ph][4 * k4 + i]); } }
        m = swap_max(m);
        const bool valid = m > -1e29f;
        float l = 0.f;
#pragma unroll
        for (int ph = 0; ph < 4; ++ph)
#pragma unroll
            for (int r = 0; r < 16; ++r) { const float e = valid ? __builtin_amdgcn_exp2f(sc[ph][r] - m) : 0.f; sc[ph][r] = e; l += e; }
        l = swap_sum(l);
        const float inv = valid ? 1.0f / l : 0.f;
#pragma unroll
        for (int ph = 0; ph < 4; ++ph) sc[ph] *= inv;
        {
            LAS float* impw = (LAS float*)(lds + A_IMP) + (hh * 64 + 32 * wq + r32) * 33;
            float prevhi = 0.f;
#pragma unroll
            for (int i = 0; i < 16; ++i) { const int ph = i >> 2, k = i & 3;
                const float av = sc[ph][4 * k] + sc[ph][4 * k + 1] + sc[ph][4 * k + 2] + 0.5f * sc[ph][4 * k + 3], bv = 0.5f * sc[ph][4 * k + 3];
                auto rr = __builtin_amdgcn_permlane32_swap(__float_as_uint(bv), __float_as_uint(bv), false, false);
                const float lo_i = __uint_as_float(rr[0]), hi_i = __uint_as_float(rr[1]);
                impw[2 * k + hi + 8 * ph] = av + (hi ? lo_i : prevhi); prevhi = hi_i; }
        }
        __builtin_amdgcn_sched_barrier(0);
        f32x16 o0 = f32x16{}, o1 = f32x16{};
#pragma unroll
        for (int ph = 0; ph < 4; ++ph)
#pragma unroll
            for (int s = 0; s < 2; ++s) { const bf16x8 pa = pack_p(sc[ph], s);
                const LAS unsigned char* vb = cmpb + (ph >> 1) * 16384 + 8192 + ((lane >> 4) & 1) * 32 + (lane & 3) * 8 + (4 * hi + ((lane & 15) >> 2)) * 64 + (2 * (ph & 1) + s) * 1024;
                const bf16x8 v0 = vfrag(vb), v1 = vfrag(vb + 4096);
                o0 = MFMA32(v0, pa, o0, 0, 0, 0); o1 = MFMA32(v1, pa, o1, 0, 0, 0); }
        ot_set(ot, o0, o1, g0);
    }
    __syncthreads();
    {
        const LAS float* impb = (const LAS float*)(lds + A_IMP); LAS float* scb = (LAS float*)(lds + A_SC); LAS unsigned* selb = (LAS unsigned*)(lds + A_SEL);
#pragma unroll 1
        for (int it = 0; it < 4; ++it) { const int e = tid + 512 * it, tok = e >> 5, n = e & 31;
            float s = (impb[(0 * 64 + tok) * 33 + n] + impb[(1 * 64 + tok) * 33 + n]) + (impb[(2 * 64 + tok) * 33 + n] + impb[(3 * 64 + tok) * 33 + n]);
            const bool forced = (n == 0) | (n == qb) | (n == qb - 1);
            s = forced ? 1e4f : (n <= qb ? s : NEGB);
            scb[tok * 33 + n] = s;
            LDS_WAIT();
            int rank = 0;
#pragma unroll 8
            for (int mm = 0; mm < 32; ++mm) { const float sm = scb[tok * 33 + mm]; rank += ((sm > s) | ((sm == s) & (mm < n))) ? 1 : 0; }
            const bool sel = (rank < 8) && (s > -5e29f);
            const unsigned long long bal = __ballot(sel);
            if ((lane & 31) == 0) selb[tok] = (unsigned)(bal >> (lane & 32));
        }
    }
    __syncthreads();
    const unsigned mymask = ((const LAS unsigned*)(lds + A_SEL))[32 * wq + r32];
    const LAS float* tabC = (const LAS float*)(lds + A_TAB) + head * TABN; const LAS float* tabW = (const LAS float*)(lds + A_TAB) + (8 + head) * TABN;
    const float cfar = tabC[96 + 128];
    WState S; ws_reset(S);
    LOADED4(q); LOADED1(g1); LOADED1(g2);
    const int grpB = wq;
#define NSA_QK(j) do { \
        if ((j) == nsel) { const float lt = swap_sum(S.l); ot_add(ot, S.o0, S.o1, g1 / lt); ws_reset(S); } \
        const bool win = (j) >= nsel; const int n = win ? qb - ((j) - nsel) : qb - (j); const int a = (tq0 - 64 * n) >> 5; \
        const LAS unsigned char* buf = kvb + ((j) % 3) * 16384; const int D0 = tq0 + r32 - 64 * n - 4 * hi; \
        if (!win) { const bool near = a < 6; const float cadd = (((mymask >> n) & 1u) ? 0.f : NEGB) + (near ? 0.f : cfar); attn_qk(S, q, buf, cadd, near, tabC + (D0 + 33), r32, hi, pa); have = 1; } \
        else if (a < 10) { const bool far = (a == 6) | (a == 7); attn_qk(S, q, buf, far ? cfar : 0.f, !far, tabW + (D0 + 33), r32, hi, pa); have = 1; } } while (0)
    STAG_LOOP(ns, NSA_ISSUE, NSA_QK);
#undef NSA_QK
    { const float lt = swap_sum(S.l); ot_add(ot, S.o0, S.o1, g2 / lt); }
    ot_store(OC + row * DM + head * 64 + 4 * hi, ot);
    __syncthreads();
#undef NSA_ISSUE
}

__device__ __forceinline__ void moba_unit(int b, int h, int ob, LAS unsigned char* lds, const bf16* PA, const float* KMEAN, bf16* OC, int tid) {
    const int lane = tid & 63, wid = __builtin_amdgcn_readfirstlane(tid >> 6), r32 = lane & 31, hi = lane >> 5;
    const int tq0 = 256 * ob + 32 * wid;
    const size_t row = (size_t)b * SEQ + tq0 + r32;
    bf16x8 q[4];
    { const bf16* qp = PA + row * NPA + PA_QM + h * 64 + 8 * hi;
#pragma unroll
      for (int ks = 0; ks < 4; ++ks) q[ks] = *(const bf16x8*)(qp + 16 * ks); }
    const bf16* Km = PA + (size_t)b * SEQ * NPA + PA_KM + h * 64; const bf16* Vm = PA + (size_t)b * SEQ * NPA + PA_VM + h * 64;
    LAS unsigned char* kvb = lds + A_KV;
    const int ns = 4 * (ob + 1);
#define MOBA_ISSUE(j) do { const int j_ = (j); const int n_ = ns - 1 - j_; stage_kv(kvb + (j_ % 3) * 16384, Km + (size_t)(64 * n_) * NPA, Vm + (size_t)(64 * n_) * NPA, NPA, wid, lane); } while (0)
    MOBA_ISSUE(0); MOBA_ISSUE(1);
    LAS float* km = (LAS float*)(lds + A_KMEAN); LAS float* mg = (LAS float*)(lds + A_MG);
    km[tid] = KMEAN[(size_t)(b * 4 + h) * 512 + tid];
    __syncthreads();
    {
        const int tok = tid >> 1, hf = tid & 1; const bf16* qrow = PA + ((size_t)b * SEQ + 256 * ob + tok) * NPA + PA_QM + h * 64;
        f32x4 acc = {0.f, 0.f, 0.f, 0.f};
#pragma unroll 1
        for (int c8 = 0; c8 < 8; ++c8) { const u32x4 w = *(const u32x4*)(qrow + 8 * c8); f32x4 qa, qb_; pg8::unpack8(w, qa, qb_);
#pragma unroll
            for (int i = 0; i < 4; ++i) { const LAS float* kp = km + (4 * hf + i) * 64 + 8 * c8; const f32x4 ka = *(const LAS f32x4*)kp, kb = *(const LAS f32x4*)(kp + 4);
                acc[i] += (qa.x * ka.x + qa.y * ka.y) + (qa.z * ka.z + qa.w * ka.w) + (qb_.x * kb.x + qb_.y * kb.y) + (qb_.z * kb.z + qb_.w * kb.w); } }
        *(LAS f32x4*)(mg + tok * 8 + 4 * hf) = acc;
    }
    __syncthreads();
    unsigned mymask = 0u;
    { const LAS float* gp = mg + (32 * wid + r32) * 8; const f32x4 ga = *(const LAS f32x4*)gp, gb = *(const LAS f32x4*)(gp + 4);
      const float gt[8] = {ga.x, ga.y, ga.z, ga.w, gb.x, gb.y, gb.z, gb.w};
#pragma unroll
      for (int n = 0; n < 8; ++n) { int rank = 0;
#pragma unroll
          for (int mm = 0; mm < 8; ++mm) rank += ((mm < ob) & ((gt[mm] > gt[n]) | ((gt[mm] == gt[n]) & (mm < n)))) ? 1 : 0;
          if ((n < ob) & (rank < 3)) mymask |= 1u << n; } }
    const LAS float* tabM = (const LAS float*)(lds + A_TAB) + (16 + h) * TABN;
    const float cfar = tabM[96 + 128];
    WState S; ws_reset(S);
    LOADED4(q);
    const int grpB = wid >> 2;
#define MOBA_QK(j) do { const int n = ns - 1 - (j), blk = n >> 2; \
        if (tq0 + 31 - 64 * n >= 0) { const int a = (tq0 - 64 * n) >> 5; const bool near = a < 6; float cadd = near ? 0.f : cfar; \
            if (blk < ob) cadd += ((mymask >> blk) & 1u) ? 0.f : NEGB; \
            const int D0 = tq0 + r32 - 64 * n - 4 * hi; \
            attn_qk(S, q, kvb + ((j) % 3) * 16384, cadd, near, tabM + (D0 + 33), r32, hi, pa); have = 1; } } while (0)
    STAG_LOOP(ns, MOBA_ISSUE, MOBA_QK);
#undef MOBA_QK
    { const float lt = swap_sum(S.l); const float scl = 1.0f / lt; S.o0 *= scl; S.o1 *= scl; }
    store_ot(OC + row * DM + 512 + h * 64 + 4 * hi, S.o0, S.o1);
    __syncthreads();
#undef MOBA_ISSUE
}

__device__ __forceinline__ void mem_unit(int b, int h, int tb, LAS unsigned char* lds, const bf16* PA, const bf16* MKV, bf16* OC, int tid) {
    const int lane = tid & 63, wid = __builtin_amdgcn_readfirstlane(tid >> 6), r32 = lane & 31, hi = lane >> 5;
    const int tq0 = 256 * tb + 32 * wid;
    const size_t row = (size_t)b * SEQ + tq0 + r32;
    bf16x8 q[4];
    { const bf16* qp = PA + row * NPA + PA_QX + h * 64 + 8 * hi;
#pragma unroll
      for (int ks = 0; ks < 4; ++ks) q[ks] = *(const bf16x8*)(qp + 16 * ks); }
    const bf16* Kx = MKV + (size_t)b * MEML * 1024 + h * 64; const bf16* Vx = Kx + 256;
    LAS unsigned char* kvb = lds + A_KV;
    stage_kv(kvb, Kx, Vx, 1024, wid, lane); stage_kv(kvb + 16384, Kx + (size_t)64 * 1024, Vx + (size_t)64 * 1024, 1024, wid, lane);
    WState S; ws_reset(S);
    LOADED4(q);
    const int grpB = wid >> 2;
#define MEM_ISSUE(j) stage_kv(kvb + ((j) % 3) * 16384, Kx + (size_t)(64 * (j)) * 1024, Vx + (size_t)(64 * (j)) * 1024, 1024, wid, lane)
#define MEM_QK(j) do { attn_qk(S, q, kvb + ((j) % 3) * 16384, 0.f, false, (const LAS float*)(lds + A_TAB), r32, hi, pa); have = 1; } while (0)
    STAG_LOOP(4, MEM_ISSUE, MEM_QK);
#undef MEM_QK
#undef MEM_ISSUE
    { const float lt = swap_sum(S.l); const float scl = 1.0f / lt; S.o0 *= scl; S.o1 *= scl; }
    store_ot(OC + row * DM + 768 + h * 64 + 4 * hi, S.o0, S.o1);
    __syncthreads();
}

#ifndef MK_MULTI_LAUNCH
#define MK_MULTI_LAUNCH 0
#endif
constexpr int N_PHASES = 20;
__device__ __forceinline__ int lane_now() { unsigned z = 0u; asm volatile("" : "+s"(z)); return (int)__builtin_amdgcn_mbcnt_hi(~0u, __builtin_amdgcn_mbcnt_lo(~0u, z)); }
struct Args { const float* in[23]; float* out; unsigned char* ws; int ph_lo, ph_hi; };

__global__ void __launch_bounds__(512, 2) fwd_kernel(Args args) {
    extern __shared__ __attribute__((aligned(16))) unsigned char lds_raw[];
    LAS unsigned char* lds = (LAS unsigned char*)lds_raw;
    volatile LAS unsigned* MISC = (volatile LAS unsigned*)(lds + MISC_OFF);
    const int wave = __builtin_amdgcn_readfirstlane((int)threadIdx.x >> 6);
#define TID_NOW (wave * 64 + lane_now())
    const int G = gridDim.x, bx_k = blockIdx.x; const int vcu_k = (G % 8 == 0) ? (bx_k % 8) * (G / 8) + bx_k / 8 : bx_k;
    unsigned* ctl = (unsigned*)(args.ws + WS_CTL);
    for (int u = threadIdx.x; u < (LDS_BYTES - MISC_OFF) / 4; u += 512) MISC[u] = 0u;
    __syncthreads();
    const int lo = args.ph_lo, hi = args.ph_hi;
    XcdBarrier bar; bar.bar = ctl + CW_BAR; bar.x = 0; bar.st = nullptr;
    if (hi - lo > 1) bar = xcd_barrier_post(ctl + CW_BAR, MISC + 8);
#ifndef ATT_EN
#define ATT_EN 7
#endif
#ifndef REP_J
#define REP_J -1
#endif
#define NREP(j) ((REP_J) == (j) ? 2 : 1)
#ifndef PHMASK
#define PHMASK 0x3ff
#endif
#define IN(k) (lo <= (k) && (k) < hi)
#define INJ(j) (((PHMASK >> ((j) + 1)) & 1) && IN(pb + (j)))
#define SEAM(k) do { if (IN(k) && IN((k) + 1)) xcd_barrier(bar); } while (0)
    typedef const __attribute__((address_space(4))) unsigned char* kaptr_t;
#define KA_DECL kaptr_t ka = (kaptr_t)__builtin_amdgcn_kernarg_segment_ptr(); int bx = bx_k, vcu = vcu_k, gw = gw_k; asm volatile("" : "+s"(ka), "+s"(bx), "+s"(vcu), "+s"(gw)); unsigned char* ws = *(unsigned char* const __attribute__((address_space(4)))*)(ka + 192)
#define KIN(i) (*(const float* const __attribute__((address_space(4)))*)(ka + 8 * (i)))
#define KOUT (*(float* const __attribute__((address_space(4)))*)(ka + 184))
    const int gw_k = vcu_k * 8 + wave, NGW = G * 8;

    if ((PHMASK & 1) && IN(0)) for (int rep_ = 0; rep_ < ((REP_J) == 100 ? 2 : 1); ++rep_) {
        const int lane = TID_NOW & 63;
        KA_DECL; const float* x_in = KIN(0); const float* mem_in = KIN(1); const float* pre_mix_g = KIN(3); const float* mem_norm_g = KIN(4); bf16* MEMN = (bf16*)KOUT; unsigned char* H8 = ws + WS_H; float* SA = (float*)(ws + WS_SA); unsigned* CMAX = (unsigned*)(ws + WS_CTL) + CW_CMAX;
        LAS float* scr = (LAS float*)(lds + wave * 16384);
        if ((gw & 7) == 0 && (gw >> 3) < 8) {
            const int t = gw >> 3, l = t >> 2, kv = (t >> 1) & 1, nh = t & 1, n = 64 * nh + lane;
            const float* pos = KIN(kv ? 10 : 7) + (size_t)l * 2048; const float* w1 = KIN(kv ? 11 : 8) + (size_t)l * 2048 * 128;
            float acc = 0.f;
#pragma unroll 8
            for (int k = 0; k < 2048; ++k) acc += pos[k] * w1[(size_t)k * 128 + n];
            ((float*)(ws + WS_W + l * WL_STRIDE + (kv ? WL_POSV : WL_POSK)))[n] = acc;
        }
        for (int l = 0; l < 2; ++l) {
            unsigned char* wl = ws + WS_W + l * WL_STRIDE;
#pragma unroll 1
            for (int mi = 0; mi < 12; ++mi) {
                int kind = 0, Ksrc = 0, ldw = 0, Ndst = 0, ldt = 0, kdst = 0; const float* W = nullptr; const float* W2 = nullptr; bf16* WT = nullptr; const float* kgain = nullptr;
                switch (mi) {
                    case 0: kind = 1; W = KIN(6) + (size_t)l * 1024 * INW; Ksrc = 1024; ldw = INW; Ndst = NIN; WT = (bf16*)(wl + WL_IN); ldt = 1024; break;
                    case 1: kind = 2; W = KIN(20) + (size_t)l * 1024 * DFF; W2 = KIN(21) + (size_t)l * 1024 * DFF; Ksrc = 1024; ldw = DFF; Ndst = NGU; WT = (bf16*)(wl + WL_GU); ldt = 1024; break;
                    case 2: W = KIN(22) + (size_t)l * DFF * 1024; Ksrc = DFF; ldw = 1024; Ndst = 1024; WT = (bf16*)(wl + WL_DN); ldt = DFF; break;
                    case 3: W = KIN(14) + (size_t)l * 512 * 1024; Ksrc = 512; ldw = 1024; Ndst = 1024; WT = (bf16*)(wl + WL_BR); ldt = 1024; kdst = 0; break;
                    case 4: W = KIN(15) + (size_t)l * 256 * 1024; Ksrc = 256; ldw = 1024; Ndst = 1024; WT = (bf16*)(wl + WL_BR); ldt = 1024; kdst = 512; break;
                    case 5: W = KIN(16) + (size_t)l * 256 * 1024; Ksrc = 256; ldw = 1024; Ndst = 1024; WT = (bf16*)(wl + WL_BR); ldt = 1024; kdst = 768; break;
                    case 6: W = KIN(17) + (size_t)l * 1024 * 1024; Ksrc = 1024; ldw = 1024; Ndst = 1024; WT = (bf16*)(wl + WL_MIX); ldt = 1024; break;
                    case 7: W = KIN(13) + (size_t)l * 1024 * 512; Ksrc = 1024; ldw = 512; Ndst = 512; WT = (bf16*)(ws + WS_MKV2) + (size_t)l * 512 * 1024; ldt = 1024; kgain = mem_norm_g + l * DM; break;
                    case 8: W = KIN(8) + (size_t)l * 2048 * 128; Ksrc = 2048; ldw = 128; Ndst = 128; WT = (bf16*)(wl + WL_W1K); ldt = 2048; break;
                    case 9: W = KIN(11) + (size_t)l * 2048 * 128; Ksrc = 2048; ldw = 128; Ndst = 128; WT = (bf16*)(wl + WL_W1V); ldt = 2048; break;
                    case 10: W = KIN(9) + (size_t)l * 128 * 64; Ksrc = 128; ldw = 64; Ndst = 64; WT = (bf16*)(wl + WL_W2K); ldt = 128; break;
                    default: W = KIN(12) + (size_t)l * 128 * 64; Ksrc = 128; ldw = 64; Ndst = 64; WT = (bf16*)(wl + WL_W2V); ldt = 128; break;
                }
                tr_matrix(kind, W, W2, Ksrc, ldw, Ndst, WT, ldt, kdst, scr, gw, NGW, lane, mi < 2 ? CMAX + (l * 2 + mi) * NIN : (unsigned*)nullptr, kgain);
            }
        }
        for (int m0 = 4 * gw; m0 < NMEM; m0 += 4 * NGW) {
            const float* xr[4] = {mem_in + (size_t)m0 * DM, mem_in + (size_t)(m0 + 1) * DM, mem_in + (size_t)(m0 + 2) * DM, mem_in + (size_t)(m0 + 3) * DM};
            bf16* orow[4] = {MEMN + (size_t)m0 * DM, MEMN + (size_t)(m0 + 1) * DM, MEMN + (size_t)(m0 + 2) * DM, MEMN + (size_t)(m0 + 3) * DM};
            rms_rows_bf16<4>(xr, (const float*)nullptr, orow, lane); }
        for (int m0 = 4 * gw; m0 < NTOK; m0 += 4 * NGW) {
            const float* xr[4] = {x_in + (size_t)m0 * DM, x_in + (size_t)(m0 + 1) * DM, x_in + (size_t)(m0 + 2) * DM, x_in + (size_t)(m0 + 3) * DM};
            unsigned char* orow[4] = {H8 + (size_t)m0 * DM, H8 + (size_t)(m0 + 1) * DM, H8 + (size_t)(m0 + 2) * DM, H8 + (size_t)(m0 + 3) * DM};
            float* sap[4] = {SA + m0, SA + m0 + 1, SA + m0 + 2, SA + m0 + 3};
            rms_rows_i8<4>(xr, pre_mix_g, orow, sap, lane); }
    }
    SEAM(0);
    if ((PHMASK & 1) && IN(1)) {
        const int lane = TID_NOW & 63;
        KA_DECL; const unsigned* CMAX = (const unsigned*)(ws + WS_CTL) + CW_CMAX;
        for (int r = gw; r < 4 * NIN; r += NGW) { const int lm = r / NIN, n = r % NIN, l = lm >> 1, mat = lm & 1;
            unsigned char* wl = ws + WS_W + l * WL_STRIDE; unsigned char* rowp = wl + (mat ? WL_GU : WL_IN) + (size_t)n * 2048;
            const u32x4 w0 = *((const u32x4*)rowp + 2 * lane), w1 = *((const u32x4*)rowp + 2 * lane + 1);
            const float am = __uint_as_float(CMAX[r]); const float inv = am > 0.f ? 127.f / am : 0.f;
            f32x4 a, b, c, d; pg8::unpack8(w0, a, b); pg8::unpack8(w1, c, d);
            u32x4 o; o.x = q8x4(a, inv); o.y = q8x4(b, inv); o.z = q8x4(c, inv); o.w = q8x4(d, inv);
            asm volatile("" ::: "memory");
            *((u32x4*)rowp + lane) = o;
            if (lane == 0) ((float*)(wl + (mat ? WL_SBGU : WL_SBIN)))[n] = am > 0.f ? am * (1.f / 127.f) : 1.f; }
    }
    SEAM(1);

#pragma unroll 1
    for (int l = 0; l < 2; ++l) {
        const int pb = 2 + 9 * l;
        if (INJ(0)) for (int rep_ = 0; rep_ < NREP(0); ++rep_) {
            KA_DECL; unsigned char* wl = ws + WS_W + l * WL_STRIDE; bf16* H = (bf16*)(ws + WS_H); bf16* PA = (bf16*)(ws + WS_PA); bf16* GT = (bf16*)(ws + WS_GT); bf16* MEMN = (bf16*)KOUT; bf16* MEMKV = (bf16*)(ws + WS_MEMKV);
            { pg8::Gemm g{H, (const bf16*)(wl + WL_IN), NTOK, NIN, 512, 512, 1024}; pg8::StaticOrder S; S.init(NTOK, NIN, G, bx);
              pg8::EpiProj E{PA, GT, (const float*)(ws + WS_SA), (const float*)(wl + WL_SBIN)}; pg8::gemm_phase<pg8::EpiProj, pg8::StaticOrder, true, true, true>(lds, g, S, E, wave); }
            if (l == 0) { pg8::Gemm g{MEMN, (const bf16*)(ws + WS_MKV2), NMEM, 1024, 1024, 1024, 1024};
                pg8::StaticOrder S; S.init(NMEM, 1024, G, bx); pg8::EpiPlain E{MEMKV, 1024};
                pg8::gemm_phase<pg8::EpiPlain, pg8::StaticOrder, true, true>(lds, g, S, E, wave); }
        }
        SEAM(pb + 0);
        if (INJ(1)) for (int rep_ = 0; rep_ < NREP(1); ++rep_) {
            int tid_p = TID_NOW; asm volatile("" : "+v"(tid_p));
            KA_DECL; unsigned char* wl = ws + WS_W + l * WL_STRIDE; bf16* PA = (bf16*)(ws + WS_PA); bf16* KC = (bf16*)(ws + WS_KC); bf16* VC = (bf16*)(ws + WS_VC); float* KMEAN = (float*)(ws + WS_KMEAN);
            for (int u = bx; u < 256; u += G) {
                if (u < 128) compress_unit(u, lds, PA, wl, KC, VC, tid_p);
                else kmean_unit((u - 128) >> 3, (u - 128) & 7, lds, PA, KMEAN, tid_p);
            }
        }
        SEAM(pb + 1);
        if (INJ(2)) for (int rep_ = 0; rep_ < NREP(2); ++rep_) {
            int tid_p = TID_NOW; asm volatile("" : "+v"(tid_p));
            KA_DECL; const float* rel_bias = KIN(2); bf16* H = (bf16*)(ws + WS_H); bf16* PA = (bf16*)(ws + WS_PA); bf16* KC = (bf16*)(ws + WS_KC); bf16* VC = (bf16*)(ws + WS_VC); float* KMEAN = (float*)(ws + WS_KMEAN); bf16* MEMKV = (bf16*)(ws + WS_MEMKV);
            attn_tables(lds, rel_bias, tid_p);
            if (ATT_EN & 1) for (int rp_ = 0; rp_ < ((REP_J) == 20 ? 2 : 1); ++rp_)
#pragma unroll 1
            for (int P = vcu; P < 512; P += G) { const int bg = P >> 4, s = P & 15;
#pragma unroll 1
                for (int k = 0; k < 2; ++k) nsa_unit(bg >> 1, bg & 1, k ? 31 - s : s, lds, PA, KC, VC, H, tid_p); }
            if (ATT_EN & 2) for (int rp_ = 0; rp_ < ((REP_J) == 21 ? 2 : 1); ++rp_)
#pragma unroll 1
            for (int M = vcu; M < 256; M += G) { const int bh = M >> 2, s = M & 3;
#pragma unroll 1
                for (int k = 0; k < 2; ++k) moba_unit(bh >> 2, bh & 3, k ? 7 - s : s, lds, PA, KMEAN, H, tid_p); }
            if (ATT_EN & 4) for (int rp_ = 0; rp_ < ((REP_J) == 22 ? 2 : 1); ++rp_)
#pragma unroll 1
            for (int u = vcu; u < 512; u += G) { const int bh = u >> 3; mem_unit(bh >> 2, bh & 3, u & 7, lds, PA, MEMKV + l * 512, H, tid_p); }
        }
        SEAM(pb + 2);
        if (INJ(3)) for (int rep_ = 0; rep_ < NREP(3); ++rep_) {
            KA_DECL; unsigned char* wl = ws + WS_W + l * WL_STRIDE; bf16* H = (bf16*)(ws + WS_H); bf16* MERGED = (bf16*)(ws + WS_PA); bf16* GT = (bf16*)(ws + WS_GT);
            pg8::Gemm g{H, (const bf16*)(wl + WL_BR), NTOK, 1024, 1024, 1024, 1024}; pg8::StaticOrder S; S.init(NTOK, 1024, G, bx);
            pg8::EpiMerge1P E{MERGED, 1024, (const unsigned char*)GT, NGT, 8, 12};
            pg8::gemm_phase<pg8::EpiMerge1P, pg8::StaticOrder, true, true>(lds, g, S, E, wave);
        }
        SEAM(pb + 3);
        if (INJ(4)) for (int rep_ = 0; rep_ < NREP(4); ++rep_) {
            KA_DECL; unsigned char* wl = ws + WS_W + l * WL_STRIDE; bf16* MERGED = (bf16*)(ws + WS_PA); bf16* YB = (bf16*)(ws + WS_GT);
            pg8::Gemm g{MERGED, (const bf16*)(wl + WL_MIX), NTOK, 1024, 1024, 1024, 1024}; pg8::StaticOrder S; S.init(NTOK, 1024, G, bx);
            pg8::EpiPlain E{YB, 1024}; pg8::gemm_phase<pg8::EpiPlain, pg8::StaticOrder, true, true>(lds, g, S, E, wave);
        }
        SEAM(pb + 4);
        if (INJ(5)) for (int rep_ = 0; rep_ < (((REP_J) == 5 && l == 0) ? 2 : 1); ++rep_) {
            int lane_p = TID_NOW & 63; asm volatile("" : "+v"(lane_p));
            KA_DECL; float* xres = KOUT; const float* post_mix_g = KIN(5); const float* pre_ffn_g = KIN(18); bf16* YB = (bf16*)(ws + WS_GT); unsigned char* H8 = ws + WS_H; float* SA = (float*)(ws + WS_SA);
            unsigned char* XB0 = (unsigned char*)xres; unsigned char* XB1 = ws + WS_PA + 64 * MiB;
            for (int m0 = 2 * gw; m0 < NTOK; m0 += 2 * NGW) {
                const bf16* sr[2] = {YB + (size_t)m0 * DM, YB + (size_t)(m0 + 1) * DM};
                unsigned char* ho[2] = {H8 + (size_t)m0 * DM, H8 + (size_t)(m0 + 1) * DM}; float* sap[2] = {SA + m0, SA + m0 + 1};
                if (l == 0) { const void* xi[2] = {KIN(0) + (size_t)m0 * DM, KIN(0) + (size_t)(m0 + 1) * DM}; void* xo[2] = {XB0 + (size_t)m0 * DM * 2, XB0 + (size_t)(m0 + 1) * DM * 2};
                    norm_res_norm<2, true, false>(sr, post_mix_g + l * DM, xi, xo, pre_ffn_g + l * DM, ho, sap, true, lane_p); }
                else { const void* xi[2] = {XB0 + (size_t)m0 * DM * 2, XB0 + (size_t)(m0 + 1) * DM * 2}; void* xo[2] = {XB1 + (size_t)m0 * DM * 2, XB1 + (size_t)(m0 + 1) * DM * 2};
                    norm_res_norm<2, false, false>(sr, post_mix_g + l * DM, xi, xo, pre_ffn_g + l * DM, ho, sap, true, lane_p); } }
        }
        SEAM(pb + 5);
        if (INJ(6)) for (int rep_ = 0; rep_ < NREP(6); ++rep_) {
            KA_DECL; unsigned char* wl = ws + WS_W + l * WL_STRIDE; bf16* H = (bf16*)(ws + WS_H); bf16* UB = (bf16*)(ws + WS_GT);
            pg8::Gemm g{H, (const bf16*)(wl + WL_GU), NTOK, NGU, 512, 512, 1024}; pg8::StaticOrder S; S.init(NTOK, NGU, G, bx);
            pg8::EpiSwiGLU E{UB, DFF, (const float*)(ws + WS_SA), (const float*)(wl + WL_SBGU)}; pg8::gemm_phase<pg8::EpiSwiGLU, pg8::StaticOrder, true, true, true>(lds, g, S, E, wave);
        }
        SEAM(pb + 6);
        if (INJ(7)) for (int rep_ = 0; rep_ < NREP(7); ++rep_) {
            KA_DECL; unsigned char* wl = ws + WS_W + l * WL_STRIDE; bf16* UB = (bf16*)(ws + WS_GT); bf16* FB = (bf16*)(ws + WS_PA);
            pg8::Gemm g{UB, (const bf16*)(wl + WL_DN), NTOK, 1024, DFF, DFF, DFF}; pg8::StaticOrder S; S.init(NTOK, 1024, G, bx);
            pg8::EpiPlain E{FB, 1024}; pg8::gemm_phase<pg8::EpiPlain, pg8::StaticOrder, true, true>(lds, g, S, E, wave);
        }
        SEAM(pb + 7);
        if (INJ(8)) {
            int lane_p = TID_NOW & 63; asm volatile("" : "+v"(lane_p));
            KA_DECL; float* xres = KOUT; const float* post_ffn_g = KIN(19); const float* pre_mix_g = KIN(3); bf16* FB = (bf16*)(ws + WS_PA); unsigned char* H8 = ws + WS_H; float* SA = (float*)(ws + WS_SA);
            unsigned char* XB0 = (unsigned char*)xres; unsigned char* XB1 = ws + WS_PA + 64 * MiB;
            for (int m0 = 2 * gw; m0 < NTOK; m0 += 2 * NGW) {
                const bf16* sr[2] = {FB + (size_t)m0 * DM, FB + (size_t)(m0 + 1) * DM};
                unsigned char* ho[2] = {H8 + (size_t)m0 * DM, H8 + (size_t)(m0 + 1) * DM}; float* sap[2] = {SA + m0, SA + m0 + 1};
                if (l == 0) { const void* xi[2] = {XB0 + (size_t)m0 * DM * 2, XB0 + (size_t)(m0 + 1) * DM * 2}; void* xo[2] = {XB0 + (size_t)m0 * DM * 2, XB0 + (size_t)(m0 + 1) * DM * 2};
                    norm_res_norm<2, false, false>(sr, post_ffn_g + l * DM, xi, xo, pre_mix_g + DM, ho, sap, true, lane_p); }
                else { const void* xi[2] = {XB1 + (size_t)m0 * DM * 2, XB1 + (size_t)(m0 + 1) * DM * 2}; void* xo[2] = {xres + (size_t)m0 * DM, xres + (size_t)(m0 + 1) * DM};
                    norm_res_norm<2, false, true>(sr, post_ffn_g + l * DM, xi, xo, pre_mix_g + DM, ho, sap, false, lane_p); } }
        }
        SEAM(pb + 8);
    }
#undef IN
#undef INJ
#undef SEAM
}

extern "C" void kernel_launch(void* const* d_in, const int* in_sizes, int n_in, void* d_out, int out_size, void* d_ws, size_t ws_size, hipStream_t stream) {
    static int grid = 0;
    if (grid == 0) {
        if (n_in != 23 || in_sizes[0] != NTOK * DM || out_size != NTOK * DM || ws_size < WS_END) { fprintf(stderr, "kernel_launch: unexpected shapes (n_in %d, in0 %d, out %d, ws %zu); nothing launched\n", n_in, n_in > 0 ? in_sizes[0] : -1, out_size, ws_size); grid = -1; return; }
        int dev = 0, cus = 0, per_cu = 0;
        if (hipGetDevice(&dev) != hipSuccess || hipDeviceGetAttribute(&cus, hipDeviceAttributeMultiprocessorCount, dev) != hipSuccess) { grid = -1; return; }
        if (hipFuncSetAttribute((const void*)fwd_kernel, hipFuncAttributeMaxDynamicSharedMemorySize, LDS_BYTES) != hipSuccess) { fprintf(stderr, "kernel_launch: hipFuncSetAttribute failed\n"); grid = -1; return; }
        if (hipOccupancyMaxActiveBlocksPerMultiprocessor(&per_cu, (const void*)fwd_kernel, 512, LDS_BYTES) != hipSuccess || per_cu < 1) fprintf(stderr, "kernel_launch: occupancy query reports %d\n", per_cu);
        (void)hipGetLastError();
        grid = cus;
    }
    if (grid < 0) return;
    if (hipMemsetAsync((char*)d_ws + WS_CTL, 0, CTL_ZERO_BYTES, stream) != hipSuccess) return;
    Args a{};
    for (int i = 0; i < 23; ++i) a.in[i] = (const float*)d_in[i];
    a.out = (float*)d_out; a.ws = (unsigned char*)d_ws;
#if MK_MULTI_LAUNCH
    for (int p = 0; p < N_PHASES; ++p) { a.ph_lo = p; a.ph_hi = p + 1; hipLaunchKernelGGL(fwd_kernel, dim3(grid), dim3(512), LDS_BYTES, stream, a); }
#else
    a.ph_lo = 0; a.ph_hi = N_PHASES;
    hipLaunchKernelGGL(fwd_kernel, dim3(grid), dim3(512), LDS_BYTES, stream, a);
#endif
    const hipError_t le = hipPeekAtLastError();
    if (le != hipSuccess) fprintf(stderr, "kernel_launch: launch failed: %s\n", hipGetErrorName(le));
}
```

```cpp
#include <hip/hip_runtime.h>
#include <cstdio>
#include <cstdint>

#define LAS __attribute__((address_space(3)))
#define GAS __attribute__((address_space(1)))
typedef unsigned short bf16;
typedef short bf16x8 __attribute__((ext_vector_type(8)));
typedef short s16x4 __attribute__((ext_vector_type(4)));
typedef float f32x2 __attribute__((ext_vector_type(2)));
typedef float f32x4 __attribute__((ext_vector_type(4)));
typedef float f32x16 __attribute__((ext_vector_type(16)));
typedef unsigned u32x2 __attribute__((ext_vector_type(2)));
typedef unsigned u32x4 __attribute__((ext_vector_type(4)));

constexpr int BATCH = 16, SEQ = 2048, DM = 1024, NTOK = BATCH * SEQ;
constexpr int NPA = 2560;
constexpr int NGT = 3072;
constexpr int NIN = NPA + NGT;
constexpr int INW = 5400;
constexpr int DFF = 2816, NGU = 2 * DFF;
constexpr int MEML = 256, NMEM = BATCH * MEML;
constexpr int PA_QN = 0, PA_KC = 512, PA_VC = 640, PA_KS = 768, PA_VS = 896, PA_KW = 1024, PA_VW = 1152;
constexpr int PA_QM = 1280, PA_KM = 1536, PA_VM = 1792, PA_QX = 2048, PA_GN = 2304;
constexpr float RMS_EPS = 1e-6f;
constexpr float LOG2E = 1.4426950408889634f;
constexpr float C2 = 0.125f * LOG2E;
constexpr float NEGB = -1e30f;

constexpr size_t MiB = 1u << 20;
constexpr size_t WS_CTL = 0, CTL_ZERO_BYTES = 1 * MiB;
constexpr size_t WS_W = 1 * MiB;
constexpr size_t WL_STRIDE = 35 * MiB;
constexpr size_t WL_IN = 0, WL_GU = 11 * MiB, WL_DN = 22 * MiB, WL_BR = 28 * MiB, WL_MIX = 30 * MiB, WL_MKV = 32 * MiB, WL_W1K = 33 * MiB, WL_W1V = 33 * MiB + 512 * 1024;
constexpr size_t WL_SM = 34 * MiB;
constexpr size_t WL_W2K = WL_SM, WL_W2V = WL_SM + 16384, WL_POSK = WL_SM + 32768, WL_POSV = WL_SM + 32768 + 512;
constexpr size_t WS_MEMKV = 71 * MiB;
constexpr size_t WS_KC = 79 * MiB, WS_VC = 79 * MiB + 512 * 1024;
constexpr size_t WS_KMEAN = 80 * MiB;
constexpr size_t WS_H = 81 * MiB;
constexpr size_t WS_PA = 145 * MiB;
constexpr size_t WS_GT = 305 * MiB;
constexpr size_t WS_MKV2 = 497 * MiB;
constexpr size_t WS_END = 499 * MiB;
static_assert(WL_DN + (size_t)DM * DFF * 2 <= WL_BR && WS_W + 2 * WL_STRIDE <= WS_MEMKV && WS_H + (size_t)NTOK * DM * 2 <= WS_PA && WS_PA + (size_t)NTOK * NPA * 2 <= WS_GT && WS_GT + (size_t)NTOK * NGT * 2 <= WS_MKV2, "ws map");
constexpr int CW_TMO = 0, CW_BAR = 4096;
constexpr int CW_CMAX = 16384;
constexpr size_t WL_SBIN = WL_SM + 65536, WL_SBGU = WL_SM + 98304;
constexpr size_t WS_POSP = WS_KMEAN + 256 * 1024;
constexpr size_t WS_SA = WS_KMEAN + 512 * 1024;
static_assert((CW_CMAX + 4 * NIN) * 4 <= (int)CTL_ZERO_BYTES && WL_SBGU + NIN * 4 <= WL_STRIDE && WS_SA + NTOK * 4 <= WS_H, "int8 side tables");

constexpr int RING_BYTES = 131072;
constexpr int MISC_OFF = 156672;
constexpr int LDS_BYTES = 157696;
constexpr int A_KV = 0, A_CMP = 49152, A_TAB = 81920, A_CTAB = 117760, A_IMP = 121984, A_SC = 32768, A_SEL = 32768 + 8448, A_KMEAN = A_IMP, A_MG = A_IMP + 2048;
constexpr int TABN = 448, CTABN = 132;
static_assert(A_IMP + 4 * 64 * 33 * 4 <= MISC_OFF && A_TAB + 20 * TABN * 4 <= A_CTAB && A_CTAB + 8 * CTABN * 4 <= A_IMP, "lds map");

__device__ __forceinline__ unsigned f2bf(float f) { unsigned u = __builtin_bit_cast(unsigned, f); return (u + 0x7fffu + ((u >> 16) & 1u)) >> 16; }
__device__ __forceinline__ unsigned pk2(float lo, float hi) { return f2bf(lo) | (f2bf(hi) << 16); }
__device__ __forceinline__ float bflo(unsigned w) { return __builtin_bit_cast(float, w << 16); }
__device__ __forceinline__ float bfhi(unsigned w) { return __builtin_bit_cast(float, w & 0xffff0000u); }
__device__ __forceinline__ float fast_sigmoid(float v) { return __builtin_amdgcn_rcpf(1.0f + __builtin_amdgcn_exp2f(-LOG2E * v)); }

namespace pg8 {
#define PG8_LAS __attribute__((address_space(3)))
typedef unsigned short bf16_t;
constexpr int BM = 256, BK = 64, HALF = 128, HTB = HALF * BK * 2  , STAGE_BYTES = 8 * HTB, NXCD = 8, WGM = 8;

__host__ __device__ __forceinline__ int lds_byte(int r, int c) { const int st = (r >> 4) * 2 + (c >> 5), rr = r & 15, cc = c & 31, ob = rr * 64 + cc * 2; return st * 1024 + (ob ^ (((ob >> 9) & 1) << 5)); }
__host__ __device__ __forceinline__ void stage_rc(int b, int& R, int& C) { const int st = b / 1024, sb = b % 1024, swz = sb ^ (((sb >> 9) & 1) << 5); R = (st >> 1) * 16 + swz / 64; C = (st & 1) * 32 + (swz % 64) / 2; }
__host__ __device__ __forceinline__ int perm32(int rho) { const int n = rho >> 4, i = rho & 15; return 8 * (i >> 2) + 4 * n + (i & 3); }

struct Unit { int pm, pn; };
struct Gemm { const bf16_t* A; const bf16_t* Bt; int M, N, K, lda, ldb; };

struct StaticOrder {
    int nM, nN, nwg, G, c;
    __host__ __device__ void init(int M, int N, int G_, int c_) { nM = M / BM; nN = N / BM; nwg = nM * nN; G = G_; c = c_; }
    __host__ __device__ bool next(int i, Unit& u) const {
        const long L = (long)i * G + c; if (L >= nwg) return false;
        int wgid = (int)L; { const int q = nwg / NXCD, r = nwg % NXCD, xcd = wgid % NXCD, off = wgid / NXCD; wgid = (xcd < r ? xcd * (q + 1) : r * (q + 1) + (xcd - r) * q) + off; }
        const int nig = WGM * nN, gid = wgid / nig, fm = gid * WGM, gsz = (nM - fm) < WGM ? (nM - fm) : WGM;
        u.pm = fm + ((wgid % nig) % gsz); u.pn = (wgid % nig) / gsz; return true;
    }
    __device__ __forceinline__ void a_ready(const Unit&) const {}
    __device__ __forceinline__ void done(const Unit&) const {}
};

__device__ __forceinline__ unsigned cvt_pk_bf16(float lo, float hi) { unsigned r; asm volatile("v_cvt_pk_bf16_f32 %0, %1, %2" : "=v"(r) : "v"(lo), "v"(hi)); return r; }
__device__ __forceinline__ u32x4 pack8(const f32x4& v0, const f32x4& v1) { u32x4 w; w.x = cvt_pk_bf16(v0[0], v0[1]); w.y = cvt_pk_bf16(v0[2], v0[3]); w.z = cvt_pk_bf16(v1[0], v1[1]); w.w = cvt_pk_bf16(v1[2], v1[3]); return w; }
__device__ __forceinline__ void unpack8(const u32x4& w, f32x4& v0, f32x4& v1) { v0 = (f32x4){bflo(w.x), bfhi(w.x), bflo(w.y), bfhi(w.y)}; v1 = (f32x4){bflo(w.z), bfhi(w.z), bflo(w.w), bfhi(w.w)}; }

typedef int i32x4 __attribute__((ext_vector_type(4)));
template <bool I8> __device__ __forceinline__ f32x4 mma16(bf16x8 b, bf16x8 a, f32x4 c) {
    if constexpr (I8) return __builtin_bit_cast(f32x4, __builtin_amdgcn_mfma_i32_16x16x64_i8(__builtin_bit_cast(i32x4, b), __builtin_bit_cast(i32x4, a), __builtin_bit_cast(i32x4, c), 0, 0, 0));
    else return __builtin_amdgcn_mfma_f32_16x16x32_bf16(b, a, c, 0, 0, 0);
}
__device__ __forceinline__ f32x4 i2f4(const f32x4& a) { const i32x4 i = __builtin_bit_cast(i32x4, a); return (f32x4){(float)i[0], (float)i[1], (float)i[2], (float)i[3]}; }
__device__ __forceinline__ unsigned u8x4(const f32x4& v) { return (unsigned)(v[0] * 255.f + 0.5f) | ((unsigned)(v[1] * 255.f + 0.5f) << 8) | ((unsigned)(v[2] * 255.f + 0.5f) << 16) | ((unsigned)(v[3] * 255.f + 0.5f) << 24); }
__device__ __forceinline__ f32x4 u8tof(unsigned w) { return (f32x4){(float)(w & 255u), (float)((w >> 8) & 255u), (float)((w >> 16) & 255u), (float)(w >> 24)}; }
struct EpiPlain {
    static constexpr bool PERM = true, AFTER_DRAIN = false, SEG = false;
    bf16_t* O; int ldc;
    __device__ __forceinline__ void operator()(const f32x4 (&acc)[2][2][4][2], const Unit& u, int wr, int wc, int fr, int fq) const {
        const int row0 = u.pm * BM + wr * 64 + fr, col0 = u.pn * BM + wc * 32 + 8 * fq;
#pragma unroll
        for (int ai = 0; ai < 2; ++ai)
#pragma unroll
            for (int m = 0; m < 4; ++m) { bf16_t* rowp = O + (size_t)(row0 + ai * HALF + m * 16) * ldc + col0;
#pragma unroll
                for (int bj = 0; bj < 2; ++bj) *(u32x4*)(rowp + bj * HALF) = pack8(acc[ai][bj][m][0], acc[ai][bj][m][1]); }
    }
};
struct EpiProj {
    static constexpr bool PERM = true, AFTER_DRAIN = false, SEG = false;
    bf16_t* PA; bf16_t* GT; const float* sa; const float* sb;
    __device__ __forceinline__ void operator()(const f32x4 (&acc)[2][2][4][2], const Unit& u, int wr, int wc, int fr, int fq) const {
        const int pn = u.pn; bf16_t* base; int ldc, colt; float sc = 1.f; bool sig = false;
        if (pn < 10) { base = PA; ldc = NPA; colt = pn * BM; if (pn < 2 || pn == 5 || pn == 8) sc = C2; if (pn == 9) sig = true; }
        else { base = GT; ldc = NGT; colt = (pn - 10) * BM; sig = true; }
        const int row0 = u.pm * BM + wr * 64 + fr, col0 = colt + wc * 32 + 8 * fq;
        f32x4 sbv[2][2];
#pragma unroll
        for (int bj = 0; bj < 2; ++bj) { const float* sp = sb + pn * BM + bj * HALF + wc * 32 + 8 * fq; sbv[bj][0] = *(const f32x4*)sp * sc; sbv[bj][1] = *(const f32x4*)(sp + 4) * sc; }
#pragma unroll
        for (int ai = 0; ai < 2; ++ai)
#pragma unroll
            for (int m = 0; m < 4; ++m) { const int row = row0 + ai * HALF + m * 16; bf16_t* rowp = base + (size_t)row * ldc + col0; const float sar = sa[row];
#pragma unroll
                for (int bj = 0; bj < 2; ++bj) { f32x4 v0 = i2f4(acc[ai][bj][m][0]) * sbv[bj][0] * sar, v1 = i2f4(acc[ai][bj][m][1]) * sbv[bj][1] * sar;
                    if (sig) {
#pragma unroll
                        for (int e = 0; e < 4; ++e) { v0[e] = fast_sigmoid(v0[e]); v1[e] = fast_sigmoid(v1[e]); } }
                    if (pn >= 10) { u32x2 w; w.x = u8x4(v0); w.y = u8x4(v1); *(u32x2*)((unsigned char*)GT + (size_t)row * NGT + col0 + bj * HALF) = w; }
                    else *(u32x4*)(rowp + bj * HALF) = pack8(v0, v1); } }
    }
};
struct EpiMerge1P {
    static constexpr bool PERM = true, AFTER_DRAIN = false, SEG = true;
    bf16_t* O; int ldc; const unsigned char* G8; int ldg; int seg1, seg2;
    __device__ __forceinline__ void rescale(f32x4 (&acc)[2][2][4][2], const Unit& u, int wr, int wc, int fr, int fq, int which) const {
        asm volatile("" ::: "memory");
        int row0 = u.pm * BM + wr * 64 + fr; const int col0 = u.pn * BM + wc * 32 + 8 * fq;
        asm volatile("" : "+v"(row0));
        const unsigned char* Ga = G8 + which * 1024 + col0;
#pragma unroll
        for (int ai = 0; ai < 2; ++ai)
#pragma unroll
          for (int mp = 0; mp < 2; ++mp) {
            u32x2 aw[2][2], bw[2][2];
#pragma unroll
            for (int mi = 0; mi < 2; ++mi) { const size_t r = (size_t)(row0 + ai * HALF + (2 * mp + mi) * 16);
#pragma unroll
                for (int bj = 0; bj < 2; ++bj) { aw[mi][bj] = *(const u32x2*)(Ga + r * ldg + bj * HALF); bw[mi][bj] = *(const u32x2*)(Ga + r * ldg + 1024 + bj * HALF); } }
#pragma unroll
            for (int mi = 0; mi < 2; ++mi)
#pragma unroll
                for (int bj = 0; bj < 2; ++bj) { const int m = 2 * mp + mi; f32x4 a0 = u8tof(aw[mi][bj].x), a1 = u8tof(aw[mi][bj].y), b0 = u8tof(bw[mi][bj].x), b1 = u8tof(bw[mi][bj].y);
#pragma unroll
                    for (int e = 0; e < 4; ++e) { const float na0 = which ? fmaxf(a0[e], 0.5f) : a0[e], na1 = which ? fmaxf(a1[e], 0.5f) : a1[e];
                        acc[ai][bj][m][0][e] *= na0 * __builtin_amdgcn_rcpf(fmaxf(b0[e], 0.5f)); acc[ai][bj][m][1][e] *= na1 * __builtin_amdgcn_rcpf(fmaxf(b1[e], 0.5f)); }
                    asm volatile("" : "+v"(acc[ai][bj][m][0]), "+v"(acc[ai][bj][m][1])); }
            asm volatile("" ::: "memory");
          }
    }
    __device__ __forceinline__ void operator()(const f32x4 (&acc)[2][2][4][2], const Unit& u, int wr, int wc, int fr, int fq) const {
        const int row0 = u.pm * BM + wr * 64 + fr, col0 = u.pn * BM + wc * 32 + 8 * fq;
#pragma unroll
        for (int ai = 0; ai < 2; ++ai) {
            u32x2 gw[4][2];
#pragma unroll
            for (int m = 0; m < 4; ++m) { const size_t r = (size_t)(row0 + ai * HALF + m * 16);
#pragma unroll
                for (int bj = 0; bj < 2; ++bj) gw[m][bj] = *(const u32x2*)(G8 + r * ldg + 2048 + col0 + bj * HALF); }
#pragma unroll
            for (int m = 0; m < 4; ++m) { const size_t r = (size_t)(row0 + ai * HALF + m * 16);
#pragma unroll
                for (int bj = 0; bj < 2; ++bj) { f32x4 g0 = u8tof(gw[m][bj].x), g1 = u8tof(gw[m][bj].y);
#pragma unroll
                    for (int e = 0; e < 4; ++e) { g0[e] = fmaxf(g0[e], 0.5f) * (1.f / 255.f); g1[e] = fmaxf(g1[e], 0.5f) * (1.f / 255.f); }
                    *(u32x4*)(O + r * ldc + col0 + bj * HALF) = pack8(acc[ai][bj][m][0] * g0, acc[ai][bj][m][1] * g1); } }
        }
    }
};
struct EpiSwiGLU {
    static constexpr bool PERM = true, AFTER_DRAIN = false, SEG = false;
    bf16_t* U; int ldc; const float* sa; const float* sb;
    __device__ __forceinline__ void operator()(const f32x4 (&acc)[2][2][4][2], const Unit& u, int wr, int wc, int fr, int fq) const {
        const int row0 = u.pm * BM + wr * 64 + fr, col0 = u.pn * HALF + wc * 32 + 8 * fq;
        f32x4 sbv[2][2];
#pragma unroll
        for (int bj = 0; bj < 2; ++bj) { const float* sp = sb + u.pn * BM + bj * HALF + wc * 32 + 8 * fq; sbv[bj][0] = *(const f32x4*)sp; sbv[bj][1] = *(const f32x4*)(sp + 4); }
#pragma unroll
        for (int ai = 0; ai < 2; ++ai)
#pragma unroll
            for (int m = 0; m < 4; ++m) { const int row = row0 + ai * HALF + m * 16; bf16_t* rowp = U + (size_t)row * ldc + col0; const float sar = sa[row];
                const f32x4 ga = i2f4(acc[ai][0][m][0]) * sbv[0][0] * sar, gb = i2f4(acc[ai][0][m][1]) * sbv[0][1] * sar;
                const f32x4 ua = i2f4(acc[ai][1][m][0]) * sbv[1][0] * sar, ub = i2f4(acc[ai][1][m][1]) * sbv[1][1] * sar;
                f32x4 v0, v1;
#pragma unroll
                for (int e = 0; e < 4; ++e) { v0[e] = ga[e] * fast_sigmoid(ga[e]) * ua[e]; v1[e] = gb[e] * fast_sigmoid(gb[e]) * ub[e]; }
                *(u32x4*)rowp = pack8(v0, v1); }
    }
};

template <class Epi, class Sched, bool ALIGN_EPI = false, bool SP2 = false, bool I8 = false>
__device__ __forceinline__ void gemm_phase(PG8_LAS unsigned char* lds, const Gemm g, const Sched& S, const Epi& E, int wave_in) {
    unsigned z_ = 0u; asm volatile("" : "+s"(z_));
    int tid_ = wave_in * 64 + (int)__builtin_amdgcn_mbcnt_hi(~0u, __builtin_amdgcn_mbcnt_lo(~0u, z_)); asm volatile("" : "+v"(tid_));
    const int tid = tid_, wid = __builtin_amdgcn_readfirstlane(tid >> 6), lane = tid & 63, wr = wid >> 2, wc = wid & 3, fr = lane & 15, fq = lane >> 4;
    const int K = g.K, nt = K / BK;
    unsigned voffA[2], voffB[2];
#pragma unroll
    for (int i = 0; i < 2; ++i) { int R, C; stage_rc(tid * 16 + i * 8192, R, C); const int Rb = Epi::PERM ? ((R & ~31) + perm32(R & 31)) : R;
        voffA[i] = (unsigned)(R * g.lda + C) * 2u; voffB[i] = (unsigned)(Rb * g.ldb + C) * 2u; }
    const size_t kstep = (size_t)(BK * 2);
    const size_t hstepA = (size_t)HALF * g.lda * 2, hstepB = (size_t)HALF * g.ldb * 2;
    const size_t tstepA = 2 * hstepA, tstepB = 2 * hstepB;
    const unsigned ldsw = (unsigned)wid * 1024u;
    const int aoff = lds_byte(wr * 64 + fr, fq * 8), boff = lds_byte(wc * 32 + fr, fq * 8);
#define PG8_SA(b, h) (((b) * 2 + (h)) * HTB)
#define PG8_SB(b, h) ((4 + (b) * 2 + (h)) * HTB)
#define PG8_STAGE(bufoff, gbase, voff) do { _Pragma("unroll") for (int _i = 0; _i < 2; ++_i) \
        __builtin_amdgcn_global_load_lds((const unsigned*)((const char*)(gbase) + (voff)[_i]), (PG8_LAS unsigned*)(lds + (bufoff) + ldsw + _i * 8192), 16, 0, 0); } while (0)
#define PG8_LDA(dst, b, h) do { _Pragma("unroll") for (int m = 0; m < 4; ++m) _Pragma("unroll") for (int k = 0; k < 2; ++k) dst[m][k] = *(const PG8_LAS bf16x8*)(lds + PG8_SA(b, h) + aoff + m * 2048 + k * 1024); } while (0)
#define PG8_LDB(dst, b, h) do { _Pragma("unroll") for (int n = 0; n < 2; ++n) _Pragma("unroll") for (int k = 0; k < 2; ++k) dst[n][k] = *(const PG8_LAS bf16x8*)(lds + PG8_SB(b, h) + boff + n * 2048 + k * 1024); } while (0)
#define PG8_MMA(ai, bj, At, Bt) do { __builtin_amdgcn_s_setprio(1); _Pragma("unroll") for (int m = 0; m < 4; ++m) _Pragma("unroll") for (int n = 0; n < 2; ++n) _Pragma("unroll") for (int k = 0; k < 2; ++k) \
        acc[ai][bj][m][n] = mma16<I8>(Bt[n][k], At[m][k], acc[ai][bj][m][n]); __builtin_amdgcn_s_setprio(0); } while (0)
#define PG8_WAIT_V(n) asm volatile("s_waitcnt vmcnt(" #n ")" ::: "memory")
#define PG8_WAIT_L(n) asm volatile("s_waitcnt lgkmcnt(" #n ")" ::: "memory")
#define PG8_BAR __builtin_amdgcn_s_barrier()
#define PG8_SCHED __builtin_amdgcn_sched_barrier(0)
    Unit cur, nxt; int ui = 0;
    if (!S.next(0, cur)) return;
    f32x4 acc[2][2][4][2];
#pragma unroll
    for (int a = 0; a < 2; ++a)
#pragma unroll
        for (int b = 0; b < 2; ++b)
#pragma unroll
            for (int m = 0; m < 4; ++m)
#pragma unroll
                for (int n = 0; n < 2; ++n) acc[a][b][m][n] = (f32x4){0.f, 0.f, 0.f, 0.f};
    bf16x8 At[4][2], B0[2][2], B1[2][2];
    const char* cA = (const char*)g.A + (size_t)cur.pm * tstepA; const char* cB = (const char*)g.Bt + (size_t)cur.pn * tstepB;
    S.a_ready(cur);
    if constexpr (SP2) {
        PG8_STAGE(PG8_SB(0, 0), cB, voffB); PG8_STAGE(PG8_SB(0, 1), cB + hstepB, voffB); PG8_STAGE(PG8_SA(0, 0), cA, voffA); PG8_STAGE(PG8_SA(0, 1), cA + hstepA, voffA);
        if (wr == 1) PG8_BAR;
        PG8_WAIT_V(2); PG8_BAR;
        PG8_STAGE(PG8_SB(1, 0), cB + kstep, voffB); PG8_STAGE(PG8_SA(1, 0), cA + kstep, voffA); PG8_STAGE(PG8_SB(1, 1), cB + hstepB + kstep, voffB);
        PG8_WAIT_V(6); PG8_BAR;
    } else {
        PG8_STAGE(PG8_SB(0, 0), cB, voffB); PG8_STAGE(PG8_SA(0, 0), cA, voffA); PG8_STAGE(PG8_SB(0, 1), cB + hstepB, voffB); PG8_STAGE(PG8_SA(0, 1), cA + hstepA, voffA);
        if (wr == 1) PG8_BAR;
        PG8_WAIT_V(4); PG8_BAR;
        PG8_STAGE(PG8_SB(1, 0), cB + kstep, voffB); PG8_STAGE(PG8_SA(1, 0), cA + kstep, voffA); PG8_STAGE(PG8_SB(1, 1), cB + hstepB + kstep, voffB);
        PG8_WAIT_V(6); PG8_BAR;
    }
    for (;;) {
        const bool has_next = S.next(ui + 1, nxt);
        const char* nA = has_next ? (const char*)g.A + (size_t)nxt.pm * tstepA : cA; const char* nB = has_next ? (const char*)g.Bt + (size_t)nxt.pn * tstepB : cB;
        for (int t = 0; t < nt; t += 2) {
            const bool last = (t == nt - 2);
            const char* a1 = cA + (size_t)(t + 1) * kstep;
            const char* a2 = last ? nA : cA + (size_t)(t + 2) * kstep; const char* b2 = last ? nB : cB + (size_t)(t + 2) * kstep;
            const char* a3 = a2 + kstep; const char* b3 = b2 + kstep;
            if (last && has_next) S.a_ready(nxt);
            if constexpr (Epi::SEG) { __builtin_amdgcn_sched_barrier(0); if (t == E.seg1 || t == E.seg2) E.rescale(acc, cur, wr, wc, fr, fq, t == E.seg1 ? 0 : 1); __builtin_amdgcn_sched_barrier(0); }
            if constexpr (SP2) {
            PG8_LDB(B0, 0, 0); PG8_LDB(B1, 0, 1); PG8_SCHED; PG8_LDA(At, 0, 0); PG8_STAGE(PG8_SA(1, 1), a1 + hstepA, voffA);
            PG8_WAIT_V(8); PG8_WAIT_L(0); PG8_BAR; PG8_MMA(0, 0, At, B0); PG8_MMA(0, 1, At, B1); PG8_BAR; PG8_SCHED;
            PG8_LDA(At, 0, 1); PG8_STAGE(PG8_SB(0, 0), b2, voffB); PG8_STAGE(PG8_SB(0, 1), b2 + hstepB, voffB); PG8_STAGE(PG8_SA(0, 0), a2, voffA);
            PG8_WAIT_V(8); PG8_WAIT_L(0); PG8_BAR; PG8_MMA(1, 0, At, B0); PG8_MMA(1, 1, At, B1); PG8_BAR; PG8_SCHED;
            PG8_LDB(B0, 1, 0); PG8_LDB(B1, 1, 1); PG8_SCHED; PG8_LDA(At, 1, 0); PG8_STAGE(PG8_SA(0, 1), a2 + hstepA, voffA);
            PG8_WAIT_V(8); PG8_WAIT_L(0); PG8_BAR; PG8_MMA(0, 0, At, B0); PG8_MMA(0, 1, At, B1); PG8_BAR; PG8_SCHED;
            PG8_LDA(At, 1, 1); PG8_STAGE(PG8_SB(1, 0), b3, voffB); PG8_STAGE(PG8_SB(1, 1), b3 + hstepB, voffB); PG8_STAGE(PG8_SA(1, 0), a3, voffA);
            PG8_WAIT_V(8); PG8_WAIT_L(0); PG8_BAR; PG8_MMA(1, 0, At, B0); PG8_MMA(1, 1, At, B1); PG8_BAR; PG8_SCHED;
            } else {
            PG8_LDB(B0, 0, 0); PG8_SCHED; PG8_LDA(At, 0, 0); PG8_STAGE(PG8_SA(1, 1), a1 + hstepA, voffA);
            PG8_WAIT_L(8); PG8_BAR; PG8_WAIT_L(0); PG8_MMA(0, 0, At, B0); PG8_BAR; PG8_SCHED;
            PG8_LDB(B1, 0, 1); PG8_STAGE(PG8_SB(0, 0), b2, voffB);
            PG8_BAR; PG8_WAIT_L(0); PG8_MMA(0, 1, At, B1); PG8_BAR;
            PG8_LDA(At, 0, 1); PG8_STAGE(PG8_SA(0, 0), a2, voffA);
            PG8_BAR; PG8_WAIT_L(0); PG8_MMA(1, 0, At, B0); PG8_BAR; PG8_SCHED;
            PG8_STAGE(PG8_SB(0, 1), b2 + hstepB, voffB);
            PG8_WAIT_V(6); PG8_BAR; PG8_MMA(1, 1, At, B1); PG8_BAR;
            PG8_LDB(B0, 1, 0); PG8_SCHED; PG8_LDA(At, 1, 0); PG8_STAGE(PG8_SA(0, 1), a2 + hstepA, voffA);
            PG8_WAIT_L(8); PG8_BAR; PG8_WAIT_L(0); PG8_MMA(0, 0, At, B0); PG8_BAR; PG8_SCHED;
            PG8_LDB(B1, 1, 1); PG8_STAGE(PG8_SB(1, 0), b3, voffB);
            PG8_BAR; PG8_WAIT_L(0); PG8_MMA(0, 1, At, B1); PG8_BAR;
            PG8_LDA(At, 1, 1); PG8_STAGE(PG8_SA(1, 0), a3, voffA);
            PG8_BAR; PG8_WAIT_L(0); PG8_MMA(1, 0, At, B0); PG8_BAR; PG8_SCHED;
            PG8_STAGE(PG8_SB(1, 1), b3 + hstepB, voffB);
            PG8_WAIT_V(6); PG8_BAR; PG8_MMA(1, 1, At, B1); PG8_BAR;
            }
        }
        if constexpr (ALIGN_EPI) { if (wr == 0) PG8_BAR; }
        if constexpr (!Epi::AFTER_DRAIN) { E(acc, cur, wr, wc, fr, fq); S.done(cur); }
        if (!has_next) break;
#pragma unroll
        for (int a = 0; a < 2; ++a)
#pragma unroll
            for (int b = 0; b < 2; ++b)
#pragma unroll
                for (int m = 0; m < 4; ++m)
#pragma unroll
                    for (int n = 0; n < 2; ++n) acc[a][b][m][n] = (f32x4){0.f, 0.f, 0.f, 0.f};
        cur = nxt; cA = nA; cB = nB; ++ui;
        if constexpr (ALIGN_EPI) { if (wr == 1) PG8_BAR; }
    }
    PG8_WAIT_V(0);
    if constexpr (!ALIGN_EPI) { if (wr == 0) PG8_BAR; }
    PG8_BAR;
    if constexpr (Epi::AFTER_DRAIN) { E.fused(acc, cur, wr, wc, fr, fq, lds, wid, lane); S.done(cur); }
#undef PG8_SA
#undef PG8_SB
#undef PG8_STAGE
#undef PG8_LDA
#undef PG8_LDB
#undef PG8_MMA
#undef PG8_WAIT_V
#undef PG8_WAIT_L
#undef PG8_BAR
#undef PG8_SCHED
}

}

typedef GAS unsigned gu32;
#define RLX_AGENT __ATOMIC_RELAXED, __HIP_MEMORY_SCOPE_AGENT
#define XB_TMO      128
#define XB_XCNT(j)  (256  + 64 * (j))
#define XB_XSUB(j)  (1280 + 64 * (j))
#define XB_XGEN(j)  (2304 + 64 * (j))
#define XB_TOP      3328
#define XB_TOPGEN   3392
#define XCD_BAR_WORDS 3456
#define XB_SPIN_CAP (1u << 18)

__device__ __forceinline__ unsigned xb_ld(unsigned* p)              { return __hip_atomic_load(p, __ATOMIC_RELAXED, __HIP_MEMORY_SCOPE_AGENT); }
__device__ __forceinline__ unsigned xb_add(unsigned* p, unsigned v) { return __hip_atomic_fetch_add(p, v, __ATOMIC_RELAXED, __HIP_MEMORY_SCOPE_AGENT); }
__device__ __forceinline__ unsigned xb_xcc_id() { return (unsigned)__builtin_amdgcn_s_getreg((3 << 11) | 20) & 0xFu; }
#define XB_SPIN(cond, bar) do { unsigned _sp = 0; while (cond) { __builtin_amdgcn_s_sleep(1); \
    if ((++_sp & 255u) == 0u) { if (xb_ld(&(bar)[XB_TMO])) break; if (_sp > XB_SPIN_CAP) { atomicAdd(&(bar)[XB_TMO], 1u); break; } } } } while (0)

struct XcdBarrier {
    unsigned* bar; unsigned x;
    volatile LAS unsigned* st;
};

__device__ __forceinline__ XcdBarrier xcd_barrier_post(unsigned* bar, volatile LAS unsigned* st) {
    XcdBarrier b; b.bar = bar; b.x = xb_xcc_id(); b.st = st;
    if (threadIdx.x == 0) (void)xb_add(&bar[XB_XCNT(b.x)], 1u);
    return b;
}
__device__ __forceinline__ void xcd_barrier_complete(unsigned* bar, unsigned x, unsigned& nloc, unsigned& nx) {
    const unsigned G = gridDim.x * gridDim.y * gridDim.z;
    unsigned sum, cnt, mine, sp = 0u;
    for (;;) {
        sum = 0u; cnt = 0u; mine = 0u;
#pragma unroll
        for (unsigned j = 0; j < 16; ++j) { const unsigned c = xb_ld(&bar[XB_XCNT(j)]); sum += c; cnt += (c > 0u) ? 1u : 0u; mine = (j == x) ? c : mine; }
        if (sum == G) break;
        __builtin_amdgcn_s_sleep(1);
        if ((++sp & 255u) == 0u) { if (xb_ld(&bar[XB_TMO])) break; if (sp > XB_SPIN_CAP) { atomicAdd(&bar[XB_TMO], 1u); break; } }
    }
    nloc = mine > 0u ? mine : 1u; nx = cnt > 0u ? cnt : 1u;
}

__device__ __forceinline__ void xcd_barrier(const XcdBarrier& b) {
    asm volatile("s_waitcnt vmcnt(0)" ::: "memory");
    __syncthreads();
    if (threadIdx.x == 0) {
        unsigned* bar = b.bar;
        __builtin_amdgcn_s_waitcnt(0);
        unsigned nloc = b.st[0], nx = b.st[1];
        if (nloc == 0u) { xcd_barrier_complete(bar, b.x, nloc, nx); b.st[0] = nloc; b.st[1] = nx; }
        const unsigned old = xb_add(&bar[XB_XSUB(b.x)], 1u);
        const unsigned gen = old / nloc;
        if (old + 1u == (gen + 1u) * nloc) {
            __builtin_amdgcn_fence(__ATOMIC_RELEASE, "agent");
            asm volatile("s_waitcnt vmcnt(0)" ::: "memory");
            const unsigned og = xb_add(&bar[XB_TOP], 1u);
            const unsigned tg = og / nx;
            if (og + 1u == (tg + 1u) * nx) xb_add(&bar[XB_TOPGEN], 1u);
            else XB_SPIN(xb_ld(&bar[XB_TOPGEN]) == tg, bar);
            __builtin_amdgcn_fence(__ATOMIC_ACQUIRE, "agent");
            xb_add(&bar[XB_XGEN(b.x)], 1u);
            asm volatile("s_waitcnt vmcnt(0)" ::: "memory");
        } else {
            XB_SPIN(xb_ld(&bar[XB_XGEN(b.x)]) == gen, bar);
            __builtin_amdgcn_fence(__ATOMIC_ACQUIRE, "agent");
            asm volatile("s_waitcnt vmcnt(0)" ::: "memory");
        }
    }
    __syncthreads();
}

#define LDS_WAIT() asm volatile("s_waitcnt lgkmcnt(0)" ::: "memory")
#define VM_WAIT() asm volatile("s_waitcnt vmcnt(0)" ::: "memory")
#define MFMA32 __builtin_amdgcn_mfma_f32_32x32x16_bf16
__device__ __forceinline__ float wave_sum(float v) {
#pragma unroll
    for (int o = 1; o < 64; o <<= 1) v += __shfl_xor(v, o);
    return v;
}
__device__ __forceinline__ float wave_max(float v) {
#pragma unroll
    for (int o = 1; o < 64; o <<= 1) v = fmaxf(v, __shfl_xor(v, o));
    return v;
}
__device__ __forceinline__ unsigned q8x4(const f32x4& y, float inv) {
    int a = __float2int_rn(y.x * inv), b = __float2int_rn(y.y * inv), c = __float2int_rn(y.z * inv), d = __float2int_rn(y.w * inv);
    a = a < -127 ? -127 : (a > 127 ? 127 : a); b = b < -127 ? -127 : (b > 127 ? 127 : b); c = c < -127 ? -127 : (c > 127 ? 127 : c); d = d < -127 ? -127 : (d > 127 ? 127 : d);
    return (unsigned)(a & 255) | ((unsigned)(b & 255) << 8) | ((unsigned)(c & 255) << 16) | ((unsigned)(d & 255) << 24);
}
__device__ __forceinline__ float amax4(const f32x4& y) { return fmaxf(fmaxf(fabsf(y.x), fabsf(y.y)), fmaxf(fabsf(y.z), fabsf(y.w))); }
__device__ __forceinline__ float swap_max(float m) { auto rr = __builtin_amdgcn_permlane32_swap(__float_as_uint(m), __float_as_uint(m), false, false); return fmaxf(__uint_as_float(rr[0]), __uint_as_float(rr[1])); }
__device__ __forceinline__ float swap_sum(float m) { auto rr = __builtin_amdgcn_permlane32_swap(__float_as_uint(m), __float_as_uint(m), false, false); return __uint_as_float(rr[0]) + __uint_as_float(rr[1]); }
__device__ __forceinline__ int crow(int r, int hi) { return (r & 3) + 8 * (r >> 2) + 4 * hi; }
__device__ __forceinline__ int t5_bucket(int dist) {
    if (dist < 16) return dist;
    int b = 16;
    b += (dist >= 19); b += (dist >= 21); b += (dist >= 24); b += (dist >= 27); b += (dist >= 31); b += (dist >= 35); b += (dist >= 40); b += (dist >= 46);
    b += (dist >= 52); b += (dist >= 59); b += (dist >= 67); b += (dist >= 77); b += (dist >= 87); b += (dist >= 99); b += (dist >= 113);
    return b;
}
__device__ __forceinline__ float gelu_tanh(float x) { const float u = 0.7978845608028654f * (x + 0.044715f * x * x * x); return x * __builtin_amdgcn_rcpf(1.0f + __builtin_amdgcn_exp2f(-2.0f * LOG2E * u)); }

__device__ __forceinline__ void tr_item(const float* W, int ldw, bf16* WT, int ldt, int kdst, LAS float* scr, int k0, int n0, int sc, int lane, unsigned* cmax, const float* kgain) {
    float tv[32];
    const float* wp = W + (size_t)(k0 + (lane >> 5)) * ldw + (sc >= 0 ? sc : 0);
#pragma unroll
    for (int i = 0; i < 32; ++i) tv[i] = wp[(size_t)(2 * i) * ldw];
    if (kgain) {
#pragma unroll
        for (int i = 0; i < 32; ++i) tv[i] *= kgain[k0 + 2 * i + (lane >> 5)]; }
#pragma unroll
    for (int i = 0; i < 32; ++i) { const int kk = 2 * i + (lane >> 5); scr[kk * 33 + (lane & 31)] = sc >= 0 ? tv[i] : 0.f; }
    LDS_WAIT(); asm volatile("" ::: "memory");
    const int c = lane & 7;
#pragma unroll
    for (int j = 0; j < 4; ++j) { const int n = (lane >> 3) + 8 * j; const LAS float* s = scr + (8 * c) * 33 + n;
        u32x4 o; o.x = pk2(s[0 * 33], s[1 * 33]); o.y = pk2(s[2 * 33], s[3 * 33]); o.z = pk2(s[4 * 33], s[5 * 33]); o.w = pk2(s[6 * 33], s[7 * 33]);
        *(u32x4*)(WT + (size_t)(n0 + n) * ldt + kdst + k0 + 8 * c) = o;
        if (cmax) { float mx = fmaxf(fmaxf(fmaxf(bflo(o.x), bfhi(o.x)), fmaxf(bflo(o.y), bfhi(o.y))), fmaxf(fmaxf(bflo(o.z), bfhi(o.z)), fmaxf(bflo(o.w), bfhi(o.w))));
            float mn = fminf(fminf(fminf(bflo(o.x), bfhi(o.x)), fminf(bflo(o.y), bfhi(o.y))), fminf(fminf(bflo(o.z), bfhi(o.z)), fminf(bflo(o.w), bfhi(o.w))));
            mx = fmaxf(mx, -mn);
            mx = fmaxf(mx, __shfl_xor(mx, 1)); mx = fmaxf(mx, __shfl_xor(mx, 2)); mx = fmaxf(mx, __shfl_xor(mx, 4));
            if (c == 0) atomicMax(cmax + n0 + n, __float_as_uint(mx)); } }
    LDS_WAIT(); asm volatile("" ::: "memory");
}
__device__ __forceinline__ void tr_one(int kind, const float* W, const float* W2, int ldw, int Ndst, bf16* WT, int ldt, int kdst, LAS float* scr, int it, int lane, unsigned* cmax, const float* kgain) {
    const int nblk = Ndst / 32;
    const int kb = it / nblk, nb = it % nblk, n0 = 32 * nb, n = n0 + (lane & 31);
    const float* src = W; int sc = n;
    if (kind == 1) { sc = n < 1280 ? n : (n < 2304 ? n + 24 : (n < 2328 ? n - 1024 : (n < 2560 ? -1 : n - 232))); }
    else if (kind == 2) { const int pn = n >> 8, w = n & 255; if (w < 128) sc = 128 * pn + w; else { sc = 128 * pn + w - 128; src = W2; } }
    tr_item(src, ldw, WT, ldt, kdst, scr, 64 * kb, n0, sc, lane, cmax, kgain);
}

template <int NR>
__device__ __forceinline__ void rms_rows_bf16(const float* const (&xrow)[NR], const float* g, bf16* const (&orow)[NR], int lane) {
    f32x4 v[NR][4];
#pragma unroll
    for (int r = 0; r < NR; ++r) { const f32x4* xr = (const f32x4*)xrow[r] + lane;
#pragma unroll
        for (int j = 0; j < 4; ++j) v[r][j] = xr[64 * j]; }
    const f32x4* gr = (const f32x4*)g + lane; f32x4 gv[4];
#pragma unroll
    for (int j = 0; j < 4; ++j) gv[j] = g ? gr[64 * j] : (f32x4){1.f, 1.f, 1.f, 1.f};
#pragma unroll
    for (int r = 0; r < NR; ++r) { float s = 0.f;
#pragma unroll
        for (int j = 0; j < 4; ++j) s += (v[r][j].x * v[r][j].x + v[r][j].y * v[r][j].y) + (v[r][j].z * v[r][j].z + v[r][j].w * v[r][j].w);
        const float rs = rsqrtf(wave_sum(s) * (1.f / DM) + RMS_EPS);
        u32x2* o8 = (u32x2*)orow[r] + lane;
#pragma unroll
        for (int j = 0; j < 4; ++j) { u32x2 w; w.x = pk2(v[r][j].x * rs * gv[j].x, v[r][j].y * rs * gv[j].y); w.y = pk2(v[r][j].z * rs * gv[j].z, v[r][j].w * rs * gv[j].w); o8[64 * j] = w; } }
}
template <int NR>
__device__ __forceinline__ void rms_rows_i8(const float* const (&xrow)[NR], const float* g, unsigned char* const (&orow)[NR], float* const (&sap)[NR], int lane) {
    f32x4 v[NR][4];
#pragma unroll
    for (int r = 0; r < NR; ++r) { const f32x4* xr = (const f32x4*)xrow[r] + lane;
#pragma unroll
        for (int j = 0; j < 4; ++j) v[r][j] = xr[64 * j]; }
    const f32x4* gr = (const f32x4*)g + lane; f32x4 gv[4];
#pragma unroll
    for (int j = 0; j < 4; ++j) gv[j] = gr[64 * j];
#pragma unroll
    for (int r = 0; r < NR; ++r) { float s = 0.f;
#pragma unroll
        for (int j = 0; j < 4; ++j) s += (v[r][j].x * v[r][j].x + v[r][j].y * v[r][j].y) + (v[r][j].z * v[r][j].z + v[r][j].w * v[r][j].w);
        const float rs = rsqrtf(wave_sum(s) * (1.f / DM) + RMS_EPS);
        float am = 0.f;
#pragma unroll
        for (int j = 0; j < 4; ++j) { v[r][j] = v[r][j] * rs * gv[j]; am = fmaxf(am, amax4(v[r][j])); }
        am = wave_max(am); const float inv = am > 0.f ? 127.f / am : 0.f;
        unsigned* o4 = (unsigned*)orow[r] + lane;
#pragma unroll
        for (int j = 0; j < 4; ++j) o4[64 * j] = q8x4(v[r][j], inv);
        if (lane == 0) *sap[r] = am > 0.f ? am * (1.f / 127.f) : 1.f; }
}
template <int NR, bool XIN_F32, bool XOUT_F32>
__device__ __forceinline__ void norm_res_norm(const bf16* const (&srow)[NR], const float* gA, const void* const (&xin)[NR], void* const (&xout)[NR], const float* gB, unsigned char* const (&hout)[NR], float* const (&sap)[NR], bool has_h, int lane) {
    u32x2 sw[NR][4]; f32x4 xv[NR][4];
#pragma unroll
    for (int r = 0; r < NR; ++r) { const u32x2* sr = (const u32x2*)srow[r] + lane;
#pragma unroll
        for (int j = 0; j < 4; ++j) { sw[r][j] = sr[64 * j];
            if constexpr (XIN_F32) xv[r][j] = ((const f32x4*)xin[r] + lane)[64 * j];
            else { const u32x2 w = ((const u32x2*)xin[r] + lane)[64 * j]; xv[r][j] = (f32x4){bflo(w.x), bfhi(w.x), bflo(w.y), bfhi(w.y)}; } } }
    const f32x4* ga = (const f32x4*)gA + lane; f32x4 gav[4];
#pragma unroll
    for (int j = 0; j < 4; ++j) gav[j] = ga[64 * j];
#pragma unroll
    for (int r = 0; r < NR; ++r) { f32x4 v[4]; float s = 0.f;
#pragma unroll
        for (int j = 0; j < 4; ++j) { const u32x2 w = sw[r][j]; v[j] = (f32x4){bflo(w.x), bfhi(w.x), bflo(w.y), bfhi(w.y)}; s += (v[j].x * v[j].x + v[j].y * v[j].y) + (v[j].z * v[j].z + v[j].w * v[j].w); }
        const float rA = rsqrtf(wave_sum(s) * (1.f / DM) + RMS_EPS);
        float s2 = 0.f;
#pragma unroll
        for (int j = 0; j < 4; ++j) { v[j] = xv[r][j] + v[j] * rA * gav[j];
            if constexpr (XOUT_F32) ((f32x4*)xout[r] + lane)[64 * j] = v[j];
            else { u32x2 w; w.x = pk2(v[j].x, v[j].y); w.y = pk2(v[j].z, v[j].w); ((u32x2*)xout[r] + lane)[64 * j] = w; }
            s2 += (v[j].x * v[j].x + v[j].y * v[j].y) + (v[j].z * v[j].z + v[j].w * v[j].w); }
        if (has_h) {
            const float rB = rsqrtf(wave_sum(s2) * (1.f / DM) + RMS_EPS);
            const f32x4* gb = (const f32x4*)gB + lane; unsigned* o4 = (unsigned*)hout[r] + lane; float am = 0.f;
#pragma unroll
            for (int j = 0; j < 4; ++j) { v[j] = v[j] * rB * gb[64 * j]; am = fmaxf(am, amax4(v[j])); }
            am = wave_max(am); const float inv = am > 0.f ? 127.f / am : 0.f;
#pragma unroll
            for (int j = 0; j < 4; ++j) o4[64 * j] = q8x4(v[j], inv);
            if (lane == 0) *sap[r] = am > 0.f ? am * (1.f / 127.f) : 1.f;
        } }
}

__device__ __forceinline__ void compress_unit(int u, LAS unsigned char* lds, const bf16* PA, const unsigned char* wl, bf16* KC, bf16* VC, int tid) {
    const int lane = tid & 63, wid = __builtin_amdgcn_readfirstlane(tid >> 6), r32 = lane & 31, hi = lane >> 5;
    const int half = u & 1, kv = (u >> 1) & 1, g = (u >> 2) & 1, b = u >> 3;
    const bf16* w1t = (const bf16*)(wl + (kv ? WL_W1V : WL_W1K));
    const bf16* w2t = (const bf16*)(wl + (kv ? WL_W2V : WL_W2K));
    const float* posb = (const float*)(wl + (kv ? WL_POSV : WL_POSK));
    const bf16* Asrc = PA + (size_t)b * SEQ * NPA + (kv ? PA_VC : PA_KC) + g * 64;
    bf16* Out = (kv ? VC : KC) + (size_t)((b * 2 + g) * 128) * 64;
    LAS bf16* H1 = (LAS bf16*)lds;
    {
        const int ctile = wid & 1, ntile = wid >> 1;
        const int c = 64 * half + 32 * ctile + r32;
        const bf16* wrow = w1t + (size_t)(32 * ntile + r32) * 2048 + 8 * hi;
        f32x16 acc = {};
#pragma unroll 4
        for (int jj = 0; jj < 32; ++jj) {
            int tok = 16 * c + jj; tok = tok > SEQ - 1 ? SEQ - 1 : tok;
            const bf16* arow = Asrc + (size_t)tok * NPA + 8 * hi;
#pragma unroll
            for (int q = 0; q < 4; ++q) {
                const bf16x8 af = *(const bf16x8*)(wrow + jj * 64 + q * 16);
                const bf16x8 bfr = *(const bf16x8*)(arow + q * 16);
                acc = MFMA32(af, bfr, acc, 0, 0, 0);
            }
        }
#pragma unroll
        for (int k4 = 0; k4 < 4; ++k4) { const int n0 = 32 * ntile + 8 * k4 + 4 * hi; const f32x4 pb = *(const f32x4*)(posb + n0);
            u32x2 w; w.x = pk2(gelu_tanh(acc[4 * k4 + 0] + pb.x), gelu_tanh(acc[4 * k4 + 1] + pb.y)); w.y = pk2(gelu_tanh(acc[4 * k4 + 2] + pb.z), gelu_tanh(acc[4 * k4 + 3] + pb.w));
            *(LAS u32x2*)(H1 + (32 * ctile + r32) * 136 + n0) = w; }
    }
    __syncthreads();
    if (wid < 4) {
        const int ct2 = wid & 1, dt = wid >> 1;
        f32x16 a2 = {};
#pragma unroll
        for (int ks = 0; ks < 8; ++ks) {
            const bf16x8 af = *(const bf16x8*)(w2t + (size_t)(32 * dt + r32) * 128 + 16 * ks + 8 * hi);
            const bf16x8 bfr = *(const LAS bf16x8*)(H1 + (32 * ct2 + r32) * 136 + 16 * ks + 8 * hi);
            a2 = MFMA32(af, bfr, a2, 0, 0, 0);
        }
#pragma unroll
        for (int k4 = 0; k4 < 4; ++k4) { u32x2 w; w.x = pk2(a2[4 * k4 + 0], a2[4 * k4 + 1]); w.y = pk2(a2[4 * k4 + 2], a2[4 * k4 + 3]);
            *(u32x2*)(Out + (size_t)(64 * half + 32 * ct2 + r32) * 64 + 32 * dt + 8 * k4 + 4 * hi) = w; }
    }
    __syncthreads();
}
__device__ __forceinline__ void kmean_unit(int b, int n, LAS unsigned char* lds, const bf16* PA, float* KMEAN, int tid) {
    const int chunk = tid & 31, tg = tid >> 5;
    const bf16* src = PA + ((size_t)b * SEQ + 256 * n + 16 * tg) * NPA + PA_KM + 8 * chunk;
    f32x4 s0 = {0.f, 0.f, 0.f, 0.f}, s1 = {0.f, 0.f, 0.f, 0.f};
#pragma unroll 4
    for (int t = 0; t < 16; ++t) { const u32x4 w = *(const u32x4*)(src + (size_t)t * NPA); f32x4 a, c; pg8::unpack8(w, a, c); s0 += a; s1 += c; }
    LAS float* red = (LAS float*)lds;
    *(LAS f32x4*)(red + tg * 256 + 8 * chunk) = s0; *(LAS f32x4*)(red + tg * 256 + 8 * chunk + 4) = s1;
    __syncthreads();
    if (tid < 256) { float s = 0.f;
#pragma unroll
        for (int t = 0; t < 16; ++t) s += red[t * 256 + tid];
        KMEAN[((size_t)(b * 4 + (tid >> 6)) * 8 + n) * 64 + (tid & 63)] = s * (1.f / 256.f); }
    __syncthreads();
}

#ifndef PROBE_DMA
#define PROBE_DMA 0
#endif
__device__ __forceinline__ void glds16(const void* gsrc, unsigned lds_dst) { unsigned keep;
    asm volatile("s_mov_b32 %0, m0\n\ts_mov_b32 m0, %2\n\ts_nop 0\n\tglobal_load_lds_dwordx4 %1, off\n\ts_mov_b32 m0, %0" : "=&s"(keep) : "v"(gsrc), "s"(lds_dst) : "memory"); }
__device__ __forceinline__ void stage_kv(LAS unsigned char* buf, const bf16* kptr, const bf16* vptr, int pitch, int wid, int lane) {
    const int kkey = 8 * wid + (lane >> 3);
    const bf16* ks = kptr + (size_t)kkey * pitch + (((lane & 7) ^ ((kkey >> 1) & 7)) * 8);
    const bf16* vs = vptr + (size_t)(16 * (wid & 3) + (lane >> 2)) * pitch + (wid >> 2) * 32 + (lane & 3) * 8;
    const unsigned dst = (unsigned)__builtin_amdgcn_readfirstlane((int)(unsigned)(uintptr_t)buf + wid * 1024);
    glds16(ks, dst); glds16(vs, dst + 8192u);
    if (PROBE_DMA) { glds16(ks, dst); glds16(vs, dst + 8192u); }
}
typedef __bf16 bf16x2_t __attribute__((ext_vector_type(2)));
__device__ __forceinline__ unsigned cvtpk_s(float lo, float hi) { f32x2 v = {lo, hi}; bf16x2_t b = __builtin_convertvector(v, bf16x2_t); return __builtin_bit_cast(unsigned, b); }
__device__ __forceinline__ bf16x8 pack_p(const f32x16& p, int s) {
    u32x4 w; w.x = cvtpk_s(p[8 * s + 0], p[8 * s + 1]); w.y = cvtpk_s(p[8 * s + 2], p[8 * s + 3]); w.z = cvtpk_s(p[8 * s + 4], p[8 * s + 5]); w.w = cvtpk_s(p[8 * s + 6], p[8 * s + 7]);
    return __builtin_bit_cast(bf16x8, w);
}
__device__ __forceinline__ bf16x8 vfrag(const LAS unsigned char* p) {
    const s16x4 lo = __builtin_bit_cast(s16x4, __builtin_amdgcn_ds_read_tr16_b64_v4i16((LAS s16x4*)p));
    const s16x4 hi = __builtin_bit_cast(s16x4, __builtin_amdgcn_ds_read_tr16_b64_v4i16((LAS s16x4*)(p + 512)));
    return (bf16x8){lo[0], lo[1], lo[2], lo[3], hi[0], hi[1], hi[2], hi[3]};
}
#define RING_WAIT_BAR(n) do { asm volatile("s_waitcnt vmcnt(" #n ")" ::: "memory"); __builtin_amdgcn_s_barrier(); asm volatile("" ::: "memory"); } while (0)
#define RING_STEP_SYNC(j, ns) do { if ((j) + 1 < (ns)) { if (PROBE_DMA) RING_WAIT_BAR(4); else RING_WAIT_BAR(2); } else RING_WAIT_BAR(0); } while (0)
__device__ __forceinline__ float max3f(float a, float b, float c) { float r; asm("v_max3_f32 %0, %1, %2, %3" : "=v"(r) : "v"(a), "v"(b), "v"(c)); return r; }
#define LOADED4(q) asm volatile("" :: "v"((q)[0]), "v"((q)[1]), "v"((q)[2]), "v"((q)[3]))
#define LOADED1(x) asm volatile("" :: "v"(x))
struct WState { f32x16 o0, o1; float m, l; int first; };
typedef unsigned u32x8 __attribute__((ext_vector_type(8)));
struct OtPk { u32x8 a, b; };
__device__ __forceinline__ void ot_set(OtPk& t, const f32x16& o0, const f32x16& o1, float sc) {
#pragma unroll
    for (int i = 0; i < 8; ++i) { t.a[i] = cvtpk_s(o0[2 * i] * sc, o0[2 * i + 1] * sc); t.b[i] = cvtpk_s(o1[2 * i] * sc, o1[2 * i + 1] * sc); }
}
__device__ __forceinline__ void ot_add(OtPk& t, const f32x16& o0, const f32x16& o1, float sc) {
#pragma unroll
    for (int i = 0; i < 8; ++i) { t.a[i] = cvtpk_s(bflo(t.a[i]) + o0[2 * i] * sc, bfhi(t.a[i]) + o0[2 * i + 1] * sc); t.b[i] = cvtpk_s(bflo(t.b[i]) + o1[2 * i] * sc, bfhi(t.b[i]) + o1[2 * i + 1] * sc); }
}
__device__ __forceinline__ void ot_store(bf16* op, const OtPk& t) {
#pragma unroll
    for (int k4 = 0; k4 < 4; ++k4) { u32x2 w0 = {t.a[2 * k4], t.a[2 * k4 + 1]}, w1 = {t.b[2 * k4], t.b[2 * k4 + 1]}; *(u32x2*)(op + 8 * k4) = w0; *(u32x2*)(op + 32 + 8 * k4) = w1; }
}
__device__ __forceinline__ void ws_reset(WState& S) { S.o0 = f32x16{}; S.o1 = f32x16{}; S.m = 0.f; S.l = 0.f; S.first = 1; }
__device__ __forceinline__ void attn_qk(WState& S, const bf16x8 (&q)[4], const LAS unsigned char* buf, float cadd, bool near, const LAS float* nearp, int r32, int hi, bf16x8 (&pa)[4]) {
    const float ci = cadd - S.m;
    f32x16 p0, p1;
#pragma unroll
    for (int r = 0; r < 16; ++r) { p0[r] = ci; p1[r] = ci; }
    const LAS unsigned char* kb = buf + r32 * 128; const int ksw = (r32 >> 1) & 7;
    bf16x8 kf[8];
#pragma unroll
    for (int ks = 0; ks < 4; ++ks) { const int ko = ((2 * ks + hi) ^ ksw) * 16; kf[2 * ks] = *(const LAS bf16x8*)(kb + ko); kf[2 * ks + 1] = *(const LAS bf16x8*)(kb + ko + 4096); }
    __builtin_amdgcn_sched_barrier(0);
#pragma unroll
    for (int ks = 0; ks < 4; ++ks) { p0 = MFMA32(kf[2 * ks], q[ks], p0, 0, 0, 0); p1 = MFMA32(kf[2 * ks + 1], q[ks], p1, 0, 0, 0); }
    asm volatile("s_nop 15\n\ts_nop 7" : "+v"(p0), "+v"(p1));
    if (near) {
#pragma unroll
        for (int r = 0; r < 16; ++r) { const int c = (r & 3) + 8 * (r >> 2); p0[r] += nearp[63 - c]; }
        __builtin_amdgcn_sched_barrier(0);
#pragma unroll
        for (int r = 0; r < 16; ++r) { const int c = (r & 3) + 8 * (r >> 2); p1[r] += nearp[31 - c]; }
    }
    __builtin_amdgcn_sched_barrier(0);
    float rm = max3f(p0[0], p1[0], p0[1]), rm2 = max3f(p1[1], p0[2], p1[2]);
#pragma unroll
    for (int r = 3; r < 15; r += 2) { rm = max3f(rm, p0[r], p1[r]); rm2 = max3f(rm2, p0[r + 1], p1[r + 1]); }
    rm = max3f(rm, p0[15], p1[15]); rm = max3f(rm, rm2, rm2);
    rm = swap_max(rm);
    if (S.first || __any(rm > 5.0f)) {
        const float d = S.first ? rm : fmaxf(rm, 0.f);
        const float f = S.first ? 1.f : __builtin_amdgcn_exp2f(-d);
        S.m += d; S.first = 0; S.l *= f; S.o0 *= f; S.o1 *= f;
#pragma unroll
        for (int r = 0; r < 16; ++r) { p0[r] -= d; p1[r] -= d; }
    }
    float ls = 0.f;
#pragma unroll
    for (int r = 0; r < 16; ++r) { p0[r] = __builtin_amdgcn_exp2f(p0[r]); p1[r] = __builtin_amdgcn_exp2f(p1[r]); ls += p0[r] + p1[r]; }
    S.l += ls;
    pa[0] = pack_p(p0, 0); pa[1] = pack_p(p0, 1); pa[2] = pack_p(p1, 0); pa[3] = pack_p(p1, 1);
}
__device__ __forceinline__ void attn_pv(WState& S, const LAS unsigned char* buf, const bf16x8 (&pa)[4], int hi, int lane) {
    const LAS unsigned char* vb = buf + 8192 + ((lane >> 4) & 1) * 32 + (lane & 3) * 8 + (4 * hi + ((lane & 15) >> 2)) * 64;
#pragma unroll
    for (int s4 = 0; s4 < 4; ++s4) {
        const bf16x8 v0 = vfrag(vb + s4 * 1024), v1 = vfrag(vb + 4096 + s4 * 1024);
        S.o0 = MFMA32(v0, pa[s4], S.o0, 0, 0, 0); S.o1 = MFMA32(v1, pa[s4], S.o1, 0, 0, 0);
    }
}
#ifndef PROBE_CMP
#define PROBE_CMP 1
#endif
#ifndef PROBE_BAR
#define PROBE_BAR 0
#endif
#define STAG_LOOP(NS, ISSUE, QKBLOCK) do { bf16x8 pa[4]; int have = 0; (void)grpB; \
    _Pragma("unroll 1") for (int j = 0; j < (NS); ++j) { \
        RING_STEP_SYNC(j, NS); if (PROBE_BAR) { __builtin_amdgcn_s_barrier(); } \
        if (j + 2 < (NS)) { ISSUE(j + 2); } \
        { QKBLOCK(j); } \
        if (have) attn_pv(S, kvb + (j % 3) * 16384, pa, hi, lane); have = 0; \
    } } while (0)

__device__ __forceinline__ void store_ot(bf16* op  , const f32x16& o0, const f32x16& o1) {
#pragma unroll
    for (int k4 = 0; k4 < 4; ++k4) {
        u32x2 w0, w1; w0.x = pk2(o0[4 * k4 + 0], o0[4 * k4 + 1]); w0.y = pk2(o0[4 * k4 + 2], o0[4 * k4 + 3]); w1.x = pk2(o1[4 * k4 + 0], o1[4 * k4 + 1]); w1.y = pk2(o1[4 * k4 + 2], o1[4 * k4 + 3]);
        *(u32x2*)(op + 8 * k4) = w0; *(u32x2*)(op + 32 + 8 * k4) = w1;
    }
}
__device__ __forceinline__ void attn_tables(LAS unsigned char* lds, const float* rel_bias, int tid) {
    LAS float* tab = (LAS float*)(lds + A_TAB);
    for (int e = tid; e < 20 * TABN; e += 512) { const int t = e / TABN, i = e % TABN, dist = i - 96, head = t < 8 ? t : t - 8; const bool win = t >= 8 && t < 16;
        float v = NEGB; if (dist >= 0 && !(win && dist >= 256)) { const int bk = dist >= 128 ? 31 : t5_bucket(dist); v = rel_bias[bk * 12 + head] * LOG2E; }
        tab[e] = v; }
    LAS float* ct = (LAS float*)(lds + A_CTAB);
    for (int e = tid; e < 8 * CTABN; e += 512) { const int hd = e / CTABN, i = e % CTABN; float v = NEGB;
        if (i >= 1 && i <= 129) { const int dist = i - 1; const int bk = dist >= 128 ? 31 : t5_bucket(dist); v = rel_bias[bk * 12 + hd] * LOG2E; }
        ct[e] = v; }
    __syncthreads();
}

__device__ __forceinline__ void nsa_unit(int b, int g, int qb, LAS unsigned char* lds, const bf16* PA, const bf16* KC, const bf16* VC, bf16* OC, int tid) {
    const int lane = tid & 63, wid = __builtin_amdgcn_readfirstlane(tid >> 6), r32 = lane & 31, hi = lane >> 5;
    const int hh = wid & 3, wq = wid >> 2, head = g * 4 + hh, tq0 = 64 * qb + 32 * wq;
    const size_t row = (size_t)b * SEQ + tq0 + r32;
    bf16x8 q[4];
    { const bf16* qp = PA + row * NPA + PA_QN + head * 64 + 8 * hi;
#pragma unroll
      for (int ks = 0; ks < 4; ++ks) q[ks] = *(const bf16x8*)(qp + 16 * ks); }
    const bf16* gp = PA + row * NPA + PA_GN + head * 3;
    const float g0 = bflo(gp[0]), g1 = bflo(gp[1]), g2 = bflo(gp[2]);
    const bf16* Kc = KC + (size_t)((b * 2 + g) * 128) * 64; const bf16* Vc = VC + (size_t)((b * 2 + g) * 128) * 64;
    const bf16* Ks = PA + (size_t)b * SEQ * NPA + PA_KS + g * 64; const bf16* Vs = PA + (size_t)b * SEQ * NPA + PA_VS + g * 64;
    const bf16* Kw = PA + (size_t)b * SEQ * NPA + PA_KW + g * 64; const bf16* Vw = PA + (size_t)b * SEQ * NPA + PA_VW + g * 64;
    LAS unsigned char* kvb = lds + A_KV; LAS unsigned char* cmpb = lds + A_CMP;
    const int nsel = qb + 1, nwin = qb + 1 < 5 ? qb + 1 : 5, ns = nsel + nwin;
#define NSA_ISSUE(j) do { const int j_ = (j); const bool w_ = j_ >= nsel; const int n_ = w_ ? qb - (j_ - nsel) : qb - j_; \
        stage_kv(kvb + (j_ % 3) * 16384, (w_ ? Kw : Ks) + (size_t)(64 * n_) * NPA, (w_ ? Vw : Vs) + (size_t)(64 * n_) * NPA, NPA, wid, lane); } while (0)
    stage_kv(cmpb, Kc, Vc, 64, wid, lane); stage_kv(cmpb + 16384, Kc + 64 * 64, Vc + 64 * 64, 64, wid, lane);
    NSA_ISSUE(0);
    if (ns > 1) { NSA_ISSUE(1); if (PROBE_DMA) RING_WAIT_BAR(8); else RING_WAIT_BAR(4); } else RING_WAIT_BAR(2);
    OtPk ot;
    for (int prb_ = 0; prb_ < PROBE_CMP; ++prb_) {
    {
        f32x16 sc[4];
#pragma unroll
        for (int ph = 0; ph < 4; ++ph) sc[ph] = f32x16{};
#pragma unroll
        for (int t = 0; t < 2; ++t) { const LAS unsigned char* kb = cmpb + t * 16384 + r32 * 128; const int ksw = (r32 >> 1) & 7;
#pragma unroll
            for (int ks = 0; ks < 4; ++ks) { const int ko = ((2 * ks + hi) ^ ksw) * 16; const bf16x8 k0f = *(const LAS bf16x8*)(kb + ko), k1f = *(const LAS bf16x8*)(kb + ko + 4096);
                sc[2 * t] = MFMA32(k0f, q[ks], sc[2 * t], 0, 0, 0); sc[2 * t + 1] = MFMA32(k1f, q[ks], sc[2 * t + 1], 0, 0, 0); } }
        __builtin_amdgcn_sched_barrier(0);
        const LAS float* ct = (const LAS float*)(lds + A_CTAB) + head * CTABN;
        const int E0 = tq0 + r32 - 31 - 64 * hi;
        float m = NEGB;
#pragma unroll
        for (int ph = 0; ph < 4; ++ph)
#pragma unroll
            for (int k4 = 0; k4 < 4; ++k4) { int base = E0 - 16 * (32 * ph + 8 * k4); asm volatile("" : "+v"(base));
#pragma unroll
                for (int i = 0; i < 4; ++i) { int dist = base - 16 * i; dist = dist < -1 ? -1 : (dist > 128 ? 128 : dist);
                    sc[ph][4 * k4 + i] += ct[dist + 1]; m = fmaxf(m, sc[ph][4 * k4 + i]); } }
        m = swap_max(m);
        const bool valid = m > -1e29f;
        float l = 0.f;
#pragma unroll
        for (int ph = 0; ph < 4; ++ph)
#pragma unroll
            for (int r = 0; r < 16; ++r) { const float e = valid ? __builtin_amdgcn_exp2f(sc[ph][r] - m) : 0.f; sc[ph][r] = e; l += e; }
        l = swap_sum(l);
        const float inv = valid ? 1.0f / l : 0.f;
#pragma unroll
        for (int ph = 0; ph < 4; ++ph) sc[ph] *= inv;
        {
            LAS float* impw = (LAS float*)(lds + A_IMP) + (hh * 64 + 32 * wq + r32) * 33;
            float prevhi = 0.f;
#pragma unroll
            for (int i = 0; i < 16; ++i) { const int ph = i >> 2, k = i & 3;
                const float av = sc[ph][4 * k] + sc[ph][4 * k + 1] + sc[ph][4 * k + 2] + 0.5f * sc[ph][4 * k + 3], bv = 0.5f * sc[ph][4 * k + 3];
                auto rr = __builtin_amdgcn_permlane32_swap(__float_as_uint(bv), __float_as_uint(bv), false, false);
                const float lo_i = __uint_as_float(rr[0]), hi_i = __uint_as_float(rr[1]);
                impw[2 * k + hi + 8 * ph] = av + (hi ? lo_i : prevhi); prevhi = hi_i; }
        }
        __builtin_amdgcn_sched_barrier(0);
        f32x16 o0 = f32x16{}, o1 = f32x16{};
#pragma unroll
        for (int ph = 0; ph < 4; ++ph)
#pragma unroll
            for (int s = 0; s < 2; ++s) { const bf16x8 pa = pack_p(sc[ph], s);
                const LAS unsigned char* vb = cmpb + (ph >> 1) * 16384 + 8192 + ((lane >> 4) & 1) * 32 + (lane & 3) * 8 + (4 * hi + ((lane & 15) >> 2)) * 64 + (2 * (ph & 1) + s) * 1024;
                const bf16x8 v0 = vfrag(vb), v1 = vfrag(vb + 4096);
                o0 = MFMA32(v0, pa, o0, 0, 0, 0); o1 = MFMA32(v1, pa, o1, 0, 0, 0); }
        ot_set(ot, o0, o1, g0);
    }
    __syncthreads();
    {
        const LAS float* impb = (const LAS float*)(lds + A_IMP); LAS float* scb = (LAS float*)(lds + A_SC); LAS unsigned* selb = (LAS unsigned*)(lds + A_SEL);
#pragma unroll 1
        for (int it = 0; it < 4; ++it) { const int e = tid + 512 * it, tok = e >> 5, n = e & 31;
            float s = (impb[(0 * 64 + tok) * 33 + n] + impb[(1 * 64 + tok) * 33 + n]) + (impb[(2 * 64 + tok) * 33 + n] + impb[(3 * 64 + tok) * 33 + n]);
            const bool forced = (n == 0) | (n == qb) | (n == qb - 1);
            s = forced ? 1e4f : (n <= qb ? s : NEGB);
            scb[tok * 33 + n] = s;
            LDS_WAIT();
            int rank = 0;
#pragma unroll 8
            for (int mm = 0; mm < 32; ++mm) { const float sm = scb[tok * 33 + mm]; rank += ((sm > s) | ((sm == s) & (mm < n))) ? 1 : 0; }
            const bool sel = (rank < 8) && (s > -5e29f);
            const unsigned long long bal = __ballot(sel);
            if ((lane & 31) == 0) selb[tok] = (unsigned)(bal >> (lane & 32));
        }
    }
    __syncthreads();
    }
    const unsigned mymask = ((const LAS unsigned*)(lds + A_SEL))[32 * wq + r32];
    const LAS float* tabC = (const LAS float*)(lds + A_TAB) + head * TABN; const LAS float* tabW = (const LAS float*)(lds + A_TAB) + (8 + head) * TABN;
    const float cfar = tabC[96 + 128];
    WState S; ws_reset(S);
    LOADED4(q); LOADED1(g1); LOADED1(g2);
    const int grpB = wq;
#define NSA_QK(j) do { \
        if ((j) == nsel) { const float lt = swap_sum(S.l); ot_add(ot, S.o0, S.o1, g1 / lt); ws_reset(S); } \
        const bool win = (j) >= nsel; const int n = win ? qb - ((j) - nsel) : qb - (j); const int a = (tq0 - 64 * n) >> 5; \
        const LAS unsigned char* buf = kvb + ((j) % 3) * 16384; const int D0 = tq0 + r32 - 64 * n - 4 * hi; \
        if (!win) { const bool near = a < 6; const float cadd = (((mymask >> n) & 1u) ? 0.f : NEGB) + (near ? 0.f : cfar); attn_qk(S, q, buf, cadd, near, tabC + (D0 + 33), r32, hi, pa); have = 1; } \
        else if (a < 10) { const bool far = (a == 6) | (a == 7); attn_qk(S, q, buf, far ? cfar : 0.f, !far, tabW + (D0 + 33), r32, hi, pa); have = 1; } } while (0)
    STAG_LOOP(ns, NSA_ISSUE, NSA_QK);
#undef NSA_QK
    { const float lt = swap_sum(S.l); ot_add(ot, S.o0, S.o1, g2 / lt); }
    ot_store(OC + row * DM + head * 64 + 4 * hi, ot);
    __syncthreads();
#undef NSA_ISSUE
}

__device__ __forceinline__ void moba_unit(int b, int h, int ob, LAS unsigned char* lds, const bf16* PA, const float* KMEAN, bf16* OC, int tid) {
    const int lane = tid & 63, wid = __builtin_amdgcn_readfirstlane(tid >> 6), r32 = lane & 31, hi = lane >> 5;
    const int tq0 = 256 * ob + 32 * wid;
    const size_t row = (size_t)b * SEQ + tq0 + r32;
    bf16x8 q[4];
    { const bf16* qp = PA + row * NPA + PA_QM + h * 64 + 8 * hi;
#pragma unroll
      for (int ks = 0; ks < 4; ++ks) q[ks] = *(const bf16x8*)(qp + 16 * ks); }
    const bf16* Km = PA + (size_t)b * SEQ * NPA + PA_KM + h * 64; const bf16* Vm = PA + (size_t)b * SEQ * NPA + PA_VM + h * 64;
    LAS unsigned char* kvb = lds + A_KV;
    const int ns = 4 * (ob + 1);
#define MOBA_ISSUE(j) do { const int j_ = (j); const int n_ = ns - 1 - j_; stage_kv(kvb + (j_ % 3) * 16384, Km + (size_t)(64 * n_) * NPA, Vm + (size_t)(64 * n_) * NPA, NPA, wid, lane); } while (0)
    MOBA_ISSUE(0); MOBA_ISSUE(1);
    LAS float* km = (LAS float*)(lds + A_KMEAN); LAS float* mg = (LAS float*)(lds + A_MG);
    km[tid] = KMEAN[(size_t)(b * 4 + h) * 512 + tid];
    __syncthreads();
    {
        const int tok = tid >> 1, hf = tid & 1; const bf16* qrow = PA + ((size_t)b * SEQ + 256 * ob + tok) * NPA + PA_QM + h * 64;
        f32x4 acc = {0.f, 0.f, 0.f, 0.f};
#pragma unroll 1
        for (int c8 = 0; c8 < 8; ++c8) { const u32x4 w = *(const u32x4*)(qrow + 8 * c8); f32x4 qa, qb_; pg8::unpack8(w, qa, qb_);
#pragma unroll
            for (int i = 0; i < 4; ++i) { const LAS float* kp = km + (4 * hf + i) * 64 + 8 * c8; const f32x4 ka = *(const LAS f32x4*)kp, kb = *(const LAS f32x4*)(kp + 4);
                acc[i] += (qa.x * ka.x + qa.y * ka.y) + (qa.z * ka.z + qa.w * ka.w) + (qb_.x * kb.x + qb_.y * kb.y) + (qb_.z * kb.z + qb_.w * kb.w); } }
        *(LAS f32x4*)(mg + tok * 8 + 4 * hf) = acc;
    }
    __syncthreads();
    unsigned mymask = 0u;
    { const LAS float* gp = mg + (32 * wid + r32) * 8; const f32x4 ga = *(const LAS f32x4*)gp, gb = *(const LAS f32x4*)(gp + 4);
      const float gt[8] = {ga.x, ga.y, ga.z, ga.w, gb.x, gb.y, gb.z, gb.w};
#pragma unroll
      for (int n = 0; n < 8; ++n) { int rank = 0;
#pragma unroll
          for (int mm = 0; mm < 8; ++mm) rank += ((mm < ob) & ((gt[mm] > gt[n]) | ((gt[mm] == gt[n]) & (mm < n)))) ? 1 : 0;
          if ((n < ob) & (rank < 3)) mymask |= 1u << n; } }
    const LAS float* tabM = (const LAS float*)(lds + A_TAB) + (16 + h) * TABN;
    const float cfar = tabM[96 + 128];
    WState S; ws_reset(S);
    LOADED4(q);
    const int grpB = wid >> 2;
#define MOBA_QK(j) do { const int n = ns - 1 - (j), blk = n >> 2; \
        if (tq0 + 31 - 64 * n >= 0) { const int a = (tq0 - 64 * n) >> 5; const bool near = a < 6; float cadd = near ? 0.f : cfar; \
            if (blk < ob) cadd += ((mymask >> blk) & 1u) ? 0.f : NEGB; \
            const int D0 = tq0 + r32 - 64 * n - 4 * hi; \
            attn_qk(S, q, kvb + ((j) % 3) * 16384, cadd, near, tabM + (D0 + 33), r32, hi, pa); have = 1; } } while (0)
    STAG_LOOP(ns, MOBA_ISSUE, MOBA_QK);
#undef MOBA_QK
    { const float lt = swap_sum(S.l); const float scl = 1.0f / lt; S.o0 *= scl; S.o1 *= scl; }
    store_ot(OC + row * DM + 512 + h * 64 + 4 * hi, S.o0, S.o1);
    __syncthreads();
#undef MOBA_ISSUE
}

__device__ __forceinline__ void mem_unit(int b, int h, int tb, LAS unsigned char* lds, const bf16* PA, const bf16* MKV, bf16* OC, int tid) {
    const int lane = tid & 63, wid = __builtin_amdgcn_readfirstlane(tid >> 6), r32 = lane & 31, hi = lane >> 5;
    const int tq0 = 256 * tb + 32 * wid;
    const size_t row = (size_t)b * SEQ + tq0 + r32;
    bf16x8 q[4];
    { const bf16* qp = PA + row * NPA + PA_QX + h * 64 + 8 * hi;
#pragma unroll
      for (int ks = 0; ks < 4; ++ks) q[ks] = *(const bf16x8*)(qp + 16 * ks); }
    const bf16* Kx = MKV + (size_t)b * MEML * 1024 + h * 64; const bf16* Vx = Kx + 256;
    LAS unsigned char* kvb = lds + A_KV;
    stage_kv(kvb, Kx, Vx, 1024, wid, lane); stage_kv(kvb + 16384, Kx + (size_t)64 * 1024, Vx + (size_t)64 * 1024, 1024, wid, lane);
    WState S; ws_reset(S);
    LOADED4(q);
    const int grpB = wid >> 2;
#define MEM_ISSUE(j) stage_kv(kvb + ((j) % 3) * 16384, Kx + (size_t)(64 * (j)) * 1024, Vx + (size_t)(64 * (j)) * 1024, 1024, wid, lane)
#define MEM_QK(j) do { attn_qk(S, q, kvb + ((j) % 3) * 16384, 0.f, false, (const LAS float*)(lds + A_TAB), r32, hi, pa); have = 1; } while (0)
    STAG_LOOP(4, MEM_ISSUE, MEM_QK);
#undef MEM_QK
#undef MEM_ISSUE
    { const float lt = swap_sum(S.l); const float scl = 1.0f / lt; S.o0 *= scl; S.o1 *= scl; }
    store_ot(OC + row * DM + 768 + h * 64 + 4 * hi, S.o0, S.o1);
    __syncthreads();
}

#ifndef MK_MULTI_LAUNCH
#define MK_MULTI_LAUNCH 0
#endif
constexpr int N_PHASES = 20;
__device__ __forceinline__ int lane_now() { unsigned z = 0u; asm volatile("" : "+s"(z)); return (int)__builtin_amdgcn_mbcnt_hi(~0u, __builtin_amdgcn_mbcnt_lo(~0u, z)); }
struct Args { const float* in[23]; float* out; unsigned char* ws; int ph_lo, ph_hi; };

__global__ void __launch_bounds__(512, 2) fwd_kernel(Args args) {
    extern __shared__ __attribute__((aligned(16))) unsigned char lds_raw[];
    LAS unsigned char* lds = (LAS unsigned char*)lds_raw;
    volatile LAS unsigned* MISC = (volatile LAS unsigned*)(lds + MISC_OFF);
    const int wave = __builtin_amdgcn_readfirstlane((int)threadIdx.x >> 6);
#define TID_NOW (wave * 64 + lane_now())
    const int G = gridDim.x, bx_k = blockIdx.x; const int vcu_k = (G % 8 == 0) ? (bx_k % 8) * (G / 8) + bx_k / 8 : bx_k;
    unsigned* ctl = (unsigned*)(args.ws + WS_CTL);
    for (int u = threadIdx.x; u < (LDS_BYTES - MISC_OFF) / 4; u += 512) MISC[u] = 0u;
    __syncthreads();
    const int lo = args.ph_lo, hi = args.ph_hi;
    XcdBarrier bar; bar.bar = ctl + CW_BAR; bar.x = 0; bar.st = nullptr;
    if (hi - lo > 1) bar = xcd_barrier_post(ctl + CW_BAR, MISC + 8);
#ifndef ATT_EN
#define ATT_EN 7
#endif
#ifndef REP_J
#define REP_J -1
#endif
#define NREP(j) ((REP_J) == (j) ? 2 : 1)
#ifndef PHMASK
#define PHMASK 0x3ff
#endif
#define IN(k) (lo <= (k) && (k) < hi)
#define INJ(j) (((PHMASK >> ((j) + 1)) & 1) && IN(pb + (j)))
#define SEAM(k) do { if (IN(k) && IN((k) + 1)) xcd_barrier(bar); } while (0)
    typedef const __attribute__((address_space(4))) unsigned char* kaptr_t;
#define KA_DECL kaptr_t ka = (kaptr_t)__builtin_amdgcn_kernarg_segment_ptr(); int bx = bx_k, vcu = vcu_k, gw = gw_k; asm volatile("" : "+s"(ka), "+s"(bx), "+s"(vcu), "+s"(gw)); unsigned char* ws = *(unsigned char* const __attribute__((address_space(4)))*)(ka + 192)
#define KIN(i) (*(const float* const __attribute__((address_space(4)))*)(ka + 8 * (i)))
#define KOUT (*(float* const __attribute__((address_space(4)))*)(ka + 184))
    const int gw_k = vcu_k * 8 + wave, NGW = G * 8;

    if ((PHMASK & 1) && IN(0)) for (int rep_ = 0; rep_ < ((REP_J) == 100 ? 2 : 1); ++rep_) {
        const int lane = TID_NOW & 63;
        KA_DECL; const float* x_in = KIN(0); const float* mem_in = KIN(1); const float* pre_mix_g = KIN(3); const float* mem_norm_g = KIN(4); bf16* MEMN = (bf16*)KOUT; unsigned char* H8 = ws + WS_H; float* SA = (float*)(ws + WS_SA); unsigned* CMAX = (unsigned*)(ws + WS_CTL) + CW_CMAX;
        LAS float* scr = (LAS float*)(lds + wave * 16384);
        if ((gw & 7) == 0 && (gw >> 3) < 128) {
            const int t = gw >> 3, kc = t & 15, t8 = t >> 4, l = t8 >> 2, kv = (t8 >> 1) & 1, nh = t8 & 1, n = 64 * nh + lane;
            const float* pos = KIN(kv ? 10 : 7) + (size_t)l * 2048 + 128 * kc; const float* w1 = KIN(kv ? 11 : 8) + (size_t)l * 2048 * 128 + (size_t)(128 * kc) * 128;
            float acc = 0.f;
#pragma unroll 16
            for (int k = 0; k < 128; ++k) acc += pos[k] * w1[(size_t)k * 128 + n];
            ((float*)(ws + WS_POSP))[t * 64 + lane] = acc;
        }
        constexpr int I0 = 0, I1 = I0 + 16 * 176, I2 = I1 + 16 * 176, I3 = I2 + 44 * 32, I4 = I3 + 8 * 32, I5 = I4 + 4 * 32, I6 = I5 + 4 * 32, I7 = I6 + 16 * 32, I8 = I7 + 16 * 16, I9 = I8 + 32 * 4, I10 = I9 + 32 * 4, I11 = I10 + 4, ITOT = I11 + 4;
#pragma unroll 1
        for (int gi = gw; gi < 2 * ITOT; gi += NGW) {
            const int l = gi / ITOT, r = gi % ITOT;
            unsigned char* wl = ws + WS_W + l * WL_STRIDE;
            const int mi = r < I1 ? 0 : r < I2 ? 1 : r < I3 ? 2 : r < I4 ? 3 : r < I5 ? 4 : r < I6 ? 5 : r < I7 ? 6 : r < I8 ? 7 : r < I9 ? 8 : r < I10 ? 9 : r < I11 ? 10 : 11;
            int kind = 0, ldw = 0, Ndst = 0, ldt = 0, kdst = 0, it0 = 0; const float* W = nullptr; const float* W2 = nullptr; bf16* WT = nullptr; const float* kgain = nullptr;
            switch (mi) {
                case 0: kind = 1; W = KIN(6) + (size_t)l * 1024 * INW; ldw = INW; Ndst = NIN; WT = (bf16*)(wl + WL_IN); ldt = 1024; it0 = I0; break;
                case 1: kind = 2; W = KIN(20) + (size_t)l * 1024 * DFF; W2 = KIN(21) + (size_t)l * 1024 * DFF; ldw = DFF; Ndst = NGU; WT = (bf16*)(wl + WL_GU); ldt = 1024; it0 = I1; break;
                case 2: W = KIN(22) + (size_t)l * DFF * 1024; ldw = 1024; Ndst = 1024; WT = (bf16*)(wl + WL_DN); ldt = DFF; it0 = I2; break;
                case 3: W = KIN(14) + (size_t)l * 512 * 1024; ldw = 1024; Ndst = 1024; WT = (bf16*)(wl + WL_BR); ldt = 1024; kdst = 0; it0 = I3; break;
                case 4: W = KIN(15) + (size_t)l * 256 * 1024; ldw = 1024; Ndst = 1024; WT = (bf16*)(wl + WL_BR); ldt = 1024; kdst = 512; it0 = I4; break;
                case 5: W = KIN(16) + (size_t)l * 256 * 1024; ldw = 1024; Ndst = 1024; WT = (bf16*)(wl + WL_BR); ldt = 1024; kdst = 768; it0 = I5; break;
                case 6: W = KIN(17) + (size_t)l * 1024 * 1024; ldw = 1024; Ndst = 1024; WT = (bf16*)(wl + WL_MIX); ldt = 1024; it0 = I6; break;
                case 7: W = KIN(13) + (size_t)l * 1024 * 512; ldw = 512; Ndst = 512; WT = (bf16*)(ws + WS_MKV2) + (size_t)l * 512 * 1024; ldt = 1024; kgain = mem_norm_g + l * DM; it0 = I7; break;
                case 8: W = KIN(8) + (size_t)l * 2048 * 128; ldw = 128; Ndst = 128; WT = (bf16*)(wl + WL_W1K); ldt = 2048; it0 = I8; break;
                case 9: W = KIN(11) + (size_t)l * 2048 * 128; ldw = 128; Ndst = 128; WT = (bf16*)(wl + WL_W1V); ldt = 2048; it0 = I9; break;
                case 10: W = KIN(9) + (size_t)l * 128 * 64; ldw = 64; Ndst = 64; WT = (bf16*)(wl + WL_W2K); ldt = 128; it0 = I10; break;
                default: W = KIN(12) + (size_t)l * 128 * 64; ldw = 64; Ndst = 64; WT = (bf16*)(wl + WL_W2V); ldt = 128; it0 = I11; break;
            }
            tr_one(kind, W, W2, ldw, Ndst, WT, ldt, kdst, scr, r - it0, lane, mi < 2 ? CMAX + (l * 2 + mi) * NIN : (unsigned*)nullptr, kgain);
        }
        for (int m0 = 4 * gw; m0 < NMEM; m0 += 4 * NGW) {
            const float* xr[4] = {mem_in + (size_t)m0 * DM, mem_in + (size_t)(m0 + 1) * DM, mem_in + (size_t)(m0 + 2) * DM, mem_in + (size_t)(m0 + 3) * DM};
            bf16* orow[4] = {MEMN + (size_t)m0 * DM, MEMN + (size_t)(m0 + 1) * DM, MEMN + (size_t)(m0 + 2) * DM, MEMN + (size_t)(m0 + 3) * DM};
            rms_rows_bf16<4>(xr, (const float*)nullptr, orow, lane); }
        for (int m0 = 4 * gw; m0 < NTOK; m0 += 4 * NGW) {
            const float* xr[4] = {x_in + (size_t)m0 * DM, x_in + (size_t)(m0 + 1) * DM, x_in + (size_t)(m0 + 2) * DM, x_in + (size_t)(m0 + 3) * DM};
            unsigned char* orow[4] = {H8 + (size_t)m0 * DM, H8 + (size_t)(m0 + 1) * DM, H8 + (size_t)(m0 + 2) * DM, H8 + (size_t)(m0 + 3) * DM};
            float* sap[4] = {SA + m0, SA + m0 + 1, SA + m0 + 2, SA + m0 + 3};
            rms_rows_i8<4>(xr, pre_mix_g, orow, sap, lane); }
    }
    SEAM(0);
    if ((PHMASK & 1) && IN(1)) {
        const int lane = TID_NOW & 63;
        KA_DECL; const unsigned* CMAX = (const unsigned*)(ws + WS_CTL) + CW_CMAX;
        if ((gw & 7) == 1 && (gw >> 3) < 8) { const int t8 = gw >> 3, l = t8 >> 2, kv = (t8 >> 1) & 1, nh = t8 & 1; float s = 0.f;
#pragma unroll
            for (int kc = 0; kc < 16; ++kc) s += ((const float*)(ws + WS_POSP))[(t8 * 16 + kc) * 64 + lane];
            ((float*)(ws + WS_W + l * WL_STRIDE + (kv ? WL_POSV : WL_POSK)))[64 * nh + lane] = s; }
        for (int r = gw; r < 4 * NIN; r += NGW) { const int lm = r / NIN, n = r % NIN, l = lm >> 1, mat = lm & 1;
            unsigned char* wl = ws + WS_W + l * WL_STRIDE; unsigned char* rowp = wl + (mat ? WL_GU : WL_IN) + (size_t)n * 2048;
            const u32x4 w0 = *((const u32x4*)rowp + 2 * lane), w1 = *((const u32x4*)rowp + 2 * lane + 1);
            const float am = __uint_as_float(CMAX[r]); const float inv = am > 0.f ? 127.f / am : 0.f;
            f32x4 a, b, c, d; pg8::unpack8(w0, a, b); pg8::unpack8(w1, c, d);
            u32x4 o; o.x = q8x4(a, inv); o.y = q8x4(b, inv); o.z = q8x4(c, inv); o.w = q8x4(d, inv);
            asm volatile("" ::: "memory");
            *((u32x4*)rowp + lane) = o;
            if (lane == 0) ((float*)(wl + (mat ? WL_SBGU : WL_SBIN)))[n] = am > 0.f ? am * (1.f / 127.f) : 1.f; }
    }
    SEAM(1);

#pragma unroll 1
    for (int l = 0; l < 2; ++l) {
        const int pb = 2 + 9 * l;
        if (INJ(0)) for (int rep_ = 0; rep_ < NREP(0); ++rep_) {
            KA_DECL; unsigned char* wl = ws + WS_W + l * WL_STRIDE; bf16* H = (bf16*)(ws + WS_H); bf16* PA = (bf16*)(ws + WS_PA); bf16* GT = (bf16*)(ws + WS_GT); bf16* MEMN = (bf16*)KOUT; bf16* MEMKV = (bf16*)(ws + WS_MEMKV);
            { pg8::Gemm g{H, (const bf16*)(wl + WL_IN), NTOK, NIN, 512, 512, 1024}; pg8::StaticOrder S; S.init(NTOK, NIN, G, bx);
              pg8::EpiProj E{PA, GT, (const float*)(ws + WS_SA), (const float*)(wl + WL_SBIN)}; pg8::gemm_phase<pg8::EpiProj, pg8::StaticOrder, true, true, true>(lds, g, S, E, wave); }
        }
        SEAM(pb + 0);
        if (INJ(1)) for (int rep_ = 0; rep_ < NREP(1); ++rep_) {
            int tid_p = TID_NOW; asm volatile("" : "+v"(tid_p));
            KA_DECL; unsigned char* wl = ws + WS_W + l * WL_STRIDE; bf16* PA = (bf16*)(ws + WS_PA); bf16* KC = (bf16*)(ws + WS_KC); bf16* VC = (bf16*)(ws + WS_VC); float* KMEAN = (float*)(ws + WS_KMEAN);
            for (int u = bx; u < 256; u += G) {
                if (u < 128) compress_unit(u, lds, PA, wl, KC, VC, tid_p);
                else kmean_unit((u - 128) >> 3, (u - 128) & 7, lds, PA, KMEAN, tid_p);
            }
            if (l == 0 && (G != 256 || bx >= 128)) {
                pg8::Gemm g{(const bf16*)KOUT, (const bf16*)(ws + WS_MKV2), NMEM, 1024, 1024, 1024, 1024};
                pg8::StaticOrder S; S.init(NMEM, 1024, G == 256 ? 128 : G, G == 256 ? bx - 128 : bx); pg8::EpiPlain E{(bf16*)(ws + WS_MEMKV), 1024};
                pg8::gemm_phase<pg8::EpiPlain, pg8::StaticOrder, true, true>(lds, g, S, E, wave); }
        }
        SEAM(pb + 1);
        if (INJ(2)) for (int rep_ = 0; rep_ < NREP(2); ++rep_) {
            int tid_p = TID_NOW; asm volatile("" : "+v"(tid_p));
            KA_DECL; const float* rel_bias = KIN(2); bf16* H = (bf16*)(ws + WS_H); bf16* PA = (bf16*)(ws + WS_PA); bf16* KC = (bf16*)(ws + WS_KC); bf16* VC = (bf16*)(ws + WS_VC); float* KMEAN = (float*)(ws + WS_KMEAN); bf16* MEMKV = (bf16*)(ws + WS_MEMKV);
            attn_tables(lds, rel_bias, tid_p);
            if (ATT_EN & 1) for (int rp_ = 0; rp_ < ((REP_J) == 20 ? 2 : 1); ++rp_)
#pragma unroll 1
            for (int P = vcu; P < 512; P += G) { const int bg = P >> 4, s = P & 15;
#pragma unroll 1
                for (int k = 0; k < 2; ++k) nsa_unit(bg >> 1, bg & 1, k ? 31 - s : s, lds, PA, KC, VC, H, tid_p); }
            if (ATT_EN & 2) for (int rp_ = 0; rp_ < ((REP_J) == 21 ? 2 : 1); ++rp_)
#pragma unroll 1
            for (int M = vcu; M < 256; M += G) { const int bh = M >> 2, s = M & 3;
#pragma unroll 1
                for (int k = 0; k < 2; ++k) moba_unit(bh >> 2, bh & 3, k ? 7 - s : s, lds, PA, KMEAN, H, tid_p); }
            if (ATT_EN & 4) for (int rp_ = 0; rp_ < ((REP_J) == 22 ? 2 : 1); ++rp_)
#pragma unroll 1
            for (int u = vcu; u < 512; u += G) { const int bh = u >> 3; mem_unit(bh >> 2, bh & 3, u & 7, lds, PA, MEMKV + l * 512, H, tid_p); }
        }
        SEAM(pb + 2);
        if (INJ(3)) for (int rep_ = 0; rep_ < NREP(3); ++rep_) {
            KA_DECL; unsigned char* wl = ws + WS_W + l * WL_STRIDE; bf16* H = (bf16*)(ws + WS_H); bf16* MERGED = (bf16*)(ws + WS_PA); bf16* GT = (bf16*)(ws + WS_GT);
            pg8::Gemm g{H, (const bf16*)(wl + WL_BR), NTOK, 1024, 1024, 1024, 1024}; pg8::StaticOrder S; S.init(NTOK, 1024, G, bx);
            pg8::EpiMerge1P E{MERGED, 1024, (const unsigned char*)GT, NGT, 8, 12};
            pg8::gemm_phase<pg8::EpiMerge1P, pg8::StaticOrder, true, true>(lds, g, S, E, wave);
        }
        SEAM(pb + 3);
        if (INJ(4)) for (int rep_ = 0; rep_ < NREP(4); ++rep_) {
            KA_DECL; unsigned char* wl = ws + WS_W + l * WL_STRIDE; bf16* MERGED = (bf16*)(ws + WS_PA); bf16* YB = (bf16*)(ws + WS_GT);
            pg8::Gemm g{MERGED, (const bf16*)(wl + WL_MIX), NTOK, 1024, 1024, 1024, 1024}; pg8::StaticOrder S; S.init(NTOK, 1024, G, bx);
            pg8::EpiPlain E{YB, 1024}; pg8::gemm_phase<pg8::EpiPlain, pg8::StaticOrder, true, true>(lds, g, S, E, wave);
        }
        SEAM(pb + 4);
        if (INJ(5)) for (int rep_ = 0; rep_ < (((REP_J) == 5 && l == 0) ? 2 : 1); ++rep_) {
            int lane_p = TID_NOW & 63; asm volatile("" : "+v"(lane_p));
            KA_DECL; float* xres = KOUT; const float* post_mix_g = KIN(5); const float* pre_ffn_g = KIN(18); bf16* YB = (bf16*)(ws + WS_GT); unsigned char* H8 = ws + WS_H; float* SA = (float*)(ws + WS_SA);
            unsigned char* XB0 = (unsigned char*)xres; unsigned char* XB1 = ws + WS_PA + 64 * MiB;
            for (int m0 = 2 * gw; m0 < NTOK; m0 += 2 * NGW) {
                const bf16* sr[2] = {YB + (size_t)m0 * DM, YB + (size_t)(m0 + 1) * DM};
                unsigned char* ho[2] = {H8 + (size_t)m0 * DM, H8 + (size_t)(m0 + 1) * DM}; float* sap[2] = {SA + m0, SA + m0 + 1};
                if (l == 0) { const void* xi[2] = {KIN(0) + (size_t)m0 * DM, KIN(0) + (size_t)(m0 + 1) * DM}; void* xo[2] = {XB0 + (size_t)m0 * DM * 2, XB0 + (size_t)(m0 + 1) * DM * 2};
                    norm_res_norm<2, true, false>(sr, post_mix_g + l * DM, xi, xo, pre_ffn_g + l * DM, ho, sap, true, lane_p); }
                else { const void* xi[2] = {XB0 + (size_t)m0 * DM * 2, XB0 + (size_t)(m0 + 1) * DM * 2}; void* xo[2] = {XB1 + (size_t)m0 * DM * 2, XB1 + (size_t)(m0 + 1) * DM * 2};
                    norm_res_norm<2, false, false>(sr, post_mix_g + l * DM, xi, xo, pre_ffn_g + l * DM, ho, sap, true, lane_p); } }
        }
        SEAM(pb + 5);
        if (INJ(6)) for (int rep_ = 0; rep_ < NREP(6); ++rep_) {
            KA_DECL; unsigned char* wl = ws + WS_W + l * WL_STRIDE; bf16* H = (bf16*)(ws + WS_H); bf16* UB = (bf16*)(ws + WS_GT);
            pg8::Gemm g{H, (const bf16*)(wl + WL_GU), NTOK, NGU, 512, 512, 1024}; pg8::StaticOrder S; S.init(NTOK, NGU, G, bx);
            pg8::EpiSwiGLU E{UB, DFF, (const float*)(ws + WS_SA), (const float*)(wl + WL_SBGU)}; pg8::gemm_phase<pg8::EpiSwiGLU, pg8::StaticOrder, true, true, true>(lds, g, S, E, wave);
        }
        SEAM(pb + 6);
        if (INJ(7)) for (int rep_ = 0; rep_ < NREP(7); ++rep_) {
            KA_DECL; unsigned char* wl = ws + WS_W + l * WL_STRIDE; bf16* UB = (bf16*)(ws + WS_GT); bf16* FB = (bf16*)(ws + WS_PA);
            pg8::Gemm g{UB, (const bf16*)(wl + WL_DN), NTOK, 1024, DFF, DFF, DFF}; pg8::StaticOrder S; S.init(NTOK, 1024, G, bx);
            pg8::EpiPlain E{FB, 1024}; pg8::gemm_phase<pg8::EpiPlain, pg8::StaticOrder, true, true>(lds, g, S, E, wave);
        }
        SEAM(pb + 7);
        if (INJ(8)) {
            int lane_p = TID_NOW & 63; asm volatile("" : "+v"(lane_p));
            KA_DECL; float* xres = KOUT; const float* post_ffn_g = KIN(19); const float* pre_mix_g = KIN(3); bf16* FB = (bf16*)(ws + WS_PA); unsigned char* H8 = ws + WS_H; float* SA = (float*)(ws + WS_SA);
            unsigned char* XB0 = (unsigned char*)xres; unsigned char* XB1 = ws + WS_PA + 64 * MiB;
            for (int m0 = 2 * gw; m0 < NTOK; m0 += 2 * NGW) {
                const bf16* sr[2] = {FB + (size_t)m0 * DM, FB + (size_t)(m0 + 1) * DM};
                unsigned char* ho[2] = {H8 + (size_t)m0 * DM, H8 + (size_t)(m0 + 1) * DM}; float* sap[2] = {SA + m0, SA + m0 + 1};
                if (l == 0) { const void* xi[2] = {XB0 + (size_t)m0 * DM * 2, XB0 + (size_t)(m0 + 1) * DM * 2}; void* xo[2] = {XB0 + (size_t)m0 * DM * 2, XB0 + (size_t)(m0 + 1) * DM * 2};
                    norm_res_norm<2, false, false>(sr, post_ffn_g + l * DM, xi, xo, pre_mix_g + DM, ho, sap, true, lane_p); }
                else { const void* xi[2] = {XB1 + (size_t)m0 * DM * 2, XB1 + (size_t)(m0 + 1) * DM * 2}; void* xo[2] = {xres + (size_t)m0 * DM, xres + (size_t)(m0 + 1) * DM};
                    norm_res_norm<2, false, true>(sr, post_ffn_g + l * DM, xi, xo, pre_mix_g + DM, ho, sap, false, lane_p); } }
        }
        SEAM(pb + 8);
    }
#undef IN
#undef INJ
#undef SEAM
}

extern "C" void kernel_launch(void* const* d_in, const int* in_sizes, int n_in, void* d_out, int out_size, void* d_ws, size_t ws_size, hipStream_t stream) {
    static int grid = 0;
    if (grid == 0) {
        if (n_in != 23 || in_sizes[0] != NTOK * DM || out_size != NTOK * DM || ws_size < WS_END) { fprintf(stderr, "kernel_launch: unexpected shapes (n_in %d, in0 %d, out %d, ws %zu); nothing launched\n", n_in, n_in > 0 ? in_sizes[0] : -1, out_size, ws_size); grid = -1; return; }
        int dev = 0, cus = 0, per_cu = 0;
        if (hipGetDevice(&dev) != hipSuccess || hipDeviceGetAttribute(&cus, hipDeviceAttributeMultiprocessorCount, dev) != hipSuccess) { grid = -1; return; }
        if (hipFuncSetAttribute((const void*)fwd_kernel, hipFuncAttributeMaxDynamicSharedMemorySize, LDS_BYTES) != hipSuccess) { fprintf(stderr, "kernel_launch: hipFuncSetAttribute failed\n"); grid = -1; return; }
        if (hipOccupancyMaxActiveBlocksPerMultiprocessor(&per_cu, (const void*)fwd_kernel, 512, LDS_BYTES) != hipSuccess || per_cu < 1) fprintf(stderr, "kernel_launch: occupancy query reports %d\n", per_cu);
        (void)hipGetLastError();
        grid = cus;
    }
    if (grid < 0) return;
    if (hipMemsetAsync((char*)d_ws + WS_CTL, 0, CTL_ZERO_BYTES, stream) != hipSuccess) return;
    Args a{};
    for (int i = 0; i < 23; ++i) a.in[i] = (const float*)d_in[i];
    a.out = (float*)d_out; a.ws = (unsigned char*)d_ws;
#if MK_MULTI_LAUNCH
    for (int p = 0; p < N_PHASES; ++p) { a.ph_lo = p; a.ph_hi = p + 1; hipLaunchKernelGGL(fwd_kernel, dim3(grid), dim3(512), LDS_BYTES, stream, a); }
#else
    a.ph_lo = 0; a.ph_hi = N_PHASES;
    hipLaunchKernelGGL(fwd_kernel, dim3(grid), dim3(512), LDS_BYTES, stream, a);
#endif
    const hipError_t le = hipPeekAtLastError();
    if (le != hipSuccess) fprintf(stderr, "kernel_launch: launch failed: %s\n", hipGetErrorName(le));
}
```

```cpp
#include <hip/hip_runtime.h>
#include <cstdio>
#include <cstdint>

#define LAS __attribute__((address_space(3)))
#define GAS __attribute__((address_space(1)))
typedef unsigned short bf16;
typedef short bf16x8 __attribute__((ext_vector_type(8)));
typedef short s16x4 __attribute__((ext_vector_type(4)));
typedef float f32x2 __attribute__((ext_vector_type(2)));
typedef float f32x4 __attribute__((ext_vector_type(4)));
typedef float f32x16 __attribute__((ext_vector_type(16)));
typedef unsigned u32x2 __attribute__((ext_vector_type(2)));
typedef unsigned u32x4 __attribute__((ext_vector_type(4)));

constexpr int BATCH = 16, SEQ = 2048, DM = 1024, NTOK = BATCH * SEQ;
constexpr int NPA = 2560;
constexpr int NGT = 3072;
constexpr int NIN = NPA + NGT;
constexpr int INW = 5400;
constexpr int DFF = 2816, NGU = 2 * DFF;
constexpr int MEML = 256, NMEM = BATCH * MEML;
constexpr int PA_QN = 0, PA_KC = 512, PA_VC = 640, PA_KS = 768, PA_VS = 896, PA_KW = 1024, PA_VW = 1152;
constexpr int PA_QM = 1280, PA_KM = 1536, PA_VM = 1792, PA_QX = 2048, PA_GN = 2304;
constexpr float RMS_EPS = 1e-6f;
constexpr float LOG2E = 1.4426950408889634f;
constexpr float C2 = 0.125f * LOG2E;
constexpr float NEGB = -1e30f;

constexpr size_t MiB = 1u << 20;
constexpr size_t WS_CTL = 0, CTL_ZERO_BYTES = 1 * MiB;
constexpr size_t WS_W = 1 * MiB;
constexpr size_t WL_STRIDE = 35 * MiB;
constexpr size_t WL_IN = 0, WL_GU = 11 * MiB, WL_DN = 22 * MiB, WL_BR = 28 * MiB, WL_MIX = 30 * MiB, WL_MKV = 32 * MiB, WL_W1K = 33 * MiB, WL_W1V = 33 * MiB + 512 * 1024;
constexpr size_t WL_SM = 34 * MiB;
constexpr size_t WL_W2K = WL_SM, WL_W2V = WL_SM + 16384, WL_POSK = WL_SM + 32768, WL_POSV = WL_SM + 32768 + 512;
constexpr size_t WS_MEMKV = 71 * MiB;
constexpr size_t WS_KC = 79 * MiB, WS_VC = 79 * MiB + 512 * 1024;
constexpr size_t WS_KMEAN = 80 * MiB;
constexpr size_t WS_H = 81 * MiB;
constexpr size_t WS_PA = 145 * MiB;
constexpr size_t WS_GT = 305 * MiB;
constexpr size_t WS_MKV2 = 497 * MiB;
constexpr size_t WS_END = 499 * MiB;
static_assert(WL_DN + (size_t)DM * DFF * 2 <= WL_BR && WS_W + 2 * WL_STRIDE <= WS_MEMKV && WS_H + (size_t)NTOK * DM * 2 <= WS_PA && WS_PA + (size_t)NTOK * NPA * 2 <= WS_GT && WS_GT + (size_t)NTOK * NGT * 2 <= WS_MKV2, "ws map");
constexpr int CW_TMO = 0, CW_BAR = 4096;
constexpr int CW_CMAX = 16384;
constexpr size_t WL_SBIN = WL_SM + 65536, WL_SBGU = WL_SM + 98304;
constexpr size_t WS_POSP = WS_KMEAN + 256 * 1024;
constexpr size_t WS_SA = WS_KMEAN + 512 * 1024;
constexpr size_t WS_SU = WS_KMEAN + 640 * 1024;
constexpr int CW_RMAX = 65536;
constexpr int CMAX_DN = 4 * NIN;
constexpr size_t WL_SBDN = WL_SM + 131072;
static_assert((CW_CMAX + 4 * NIN + 2048) <= CW_RMAX && (CW_RMAX + 2 * NTOK) * 4 <= (int)CTL_ZERO_BYTES && WS_SU + NTOK * 4 <= WS_H && WL_SBDN + 4096 <= WL_STRIDE && WL_SBGU + NIN * 4 <= WL_STRIDE && WS_SA + NTOK * 4 <= WS_H, "int8 side tables");

constexpr int RING_BYTES = 131072;
constexpr int MISC_OFF = 156672;
constexpr int LDS_BYTES = 157696;
constexpr int A_KV = 0, A_CMP = 49152, A_TAB = 81920, A_CTAB = 117760, A_IMP = 121984, A_SC = 32768, A_SEL = 32768 + 8448, A_KMEAN = A_IMP, A_MG = A_IMP + 2048;
constexpr int TABN = 448, CTABN = 132;
static_assert(A_IMP + 4 * 64 * 33 * 4 <= MISC_OFF && A_TAB + 20 * TABN * 4 <= A_CTAB && A_CTAB + 8 * CTABN * 4 <= A_IMP, "lds map");

__device__ __forceinline__ unsigned f2bf(float f) { unsigned u = __builtin_bit_cast(unsigned, f); return (u + 0x7fffu + ((u >> 16) & 1u)) >> 16; }
__device__ __forceinline__ unsigned pk2(float lo, float hi) { return f2bf(lo) | (f2bf(hi) << 16); }
__device__ __forceinline__ float bflo(unsigned w) { return __builtin_bit_cast(float, w << 16); }
__device__ __forceinline__ float bfhi(unsigned w) { return __builtin_bit_cast(float, w & 0xffff0000u); }
__device__ __forceinline__ float fast_sigmoid(float v) { return __builtin_amdgcn_rcpf(1.0f + __builtin_amdgcn_exp2f(-LOG2E * v)); }

namespace pg8 {
#define PG8_LAS __attribute__((address_space(3)))
typedef unsigned short bf16_t;
constexpr int BM = 256, BK = 64, HALF = 128, HTB = HALF * BK * 2  , STAGE_BYTES = 8 * HTB, NXCD = 8, WGM = 8;

__host__ __device__ __forceinline__ int lds_byte(int r, int c) { const int st = (r >> 4) * 2 + (c >> 5), rr = r & 15, cc = c & 31, ob = rr * 64 + cc * 2; return st * 1024 + (ob ^ (((ob >> 9) & 1) << 5)); }
__host__ __device__ __forceinline__ void stage_rc(int b, int& R, int& C) { const int st = b / 1024, sb = b % 1024, swz = sb ^ (((sb >> 9) & 1) << 5); R = (st >> 1) * 16 + swz / 64; C = (st & 1) * 32 + (swz % 64) / 2; }
__host__ __device__ __forceinline__ int perm32(int rho) { const int n = rho >> 4, i = rho & 15; return 8 * (i >> 2) + 4 * n + (i & 3); }

struct Unit { int pm, pn; };
struct Gemm { const bf16_t* A; const bf16_t* Bt; int M, N, K, lda, ldb; };

struct StaticOrder {
    int nM, nN, nwg, G, c;
    __host__ __device__ void init(int M, int N, int G_, int c_) { nM = M / BM; nN = N / BM; nwg = nM * nN; G = G_; c = c_; }
    __host__ __device__ bool next(int i, Unit& u) const {
        const long L = (long)i * G + c; if (L >= nwg) return false;
        int wgid = (int)L; { const int q = nwg / NXCD, r = nwg % NXCD, xcd = wgid % NXCD, off = wgid / NXCD; wgid = (xcd < r ? xcd * (q + 1) : r * (q + 1) + (xcd - r) * q) + off; }
        const int nig = WGM * nN, gid = wgid / nig, fm = gid * WGM, gsz = (nM - fm) < WGM ? (nM - fm) : WGM;
        u.pm = fm + ((wgid % nig) % gsz); u.pn = (wgid % nig) / gsz; return true;
    }
    __device__ __forceinline__ void a_ready(const Unit&) const {}
    __device__ __forceinline__ void done(const Unit&) const {}
};

__device__ __forceinline__ unsigned cvt_pk_bf16(float lo, float hi) { unsigned r; asm volatile("v_cvt_pk_bf16_f32 %0, %1, %2" : "=v"(r) : "v"(lo), "v"(hi)); return r; }
__device__ __forceinline__ u32x4 pack8(const f32x4& v0, const f32x4& v1) { u32x4 w; w.x = cvt_pk_bf16(v0[0], v0[1]); w.y = cvt_pk_bf16(v0[2], v0[3]); w.z = cvt_pk_bf16(v1[0], v1[1]); w.w = cvt_pk_bf16(v1[2], v1[3]); return w; }
__device__ __forceinline__ void unpack8(const u32x4& w, f32x4& v0, f32x4& v1) { v0 = (f32x4){bflo(w.x), bfhi(w.x), bflo(w.y), bfhi(w.y)}; v1 = (f32x4){bflo(w.z), bfhi(w.z), bflo(w.w), bfhi(w.w)}; }

typedef int i32x4 __attribute__((ext_vector_type(4)));
template <bool I8> __device__ __forceinline__ f32x4 mma16(bf16x8 b, bf16x8 a, f32x4 c) {
    if constexpr (I8) return __builtin_bit_cast(f32x4, __builtin_amdgcn_mfma_i32_16x16x64_i8(__builtin_bit_cast(i32x4, b), __builtin_bit_cast(i32x4, a), __builtin_bit_cast(i32x4, c), 0, 0, 0));
    else return __builtin_amdgcn_mfma_f32_16x16x32_bf16(b, a, c, 0, 0, 0);
}
__device__ __forceinline__ f32x4 i2f4(const f32x4& a) { const i32x4 i = __builtin_bit_cast(i32x4, a); return (f32x4){(float)i[0], (float)i[1], (float)i[2], (float)i[3]}; }
__device__ __forceinline__ unsigned u8x4(const f32x4& v) { return (unsigned)(v[0] * 255.f + 0.5f) | ((unsigned)(v[1] * 255.f + 0.5f) << 8) | ((unsigned)(v[2] * 255.f + 0.5f) << 16) | ((unsigned)(v[3] * 255.f + 0.5f) << 24); }
__device__ __forceinline__ f32x4 u8tof(unsigned w) { return (f32x4){(float)(w & 255u), (float)((w >> 8) & 255u), (float)((w >> 16) & 255u), (float)(w >> 24)}; }
struct EpiPlain {
    static constexpr bool PERM = true, AFTER_DRAIN = false, SEG = false;
    bf16_t* O; int ldc;
    __device__ __forceinline__ void operator()(const f32x4 (&acc)[2][2][4][2], const Unit& u, int wr, int wc, int fr, int fq) const {
        const int row0 = u.pm * BM + wr * 64 + fr, col0 = u.pn * BM + wc * 32 + 8 * fq;
#pragma unroll
        for (int ai = 0; ai < 2; ++ai)
#pragma unroll
            for (int m = 0; m < 4; ++m) { bf16_t* rowp = O + (size_t)(row0 + ai * HALF + m * 16) * ldc + col0;
#pragma unroll
                for (int bj = 0; bj < 2; ++bj) *(u32x4*)(rowp + bj * HALF) = pack8(acc[ai][bj][m][0], acc[ai][bj][m][1]); }
    }
};
struct EpiPlain8 {
    static constexpr bool PERM = true, AFTER_DRAIN = false, SEG = false;
    bf16_t* O; int ldc; const float* sa; const float* sb;
    __device__ __forceinline__ void operator()(const f32x4 (&acc)[2][2][4][2], const Unit& u, int wr, int wc, int fr, int fq) const {
        const int row0 = u.pm * BM + wr * 64 + fr, col0 = u.pn * BM + wc * 32 + 8 * fq;
        f32x4 sbv[2][2];
#pragma unroll
        for (int bj = 0; bj < 2; ++bj) { sbv[bj][0] = *(const f32x4*)(sb + col0 + bj * HALF); sbv[bj][1] = *(const f32x4*)(sb + col0 + bj * HALF + 4); }
#pragma unroll
        for (int ai = 0; ai < 2; ++ai)
#pragma unroll
            for (int m = 0; m < 4; ++m) { const int row = row0 + ai * HALF + m * 16; bf16_t* rowp = O + (size_t)row * ldc + col0; const float sar = sa[row];
#pragma unroll
                for (int bj = 0; bj < 2; ++bj) *(u32x4*)(rowp + bj * HALF) = pack8(i2f4(acc[ai][bj][m][0]) * sbv[bj][0] * sar, i2f4(acc[ai][bj][m][1]) * sbv[bj][1] * sar); }
    }
};
struct EpiProj {
    static constexpr bool PERM = true, AFTER_DRAIN = false, SEG = false;
    bf16_t* PA; bf16_t* GT; const float* sa; const float* sb;
    __device__ __forceinline__ void operator()(const f32x4 (&acc)[2][2][4][2], const Unit& u, int wr, int wc, int fr, int fq) const {
        const int pn = u.pn; bf16_t* base; int ldc, colt; float sc = 1.f; bool sig = false;
        if (pn < 10) { base = PA; ldc = NPA; colt = pn * BM; if (pn < 2 || pn == 5 || pn == 8) sc = C2; if (pn == 9) sig = true; }
        else { base = GT; ldc = NGT; colt = (pn - 10) * BM; sig = true; }
        const int row0 = u.pm * BM + wr * 64 + fr, col0 = colt + wc * 32 + 8 * fq;
        f32x4 sbv[2][2];
#pragma unroll
        for (int bj = 0; bj < 2; ++bj) { const float* sp = sb + pn * BM + bj * HALF + wc * 32 + 8 * fq; sbv[bj][0] = *(const f32x4*)sp * sc; sbv[bj][1] = *(const f32x4*)(sp + 4) * sc; }
#pragma unroll
        for (int ai = 0; ai < 2; ++ai)
#pragma unroll
            for (int m = 0; m < 4; ++m) { const int row = row0 + ai * HALF + m * 16; bf16_t* rowp = base + (size_t)row * ldc + col0; const float sar = sa[row];
#pragma unroll
                for (int bj = 0; bj < 2; ++bj) { f32x4 v0 = i2f4(acc[ai][bj][m][0]) * sbv[bj][0] * sar, v1 = i2f4(acc[ai][bj][m][1]) * sbv[bj][1] * sar;
                    if (sig) {
#pragma unroll
                        for (int e = 0; e < 4; ++e) { v0[e] = fast_sigmoid(v0[e]); v1[e] = fast_sigmoid(v1[e]); } }
                    if (pn >= 10) { u32x2 w; w.x = u8x4(v0); w.y = u8x4(v1); *(u32x2*)((unsigned char*)GT + (size_t)row * NGT + col0 + bj * HALF) = w; }
                    else *(u32x4*)(rowp + bj * HALF) = pack8(v0, v1); } }
    }
};
struct EpiMerge1P {
    static constexpr bool PERM = true, AFTER_DRAIN = false, SEG = true;
    bf16_t* O; int ldc; const unsigned char* G8; int ldg; int seg1, seg2;
    __device__ __forceinline__ void rescale(f32x4 (&acc)[2][2][4][2], const Unit& u, int wr, int wc, int fr, int fq, int which) const {
        asm volatile("" ::: "memory");
        int row0 = u.pm * BM + wr * 64 + fr; const int col0 = u.pn * BM + wc * 32 + 8 * fq;
        asm volatile("" : "+v"(row0));
        const unsigned char* Ga = G8 + which * 1024 + col0;
#pragma unroll
        for (int ai = 0; ai < 2; ++ai)
#pragma unroll
          for (int mp = 0; mp < 2; ++mp) {
            u32x2 aw[2][2], bw[2][2];
#pragma unroll
            for (int mi = 0; mi < 2; ++mi) { const size_t r = (size_t)(row0 + ai * HALF + (2 * mp + mi) * 16);
#pragma unroll
                for (int bj = 0; bj < 2; ++bj) { aw[mi][bj] = *(const u32x2*)(Ga + r * ldg + bj * HALF); bw[mi][bj] = *(const u32x2*)(Ga + r * ldg + 1024 + bj * HALF); } }
#pragma unroll
            for (int mi = 0; mi < 2; ++mi)
#pragma unroll
                for (int bj = 0; bj < 2; ++bj) { const int m = 2 * mp + mi; f32x4 a0 = u8tof(aw[mi][bj].x), a1 = u8tof(aw[mi][bj].y), b0 = u8tof(bw[mi][bj].x), b1 = u8tof(bw[mi][bj].y);
#pragma unroll
                    for (int e = 0; e < 4; ++e) { const float na0 = which ? fmaxf(a0[e], 0.5f) : a0[e], na1 = which ? fmaxf(a1[e], 0.5f) : a1[e];
                        acc[ai][bj][m][0][e] *= na0 * __builtin_amdgcn_rcpf(fmaxf(b0[e], 0.5f)); acc[ai][bj][m][1][e] *= na1 * __builtin_amdgcn_rcpf(fmaxf(b1[e], 0.5f)); }
                    asm volatile("" : "+v"(acc[ai][bj][m][0]), "+v"(acc[ai][bj][m][1])); }
            asm volatile("" ::: "memory");
          }
    }
    __device__ __forceinline__ void operator()(const f32x4 (&acc)[2][2][4][2], const Unit& u, int wr, int wc, int fr, int fq) const {
        const int row0 = u.pm * BM + wr * 64 + fr, col0 = u.pn * BM + wc * 32 + 8 * fq;
#pragma unroll
        for (int ai = 0; ai < 2; ++ai) {
            u32x2 gw[4][2];
#pragma unroll
            for (int m = 0; m < 4; ++m) { const size_t r = (size_t)(row0 + ai * HALF + m * 16);
#pragma unroll
                for (int bj = 0; bj < 2; ++bj) gw[m][bj] = *(const u32x2*)(G8 + r * ldg + 2048 + col0 + bj * HALF); }
#pragma unroll
            for (int m = 0; m < 4; ++m) { const size_t r = (size_t)(row0 + ai * HALF + m * 16);
#pragma unroll
                for (int bj = 0; bj < 2; ++bj) { f32x4 g0 = u8tof(gw[m][bj].x), g1 = u8tof(gw[m][bj].y);
#pragma unroll
                    for (int e = 0; e < 4; ++e) { g0[e] = fmaxf(g0[e], 0.5f) * (1.f / 255.f); g1[e] = fmaxf(g1[e], 0.5f) * (1.f / 255.f); }
                    *(u32x4*)(O + r * ldc + col0 + bj * HALF) = pack8(acc[ai][bj][m][0] * g0, acc[ai][bj][m][1] * g1); } }
        }
    }
};
struct EpiSwiGLU {
    static constexpr bool PERM = true, AFTER_DRAIN = false, SEG = false;
    bf16_t* U; int ldc; const float* sa; const float* sb;
    __device__ __forceinline__ void operator()(const f32x4 (&acc)[2][2][4][2], const Unit& u, int wr, int wc, int fr, int fq) const {
        const int row0 = u.pm * BM + wr * 64 + fr, col0 = u.pn * HALF + wc * 32 + 8 * fq;
        f32x4 sbv[2][2];
#pragma unroll
        for (int bj = 0; bj < 2; ++bj) { const float* sp = sb + u.pn * BM + bj * HALF + wc * 32 + 8 * fq; sbv[bj][0] = *(const f32x4*)sp; sbv[bj][1] = *(const f32x4*)(sp + 4); }
#pragma unroll
        for (int ai = 0; ai < 2; ++ai)
#pragma unroll
            for (int m = 0; m < 4; ++m) { const int row = row0 + ai * HALF + m * 16; bf16_t* rowp = U + (size_t)row * ldc + col0; const float sar = sa[row];
                const f32x4 ga = i2f4(acc[ai][0][m][0]) * sbv[0][0] * sar, gb = i2f4(acc[ai][0][m][1]) * sbv[0][1] * sar;
                const f32x4 ua = i2f4(acc[ai][1][m][0]) * sbv[1][0] * sar, ub = i2f4(acc[ai][1][m][1]) * sbv[1][1] * sar;
                f32x4 v0, v1;
#pragma unroll
                for (int e = 0; e < 4; ++e) { v0[e] = ga[e] * fast_sigmoid(ga[e]) * ua[e]; v1[e] = gb[e] * fast_sigmoid(gb[e]) * ub[e]; }
                *(u32x4*)rowp = pack8(v0, v1); }
    }
};

template <class Epi, class Sched, bool ALIGN_EPI = false, bool SP2 = false, bool I8 = false>
__device__ __forceinline__ void gemm_phase(PG8_LAS unsigned char* lds, const Gemm g, const Sched& S, const Epi& E, int wave_in) {
    unsigned z_ = 0u; asm volatile("" : "+s"(z_));
    int tid_ = wave_in * 64 + (int)__builtin_amdgcn_mbcnt_hi(~0u, __builtin_amdgcn_mbcnt_lo(~0u, z_)); asm volatile("" : "+v"(tid_));
    const int tid = tid_, wid = __builtin_amdgcn_readfirstlane(tid >> 6), lane = tid & 63, wr = wid >> 2, wc = wid & 3, fr = lane & 15, fq = lane >> 4;
    const int K = g.K, nt = K / BK;
    unsigned voffA[2], voffB[2];
#pragma unroll
    for (int i = 0; i < 2; ++i) { int R, C; stage_rc(tid * 16 + i * 8192, R, C); const int Rb = Epi::PERM ? ((R & ~31) + perm32(R & 31)) : R;
        voffA[i] = (unsigned)(R * g.lda + C) * 2u; voffB[i] = (unsigned)(Rb * g.ldb + C) * 2u; }
    const size_t kstep = (size_t)(BK * 2);
    const size_t hstepA = (size_t)HALF * g.lda * 2, hstepB = (size_t)HALF * g.ldb * 2;
    const size_t tstepA = 2 * hstepA, tstepB = 2 * hstepB;
    const unsigned ldsw = (unsigned)wid * 1024u;
    const int aoff = lds_byte(wr * 64 + fr, fq * 8), boff = lds_byte(wc * 32 + fr, fq * 8);
#define PG8_SA(b, h) (((b) * 2 + (h)) * HTB)
#define PG8_SB(b, h) ((4 + (b) * 2 + (h)) * HTB)
#define PG8_STAGE(bufoff, gbase, voff) do { _Pragma("unroll") for (int _i = 0; _i < 2; ++_i) \
        __builtin_amdgcn_global_load_lds((const unsigned*)((const char*)(gbase) + (voff)[_i]), (PG8_LAS unsigned*)(lds + (bufoff) + ldsw + _i * 8192), 16, 0, 0); } while (0)
#define PG8_LDA(dst, b, h) do { _Pragma("unroll") for (int m = 0; m < 4; ++m) _Pragma("unroll") for (int k = 0; k < 2; ++k) dst[m][k] = *(const PG8_LAS bf16x8*)(lds + PG8_SA(b, h) + aoff + m * 2048 + k * 1024); } while (0)
#define PG8_LDB(dst, b, h) do { _Pragma("unroll") for (int n = 0; n < 2; ++n) _Pragma("unroll") for (int k = 0; k < 2; ++k) dst[n][k] = *(const PG8_LAS bf16x8*)(lds + PG8_SB(b, h) + boff + n * 2048 + k * 1024); } while (0)
#define PG8_MMA(ai, bj, At, Bt) do { __builtin_amdgcn_s_setprio(1); _Pragma("unroll") for (int m = 0; m < 4; ++m) _Pragma("unroll") for (int n = 0; n < 2; ++n) _Pragma("unroll") for (int k = 0; k < 2; ++k) \
        acc[ai][bj][m][n] = mma16<I8>(Bt[n][k], At[m][k], acc[ai][bj][m][n]); __builtin_amdgcn_s_setprio(0); } while (0)
#define PG8_WAIT_V(n) asm volatile("s_waitcnt vmcnt(" #n ")" ::: "memory")
#define PG8_WAIT_L(n) asm volatile("s_waitcnt lgkmcnt(" #n ")" ::: "memory")
#define PG8_BAR __builtin_amdgcn_s_barrier()
#define PG8_SCHED __builtin_amdgcn_sched_barrier(0)
    Unit cur, nxt; int ui = 0;
    if (!S.next(0, cur)) return;
    f32x4 acc[2][2][4][2];
#pragma unroll
    for (int a = 0; a < 2; ++a)
#pragma unroll
        for (int b = 0; b < 2; ++b)
#pragma unroll
            for (int m = 0; m < 4; ++m)
#pragma unroll
                for (int n = 0; n < 2; ++n) acc[a][b][m][n] = (f32x4){0.f, 0.f, 0.f, 0.f};
    bf16x8 At[4][2], B0[2][2], B1[2][2];
    const char* cA = (const char*)g.A + (size_t)cur.pm * tstepA; const char* cB = (const char*)g.Bt + (size_t)cur.pn * tstepB;
    S.a_ready(cur);
    if constexpr (SP2) {
        PG8_STAGE(PG8_SB(0, 0), cB, voffB); PG8_STAGE(PG8_SB(0, 1), cB + hstepB, voffB); PG8_STAGE(PG8_SA(0, 0), cA, voffA); PG8_STAGE(PG8_SA(0, 1), cA + hstepA, voffA);
        if (wr == 1) PG8_BAR;
        PG8_WAIT_V(2); PG8_BAR;
        PG8_STAGE(PG8_SB(1, 0), cB + kstep, voffB); PG8_STAGE(PG8_SA(1, 0), cA + kstep, voffA); PG8_STAGE(PG8_SB(1, 1), cB + hstepB + kstep, voffB);
        PG8_WAIT_V(6); PG8_BAR;
    } else {
        PG8_STAGE(PG8_SB(0, 0), cB, voffB); PG8_STAGE(PG8_SA(0, 0), cA, voffA); PG8_STAGE(PG8_SB(0, 1), cB + hstepB, voffB); PG8_STAGE(PG8_SA(0, 1), cA + hstepA, voffA);
        if (wr == 1) PG8_BAR;
        PG8_WAIT_V(4); PG8_BAR;
        PG8_STAGE(PG8_SB(1, 0), cB + kstep, voffB); PG8_STAGE(PG8_SA(1, 0), cA + kstep, voffA); PG8_STAGE(PG8_SB(1, 1), cB + hstepB + kstep, voffB);
        PG8_WAIT_V(6); PG8_BAR;
    }
    for (;;) {
        const bool has_next = S.next(ui + 1, nxt);
        const char* nA = has_next ? (const char*)g.A + (size_t)nxt.pm * tstepA : cA; const char* nB = has_next ? (const char*)g.Bt + (size_t)nxt.pn * tstepB : cB;
        for (int t = 0; t < nt; t += 2) {
            const bool last = (t == nt - 2);
            const char* a1 = cA + (size_t)(t + 1) * kstep;
            const char* a2 = last ? nA : cA + (size_t)(t + 2) * kstep; const char* b2 = last ? nB : cB + (size_t)(t + 2) * kstep;
            const char* a3 = a2 + kstep; const char* b3 = b2 + kstep;
            if (last && has_next) S.a_ready(nxt);
            if constexpr (Epi::SEG) { __builtin_amdgcn_sched_barrier(0); if (t == E.seg1 || t == E.seg2) E.rescale(acc, cur, wr, wc, fr, fq, t == E.seg1 ? 0 : 1); __builtin_amdgcn_sched_barrier(0); }
            if constexpr (SP2) {
            PG8_LDB(B0, 0, 0); PG8_LDB(B1, 0, 1); PG8_SCHED; PG8_LDA(At, 0, 0); PG8_STAGE(PG8_SA(1, 1), a1 + hstepA, voffA);
            PG8_WAIT_V(8); PG8_WAIT_L(0); PG8_BAR; PG8_MMA(0, 0, At, B0); PG8_MMA(0, 1, At, B1); PG8_BAR; PG8_SCHED;
            PG8_LDA(At, 0, 1); PG8_STAGE(PG8_SB(0, 0), b2, voffB); PG8_STAGE(PG8_SB(0, 1), b2 + hstepB, voffB); PG8_STAGE(PG8_SA(0, 0), a2, voffA);
            PG8_WAIT_V(8); PG8_WAIT_L(0); PG8_BAR; PG8_MMA(1, 0, At, B0); PG8_MMA(1, 1, At, B1); PG8_BAR; PG8_SCHED;
            PG8_LDB(B0, 1, 0); PG8_LDB(B1, 1, 1); PG8_SCHED; PG8_LDA(At, 1, 0); PG8_STAGE(PG8_SA(0, 1), a2 + hstepA, voffA);
            PG8_WAIT_V(8); PG8_WAIT_L(0); PG8_BAR; PG8_MMA(0, 0, At, B0); PG8_MMA(0, 1, At, B1); PG8_BAR; PG8_SCHED;
            PG8_LDA(At, 1, 1); PG8_STAGE(PG8_SB(1, 0), b3, voffB); PG8_STAGE(PG8_SB(1, 1), b3 + hstepB, voffB); PG8_STAGE(PG8_SA(1, 0), a3, voffA);
            PG8_WAIT_V(8); PG8_WAIT_L(0); PG8_BAR; PG8_MMA(1, 0, At, B0); PG8_MMA(1, 1, At, B1); PG8_BAR; PG8_SCHED;
            } else {
            PG8_LDB(B0, 0, 0); PG8_SCHED; PG8_LDA(At, 0, 0); PG8_STAGE(PG8_SA(1, 1), a1 + hstepA, voffA);
            PG8_WAIT_L(8); PG8_BAR; PG8_WAIT_L(0); PG8_MMA(0, 0, At, B0); PG8_BAR; PG8_SCHED;
            PG8_LDB(B1, 0, 1); PG8_STAGE(PG8_SB(0, 0), b2, voffB);
            PG8_BAR; PG8_WAIT_L(0); PG8_MMA(0, 1, At, B1); PG8_BAR;
            PG8_LDA(At, 0, 1); PG8_STAGE(PG8_SA(0, 0), a2, voffA);
            PG8_BAR; PG8_WAIT_L(0); PG8_MMA(1, 0, At, B0); PG8_BAR; PG8_SCHED;
            PG8_STAGE(PG8_SB(0, 1), b2 + hstepB, voffB);
            PG8_WAIT_V(6); PG8_BAR; PG8_MMA(1, 1, At, B1); PG8_BAR;
            PG8_LDB(B0, 1, 0); PG8_SCHED; PG8_LDA(At, 1, 0); PG8_STAGE(PG8_SA(0, 1), a2 + hstepA, voffA);
            PG8_WAIT_L(8); PG8_BAR; PG8_WAIT_L(0); PG8_MMA(0, 0, At, B0); PG8_BAR; PG8_SCHED;
            PG8_LDB(B1, 1, 1); PG8_STAGE(PG8_SB(1, 0), b3, voffB);
            PG8_BAR; PG8_WAIT_L(0); PG8_MMA(0, 1, At, B1); PG8_BAR;
            PG8_LDA(At, 1, 1); PG8_STAGE(PG8_SA(1, 0), a3, voffA);
            PG8_BAR; PG8_WAIT_L(0); PG8_MMA(1, 0, At, B0); PG8_BAR; PG8_SCHED;
            PG8_STAGE(PG8_SB(1, 1), b3 + hstepB, voffB);
            PG8_WAIT_V(6); PG8_BAR; PG8_MMA(1, 1, At, B1); PG8_BAR;
            }
        }
        if constexpr (ALIGN_EPI) { if (wr == 0) PG8_BAR; }
        if constexpr (!Epi::AFTER_DRAIN) { E(acc, cur, wr, wc, fr, fq); S.done(cur); }
        if (!has_next) break;
#pragma unroll
        for (int a = 0; a < 2; ++a)
#pragma unroll
            for (int b = 0; b < 2; ++b)
#pragma unroll
                for (int m = 0; m < 4; ++m)
#pragma unroll
                    for (int n = 0; n < 2; ++n) acc[a][b][m][n] = (f32x4){0.f, 0.f, 0.f, 0.f};
        cur = nxt; cA = nA; cB = nB; ++ui;
        if constexpr (ALIGN_EPI) { if (wr == 1) PG8_BAR; }
    }
    PG8_WAIT_V(0);
    if constexpr (!ALIGN_EPI) { if (wr == 0) PG8_BAR; }
    PG8_BAR;
    if constexpr (Epi::AFTER_DRAIN) { E.fused(acc, cur, wr, wc, fr, fq, lds, wid, lane); S.done(cur); }
#undef PG8_SA
#undef PG8_SB
#undef PG8_STAGE
#undef PG8_LDA
#undef PG8_LDB
#undef PG8_MMA
#undef PG8_WAIT_V
#undef PG8_WAIT_L
#undef PG8_BAR
#undef PG8_SCHED
}

}

typedef GAS unsigned gu32;
#define RLX_AGENT __ATOMIC_RELAXED, __HIP_MEMORY_SCOPE_AGENT
#define XB_TMO      128
#define XB_XCNT(j)  (256  + 64 * (j))
#define XB_XSUB(j)  (1280 + 64 * (j))
#define XB_XGEN(j)  (2304 + 64 * (j))
#define XB_TOP      3328
#define XB_TOPGEN   3392
#define XCD_BAR_WORDS 3456
#define XB_SPIN_CAP (1u << 18)

__device__ __forceinline__ unsigned xb_ld(unsigned* p)              { return __hip_atomic_load(p, __ATOMIC_RELAXED, __HIP_MEMORY_SCOPE_AGENT); }
__device__ __forceinline__ unsigned xb_add(unsigned* p, unsigned v) { return __hip_atomic_fetch_add(p, v, __ATOMIC_RELAXED, __HIP_MEMORY_SCOPE_AGENT); }
__device__ __forceinline__ unsigned xb_xcc_id() { return (unsigned)__builtin_amdgcn_s_getreg((3 << 11) | 20) & 0xFu; }
#define XB_SPIN(cond, bar) do { unsigned _sp = 0; while (cond) { __builtin_amdgcn_s_sleep(1); \
    if ((++_sp & 255u) == 0u) { if (xb_ld(&(bar)[XB_TMO])) break; if (_sp > XB_SPIN_CAP) { atomicAdd(&(bar)[XB_TMO], 1u); break; } } } } while (0)

struct XcdBarrier {
    unsigned* bar; unsigned x;
    volatile LAS unsigned* st;
};

__device__ __forceinline__ XcdBarrier xcd_barrier_post(unsigned* bar, volatile LAS unsigned* st) {
    XcdBarrier b; b.bar = bar; b.x = xb_xcc_id(); b.st = st;
    if (threadIdx.x == 0) (void)xb_add(&bar[XB_XCNT(b.x)], 1u);
    return b;
}
__device__ __forceinline__ void xcd_barrier_complete(unsigned* bar, unsigned x, unsigned& nloc, unsigned& nx) {
    const unsigned G = gridDim.x * gridDim.y * gridDim.z;
    unsigned sum, cnt, mine, sp = 0u;
    for (;;) {
        sum = 0u; cnt = 0u; mine = 0u;
#pragma unroll
        for (unsigned j = 0; j < 16; ++j) { const unsigned c = xb_ld(&bar[XB_XCNT(j)]); sum += c; cnt += (c > 0u) ? 1u : 0u; mine = (j == x) ? c : mine; }
        if (sum == G) break;
        __builtin_amdgcn_s_sleep(1);
        if ((++sp & 255u) == 0u) { if (xb_ld(&bar[XB_TMO])) break; if (sp > XB_SPIN_CAP) { atomicAdd(&bar[XB_TMO], 1u); break; } }
    }
    nloc = mine > 0u ? mine : 1u; nx = cnt > 0u ? cnt : 1u;
}

__device__ __forceinline__ void xcd_barrier(const XcdBarrier& b) {
    asm volatile("s_waitcnt vmcnt(0)" ::: "memory");
    __syncthreads();
    if (threadIdx.x == 0) {
        unsigned* bar = b.bar;
        __builtin_amdgcn_s_waitcnt(0);
        unsigned nloc = b.st[0], nx = b.st[1];
        if (nloc == 0u) { xcd_barrier_complete(bar, b.x, nloc, nx); b.st[0] = nloc; b.st[1] = nx; }
        const unsigned old = xb_add(&bar[XB_XSUB(b.x)], 1u);
        const unsigned gen = old / nloc;
        if (old + 1u == (gen + 1u) * nloc) {
            __builtin_amdgcn_fence(__ATOMIC_RELEASE, "agent");
            asm volatile("s_waitcnt vmcnt(0)" ::: "memory");
            const unsigned og = xb_add(&bar[XB_TOP], 1u);
            const unsigned tg = og / nx;
            if (og + 1u == (tg + 1u) * nx) xb_add(&bar[XB_TOPGEN], 1u);
            else XB_SPIN(xb_ld(&bar[XB_TOPGEN]) == tg, bar);
            __builtin_amdgcn_fence(__ATOMIC_ACQUIRE, "agent");
            xb_add(&bar[XB_XGEN(b.x)], 1u);
            asm volatile("s_waitcnt vmcnt(0)" ::: "memory");
        } else {
            XB_SPIN(xb_ld(&bar[XB_XGEN(b.x)]) == gen, bar);
            __builtin_amdgcn_fence(__ATOMIC_ACQUIRE, "agent");
            asm volatile("s_waitcnt vmcnt(0)" ::: "memory");
        }
    }
    __syncthreads();
}

#define LDS_WAIT() asm volatile("s_waitcnt lgkmcnt(0)" ::: "memory")
#define VM_WAIT() asm volatile("s_waitcnt vmcnt(0)" ::: "memory")
#define MFMA32 __builtin_amdgcn_mfma_f32_32x32x16_bf16
__device__ __forceinline__ float wave_sum(float v) {
#pragma unroll
    for (int o = 1; o < 64; o <<= 1) v += __shfl_xor(v, o);
    return v;
}
__device__ __forceinline__ float wave_max(float v) {
#pragma unroll
    for (int o = 1; o < 64; o <<= 1) v = fmaxf(v, __shfl_xor(v, o));
    return v;
}
__device__ __forceinline__ unsigned q8x4(const f32x4& y, float inv) {
    int a = __float2int_rn(y.x * inv), b = __float2int_rn(y.y * inv), c = __float2int_rn(y.z * inv), d = __float2int_rn(y.w * inv);
    a = a < -127 ? -127 : (a > 127 ? 127 : a); b = b < -127 ? -127 : (b > 127 ? 127 : b); c = c < -127 ? -127 : (c > 127 ? 127 : c); d = d < -127 ? -127 : (d > 127 ? 127 : d);
    return (unsigned)(a & 255) | ((unsigned)(b & 255) << 8) | ((unsigned)(c & 255) << 16) | ((unsigned)(d & 255) << 24);
}
__device__ __forceinline__ float amax4(const f32x4& y) { return fmaxf(fmaxf(fabsf(y.x), fabsf(y.y)), fmaxf(fabsf(y.z), fabsf(y.w))); }
__device__ __forceinline__ float swap_max(float m) { auto rr = __builtin_amdgcn_permlane32_swap(__float_as_uint(m), __float_as_uint(m), false, false); return fmaxf(__uint_as_float(rr[0]), __uint_as_float(rr[1])); }
__device__ __forceinline__ float swap_sum(float m) { auto rr = __builtin_amdgcn_permlane32_swap(__float_as_uint(m), __float_as_uint(m), false, false); return __uint_as_float(rr[0]) + __uint_as_float(rr[1]); }
__device__ __forceinline__ int crow(int r, int hi) { return (r & 3) + 8 * (r >> 2) + 4 * hi; }
__device__ __forceinline__ int t5_bucket(int dist) {
    if (dist < 16) return dist;
    int b = 16;
    b += (dist >= 19); b += (dist >= 21); b += (dist >= 24); b += (dist >= 27); b += (dist >= 31); b += (dist >= 35); b += (dist >= 40); b += (dist >= 46);
    b += (dist >= 52); b += (dist >= 59); b += (dist >= 67); b += (dist >= 77); b += (dist >= 87); b += (dist >= 99); b += (dist >= 113);
    return b;
}
__device__ __forceinline__ float gelu_tanh(float x) { const float u = 0.7978845608028654f * (x + 0.044715f * x * x * x); return x * __builtin_amdgcn_rcpf(1.0f + __builtin_amdgcn_exp2f(-2.0f * LOG2E * u)); }

__device__ __forceinline__ void tr_item(const float* W, int ldw, bf16* WT, int ldt, int kdst, LAS float* scr, int k0, int n0, int sc, int lane, unsigned* cmax, const float* kgain) {
    float tv[32];
    const float* wp = W + (size_t)(k0 + (lane >> 5)) * ldw + (sc >= 0 ? sc : 0);
#pragma unroll
    for (int i = 0; i < 32; ++i) tv[i] = wp[(size_t)(2 * i) * ldw];
    if (kgain) {
#pragma unroll
        for (int i = 0; i < 32; ++i) tv[i] *= kgain[k0 + 2 * i + (lane >> 5)]; }
#pragma unroll
    for (int i = 0; i < 32; ++i) { const int kk = 2 * i + (lane >> 5); scr[kk * 33 + (lane & 31)] = sc >= 0 ? tv[i] : 0.f; }
    LDS_WAIT(); asm volatile("" ::: "memory");
    const int c = lane & 7;
#pragma unroll
    for (int j = 0; j < 4; ++j) { const int n = (lane >> 3) + 8 * j; const LAS float* s = scr + (8 * c) * 33 + n;
        u32x4 o; o.x = pk2(s[0 * 33], s[1 * 33]); o.y = pk2(s[2 * 33], s[3 * 33]); o.z = pk2(s[4 * 33], s[5 * 33]); o.w = pk2(s[6 * 33], s[7 * 33]);
        *(u32x4*)(WT + (size_t)(n0 + n) * ldt + kdst + k0 + 8 * c) = o;
        if (cmax) { float mx = fmaxf(fmaxf(fmaxf(bflo(o.x), bfhi(o.x)), fmaxf(bflo(o.y), bfhi(o.y))), fmaxf(fmaxf(bflo(o.z), bfhi(o.z)), fmaxf(bflo(o.w), bfhi(o.w))));
            float mn = fminf(fminf(fminf(bflo(o.x), bfhi(o.x)), fminf(bflo(o.y), bfhi(o.y))), fminf(fminf(bflo(o.z), bfhi(o.z)), fminf(bflo(o.w), bfhi(o.w))));
            mx = fmaxf(mx, -mn);
            mx = fmaxf(mx, __shfl_xor(mx, 1)); mx = fmaxf(mx, __shfl_xor(mx, 2)); mx = fmaxf(mx, __shfl_xor(mx, 4));
            if (c == 0) atomicMax(cmax + n0 + n, __float_as_uint(mx)); } }
    LDS_WAIT(); asm volatile("" ::: "memory");
}
__device__ __forceinline__ void tr_one(int kind, const float* W, const float* W2, int ldw, int Ndst, bf16* WT, int ldt, int kdst, LAS float* scr, int it, int lane, unsigned* cmax, const float* kgain) {
    const int nblk = Ndst / 32;
    const int kb = it / nblk, nb = it % nblk, n0 = 32 * nb, n = n0 + (lane & 31);
    const float* src = W; int sc = n;
    if (kind == 1) { sc = n < 1280 ? n : (n < 2304 ? n + 24 : (n < 2328 ? n - 1024 : (n < 2560 ? -1 : n - 232))); }
    else if (kind == 2) { const int pn = n >> 8, w = n & 255; if (w < 128) sc = 128 * pn + w; else { sc = 128 * pn + w - 128; src = W2; } }
    tr_item(src, ldw, WT, ldt, kdst, scr, 64 * kb, n0, sc, lane, cmax, kgain);
}

template <int NR>
__device__ __forceinline__ void rms_rows_bf16(const float* const (&xrow)[NR], const float* g, bf16* const (&orow)[NR], int lane) {
    f32x4 v[NR][4];
#pragma unroll
    for (int r = 0; r < NR; ++r) { const f32x4* xr = (const f32x4*)xrow[r] + lane;
#pragma unroll
        for (int j = 0; j < 4; ++j) v[r][j] = xr[64 * j]; }
    const f32x4* gr = (const f32x4*)g + lane; f32x4 gv[4];
#pragma unroll
    for (int j = 0; j < 4; ++j) gv[j] = g ? gr[64 * j] : (f32x4){1.f, 1.f, 1.f, 1.f};
#pragma unroll
    for (int r = 0; r < NR; ++r) { float s = 0.f;
#pragma unroll
        for (int j = 0; j < 4; ++j) s += (v[r][j].x * v[r][j].x + v[r][j].y * v[r][j].y) + (v[r][j].z * v[r][j].z + v[r][j].w * v[r][j].w);
        const float rs = rsqrtf(wave_sum(s) * (1.f / DM) + RMS_EPS);
        u32x2* o8 = (u32x2*)orow[r] + lane;
#pragma unroll
        for (int j = 0; j < 4; ++j) { u32x2 w; w.x = pk2(v[r][j].x * rs * gv[j].x, v[r][j].y * rs * gv[j].y); w.y = pk2(v[r][j].z * rs * gv[j].z, v[r][j].w * rs * gv[j].w); o8[64 * j] = w; } }
}
template <int NR>
__device__ __forceinline__ void rms_rows_i8(const float* const (&xrow)[NR], const float* g, unsigned char* const (&orow)[NR], float* const (&sap)[NR], int lane) {
    f32x4 v[NR][4];
#pragma unroll
    for (int r = 0; r < NR; ++r) { const f32x4* xr = (const f32x4*)xrow[r] + lane;
#pragma unroll
        for (int j = 0; j < 4; ++j) v[r][j] = xr[64 * j]; }
    const f32x4* gr = (const f32x4*)g + lane; f32x4 gv[4];
#pragma unroll
    for (int j = 0; j < 4; ++j) gv[j] = gr[64 * j];
#pragma unroll
    for (int r = 0; r < NR; ++r) { float s = 0.f;
#pragma unroll
        for (int j = 0; j < 4; ++j) s += (v[r][j].x * v[r][j].x + v[r][j].y * v[r][j].y) + (v[r][j].z * v[r][j].z + v[r][j].w * v[r][j].w);
        const float rs = rsqrtf(wave_sum(s) * (1.f / DM) + RMS_EPS);
        float am = 0.f;
#pragma unroll
        for (int j = 0; j < 4; ++j) { v[r][j] = v[r][j] * rs * gv[j]; am = fmaxf(am, amax4(v[r][j])); }
        am = wave_max(am); const float inv = am > 0.f ? 127.f / am : 0.f;
        unsigned* o4 = (unsigned*)orow[r] + lane;
#pragma unroll
        for (int j = 0; j < 4; ++j) o4[64 * j] = q8x4(v[r][j], inv);
        if (lane == 0) *sap[r] = am > 0.f ? am * (1.f / 127.f) : 1.f; }
}
template <int NR, bool XIN_F32, bool XOUT_F32>
__device__ __forceinline__ void norm_res_norm(const bf16* const (&srow)[NR], const float* gA, const void* const (&xin)[NR], void* const (&xout)[NR], const float* gB, unsigned char* const (&hout)[NR], float* const (&sap)[NR], bool has_h, int lane) {
    u32x2 sw[NR][4]; f32x4 xv[NR][4];
#pragma unroll
    for (int r = 0; r < NR; ++r) { const u32x2* sr = (const u32x2*)srow[r] + lane;
#pragma unroll
        for (int j = 0; j < 4; ++j) { sw[r][j] = sr[64 * j];
            if constexpr (XIN_F32) xv[r][j] = ((const f32x4*)xin[r] + lane)[64 * j];
            else { const u32x2 w = ((const u32x2*)xin[r] + lane)[64 * j]; xv[r][j] = (f32x4){bflo(w.x), bfhi(w.x), bflo(w.y), bfhi(w.y)}; } } }
    const f32x4* ga = (const f32x4*)gA + lane; f32x4 gav[4];
#pragma unroll
    for (int j = 0; j < 4; ++j) gav[j] = ga[64 * j];
#pragma unroll
    for (int r = 0; r < NR; ++r) { f32x4 v[4]; float s = 0.f;
#pragma unroll
        for (int j = 0; j < 4; ++j) { const u32x2 w = sw[r][j]; v[j] = (f32x4){bflo(w.x), bfhi(w.x), bflo(w.y), bfhi(w.y)}; s += (v[j].x * v[j].x + v[j].y * v[j].y) + (v[j].z * v[j].z + v[j].w * v[j].w); }
        const float rA = rsqrtf(wave_sum(s) * (1.f / DM) + RMS_EPS);
        float s2 = 0.f;
#pragma unroll
        for (int j = 0; j < 4; ++j) { v[j] = xv[r][j] + v[j] * rA * gav[j];
            if constexpr (XOUT_F32) ((f32x4*)xout[r] + lane)[64 * j] = v[j];
            else { u32x2 w; w.x = pk2(v[j].x, v[j].y); w.y = pk2(v[j].z, v[j].w); ((u32x2*)xout[r] + lane)[64 * j] = w; }
            s2 += (v[j].x * v[j].x + v[j].y * v[j].y) + (v[j].z * v[j].z + v[j].w * v[j].w); }
        if (has_h) {
            const float rB = rsqrtf(wave_sum(s2) * (1.f / DM) + RMS_EPS);
            const f32x4* gb = (const f32x4*)gB + lane; unsigned* o4 = (unsigned*)hout[r] + lane; float am = 0.f;
#pragma unroll
            for (int j = 0; j < 4; ++j) { v[j] = v[j] * rB * gb[64 * j]; am = fmaxf(am, amax4(v[j])); }
            am = wave_max(am); const float inv = am > 0.f ? 127.f / am : 0.f;
#pragma unroll
            for (int j = 0; j < 4; ++j) o4[64 * j] = q8x4(v[j], inv);
            if (lane == 0) *sap[r] = am > 0.f ? am * (1.f / 127.f) : 1.f;
        } }
}

__device__ __forceinline__ void quant_row_2816(unsigned char* rowp, float inv, int lane) {
    const u32x2* src = (const u32x2*)(rowp + lane * 88); u32x2 w[11];
#pragma unroll
    for (int i = 0; i < 11; ++i) w[i] = src[i];
    asm volatile("s_waitcnt vmcnt(0)" ::: "memory");
    unsigned* dst = (unsigned*)(rowp + lane * 44);
#pragma unroll
    for (int i = 0; i < 11; ++i) dst[i] = q8x4((f32x4){bflo(w[i].x), bfhi(w[i].x), bflo(w[i].y), bfhi(w[i].y)}, inv);
}
__device__ __forceinline__ void cmp_glds(const void* gsrc, unsigned lds_dst) { unsigned keep;
    asm volatile("s_mov_b32 %0, m0\n\ts_mov_b32 m0, %2\n\ts_nop 0\n\tglobal_load_lds_dwordx4 %1, off\n\ts_mov_b32 m0, %0" : "=&s"(keep) : "v"(gsrc), "s"(lds_dst) : "memory"); }
__device__ __forceinline__ void compress_unit(int u, LAS unsigned char* lds, const bf16* PA, const unsigned char* wl, bf16* KC, bf16* VC, int tid) {
    const int lane = tid & 63, wid = __builtin_amdgcn_readfirstlane(tid >> 6), r32 = lane & 31, hi = lane >> 5;
    const int kv = u & 1, g = (u >> 1) & 1, b = u >> 2;
    const bf16* w1t = (const bf16*)(wl + (kv ? WL_W1V : WL_W1K));
    const bf16* w2t = (const bf16*)(wl + (kv ? WL_W2V : WL_W2K));
    const float* posb = (const float*)(wl + (kv ? WL_POSV : WL_POSK));
    const bf16* Asrc = PA + (size_t)b * SEQ * NPA + (kv ? PA_VC : PA_KC) + g * 64;
    bf16* Out = (kv ? VC : KC) + (size_t)((b * 2 + g) * 128) * 64;
    LAS bf16* H1 = (LAS bf16*)(lds + 98304);
    const bf16* asrc[2]; const bf16* wsrc[2];
#pragma unroll
    for (int i = 0; i < 2; ++i) { const int row = 16 * wid + 8 * i + (lane >> 3), ch = (lane & 7) ^ ((row >> 1) & 7);
        asrc[i] = Asrc + (size_t)(16 * row) * NPA + ch * 8; wsrc[i] = w1t + (size_t)row * 2048 + ch * 8; }
    const int arow_tok0[2] = {16 * (16 * wid + (lane >> 3)), 16 * (16 * wid + 8 + (lane >> 3))};
    const unsigned ldsb = (unsigned)(uintptr_t)lds;
#define CMP_ISSUE(jj) do { const int jj_ = (jj); const unsigned sb_ = (unsigned)__builtin_amdgcn_readfirstlane((int)(ldsb + (jj_ % 3) * 32768 + wid * 2048)); \
        _Pragma("unroll") for (int i = 0; i < 2; ++i) { int tk = arow_tok0[i] + jj_; const int over = tk - (SEQ - 1); \
            cmp_glds(asrc[i] + (size_t)(over > 0 ? jj_ - over : jj_) * NPA, sb_ + i * 1024); cmp_glds(wsrc[i] + jj_ * 64, sb_ + 16384 + i * 1024); } } while (0)
    CMP_ISSUE(0); CMP_ISSUE(1);
    const int ct = wid & 3, nh = wid >> 2;
    f32x16 acc0 = {}, acc1 = {};
    const int ksw = (r32 >> 1) & 7;
#pragma unroll 1
    for (int jj = 0; jj < 32; ++jj) {
        if (jj + 1 < 32) { asm volatile("s_waitcnt vmcnt(4)" ::: "memory"); } else { asm volatile("s_waitcnt vmcnt(0)" ::: "memory"); }
        __builtin_amdgcn_s_barrier(); asm volatile("" ::: "memory");
        if (jj + 2 < 32) CMP_ISSUE(jj + 2);
        const LAS unsigned char* sa_ = lds + (jj % 3) * 32768 + (32 * ct + r32) * 128;
        const LAS unsigned char* sw_ = lds + (jj % 3) * 32768 + 16384 + (64 * nh + r32) * 128;
#pragma unroll
        for (int ks = 0; ks < 4; ++ks) { const int ko = ((2 * ks + hi) ^ ksw) * 16;
            const bf16x8 bfr = *(const LAS bf16x8*)(sa_ + ko), af0 = *(const LAS bf16x8*)(sw_ + ko), af1 = *(const LAS bf16x8*)(sw_ + 4096 + ko);
            acc0 = MFMA32(af0, bfr, acc0, 0, 0, 0); acc1 = MFMA32(af1, bfr, acc1, 0, 0, 0); }
    }
#undef CMP_ISSUE
#pragma unroll
    for (int t = 0; t < 2; ++t)
#pragma unroll
        for (int k4 = 0; k4 < 4; ++k4) { const int n0 = 64 * nh + 32 * t + 8 * k4 + 4 * hi; const f32x4 pb = *(const f32x4*)(posb + n0);
            const f32x16& a = t ? acc1 : acc0;
            u32x2 w; w.x = pk2(gelu_tanh(a[4 * k4 + 0] + pb.x), gelu_tanh(a[4 * k4 + 1] + pb.y)); w.y = pk2(gelu_tanh(a[4 * k4 + 2] + pb.z), gelu_tanh(a[4 * k4 + 3] + pb.w));
            *(LAS u32x2*)(H1 + (32 * ct + r32) * 136 + n0) = w; }
    __syncthreads();
    {
        const int dt = wid & 1, c4 = wid >> 1;
        f32x16 a2 = {};
#pragma unroll
        for (int ks = 0; ks < 8; ++ks) {
            const bf16x8 af = *(const bf16x8*)(w2t + (size_t)(32 * dt + r32) * 128 + 16 * ks + 8 * hi);
            const bf16x8 bfr = *(const LAS bf16x8*)(H1 + (32 * c4 + r32) * 136 + 16 * ks + 8 * hi);
            a2 = MFMA32(af, bfr, a2, 0, 0, 0);
        }
#pragma unroll
        for (int k4 = 0; k4 < 4; ++k4) { u32x2 w; w.x = pk2(a2[4 * k4 + 0], a2[4 * k4 + 1]); w.y = pk2(a2[4 * k4 + 2], a2[4 * k4 + 3]);
            *(u32x2*)(Out + (size_t)(32 * c4 + r32) * 64 + 32 * dt + 8 * k4 + 4 * hi) = w; }
    }
    __syncthreads();
}
__device__ __forceinline__ void kmean_unit(int b, int n, LAS unsigned char* lds, const bf16* PA, float* KMEAN, int tid) {
    const int chunk = tid & 31, tg = tid >> 5;
    const bf16* src = PA + ((size_t)b * SEQ + 256 * n + 16 * tg) * NPA + PA_KM + 8 * chunk;
    f32x4 s0 = {0.f, 0.f, 0.f, 0.f}, s1 = {0.f, 0.f, 0.f, 0.f};
#pragma unroll 4
    for (int t = 0; t < 16; ++t) { const u32x4 w = *(const u32x4*)(src + (size_t)t * NPA); f32x4 a, c; pg8::unpack8(w, a, c); s0 += a; s1 += c; }
    LAS float* red = (LAS float*)lds;
    *(LAS f32x4*)(red + tg * 256 + 8 * chunk) = s0; *(LAS f32x4*)(red + tg * 256 + 8 * chunk + 4) = s1;
    __syncthreads();
    if (tid < 256) { float s = 0.f;
#pragma unroll
        for (int t = 0; t < 16; ++t) s += red[t * 256 + tid];
        KMEAN[((size_t)(b * 4 + (tid >> 6)) * 8 + n) * 64 + (tid & 63)] = s * (1.f / 256.f); }
    __syncthreads();
}

#ifndef PROBE_DMA
#define PROBE_DMA 0
#endif
__device__ __forceinline__ void glds16(const void* gsrc, unsigned lds_dst) { unsigned keep;
    asm volatile("s_mov_b32 %0, m0\n\ts_mov_b32 m0, %2\n\ts_nop 0\n\tglobal_load_lds_dwordx4 %1, off\n\ts_mov_b32 m0, %0" : "=&s"(keep) : "v"(gsrc), "s"(lds_dst) : "memory"); }
__device__ __forceinline__ void stage_kv(LAS unsigned char* buf, const bf16* kptr, const bf16* vptr, int pitch, int wid, int lane) {
    const int kkey = 8 * wid + (lane >> 3);
    const bf16* ks = kptr + (size_t)kkey * pitch + (((lane & 7) ^ ((kkey >> 1) & 7)) * 8);
    const bf16* vs = vptr + (size_t)(16 * (wid & 3) + (lane >> 2)) * pitch + (wid >> 2) * 32 + (lane & 3) * 8;
    const unsigned dst = (unsigned)__builtin_amdgcn_readfirstlane((int)(unsigned)(uintptr_t)buf + wid * 1024);
    glds16(ks, dst); glds16(vs, dst + 8192u);
    if (PROBE_DMA) { glds16(ks, dst); glds16(vs, dst + 8192u); }
}
typedef __bf16 bf16x2_t __attribute__((ext_vector_type(2)));
__device__ __forceinline__ unsigned cvtpk_s(float lo, float hi) { f32x2 v = {lo, hi}; bf16x2_t b = __builtin_convertvector(v, bf16x2_t); return __builtin_bit_cast(unsigned, b); }
__device__ __forceinline__ bf16x8 pack_p(const f32x16& p, int s) {
    u32x4 w; w.x = cvtpk_s(p[8 * s + 0], p[8 * s + 1]); w.y = cvtpk_s(p[8 * s + 2], p[8 * s + 3]); w.z = cvtpk_s(p[8 * s + 4], p[8 * s + 5]); w.w = cvtpk_s(p[8 * s + 6], p[8 * s + 7]);
    return __builtin_bit_cast(bf16x8, w);
}
__device__ __forceinline__ bf16x8 vfrag(const LAS unsigned char* p) {
    const s16x4 lo = __builtin_bit_cast(s16x4, __builtin_amdgcn_ds_read_tr16_b64_v4i16((LAS s16x4*)p));
    const s16x4 hi = __builtin_bit_cast(s16x4, __builtin_amdgcn_ds_read_tr16_b64_v4i16((LAS s16x4*)(p + 512)));
    return (bf16x8){lo[0], lo[1], lo[2], lo[3], hi[0], hi[1], hi[2], hi[3]};
}
#define RING_WAIT_BAR(n) do { asm volatile("s_waitcnt vmcnt(" #n ")" ::: "memory"); __builtin_amdgcn_s_barrier(); asm volatile("" ::: "memory"); } while (0)
#define RING_STEP_SYNC(j, ns) do { if ((j) + 1 < (ns)) { if (PROBE_DMA) RING_WAIT_BAR(4); else RING_WAIT_BAR(2); } else RING_WAIT_BAR(0); } while (0)
__device__ __forceinline__ float max3f(float a, float b, float c) { float r; asm("v_max3_f32 %0, %1, %2, %3" : "=v"(r) : "v"(a), "v"(b), "v"(c)); return r; }
#define LOADED4(q) asm volatile("" :: "v"((q)[0]), "v"((q)[1]), "v"((q)[2]), "v"((q)[3]))
#define LOADED1(x) asm volatile("" :: "v"(x))
struct WState { f32x16 o0, o1; float m, l; int first; };
typedef unsigned u32x8 __attribute__((ext_vector_type(8)));
struct OtPk { u32x8 a, b; };
__device__ __forceinline__ void ot_set(OtPk& t, const f32x16& o0, const f32x16& o1, float sc) {
#pragma unroll
    for (int i = 0; i < 8; ++i) { t.a[i] = cvtpk_s(o0[2 * i] * sc, o0[2 * i + 1] * sc); t.b[i] = cvtpk_s(o1[2 * i] * sc, o1[2 * i + 1] * sc); }
}
__device__ __forceinline__ void ot_add(OtPk& t, const f32x16& o0, const f32x16& o1, float sc) {
#pragma unroll
    for (int i = 0; i < 8; ++i) { t.a[i] = cvtpk_s(bflo(t.a[i]) + o0[2 * i] * sc, bfhi(t.a[i]) + o0[2 * i + 1] * sc); t.b[i] = cvtpk_s(bflo(t.b[i]) + o1[2 * i] * sc, bfhi(t.b[i]) + o1[2 * i + 1] * sc); }
}
__device__ __forceinline__ void ot_store(bf16* op, const OtPk& t) {
#pragma unroll
    for (int k4 = 0; k4 < 4; ++k4) { u32x2 w0 = {t.a[2 * k4], t.a[2 * k4 + 1]}, w1 = {t.b[2 * k4], t.b[2 * k4 + 1]}; *(u32x2*)(op + 8 * k4) = w0; *(u32x2*)(op + 32 + 8 * k4) = w1; }
}
__device__ __forceinline__ void ws_reset(WState& S) { S.o0 = f32x16{}; S.o1 = f32x16{}; S.m = 0.f; S.l = 0.f; S.first = 1; }
__device__ __forceinline__ void attn_qk(WState& S, const bf16x8 (&q)[4], const LAS unsigned char* buf, float cadd, bool near, const LAS float* nearp, int r32, int hi, bf16x8 (&pa)[4]) {
    const float ci = cadd - S.m;
    f32x16 p0, p1;
#pragma unroll
    for (int r = 0; r < 16; ++r) { p0[r] = ci; p1[r] = ci; }
    const LAS unsigned char* kb = buf + r32 * 128; const int ksw = (r32 >> 1) & 7;
    bf16x8 kf[8];
#pragma unroll
    for (int ks = 0; ks < 4; ++ks) { const int ko = ((2 * ks + hi) ^ ksw) * 16; kf[2 * ks] = *(const LAS bf16x8*)(kb + ko); kf[2 * ks + 1] = *(const LAS bf16x8*)(kb + ko + 4096); }
    __builtin_amdgcn_sched_barrier(0);
#pragma unroll
    for (int ks = 0; ks < 4; ++ks) { p0 = MFMA32(kf[2 * ks], q[ks], p0, 0, 0, 0); p1 = MFMA32(kf[2 * ks + 1], q[ks], p1, 0, 0, 0); }
    asm volatile("s_nop 15\n\ts_nop 7" : "+v"(p0), "+v"(p1));
    if (near) {
#pragma unroll
        for (int r = 0; r < 16; ++r) { const int c = (r & 3) + 8 * (r >> 2); p0[r] += nearp[63 - c]; }
        __builtin_amdgcn_sched_barrier(0);
#pragma unroll
        for (int r = 0; r < 16; ++r) { const int c = (r & 3) + 8 * (r >> 2); p1[r] += nearp[31 - c]; }
    }
    __builtin_amdgcn_sched_barrier(0);
    float rm = max3f(p0[0], p1[0], p0[1]), rm2 = max3f(p1[1], p0[2], p1[2]);
#pragma unroll
    for (int r = 3; r < 15; r += 2) { rm = max3f(rm, p0[r], p1[r]); rm2 = max3f(rm2, p0[r + 1], p1[r + 1]); }
    rm = max3f(rm, p0[15], p1[15]); rm = max3f(rm, rm2, rm2);
    rm = swap_max(rm);
    if (S.first || __any(rm > 5.0f)) {
        const float d = S.first ? rm : fmaxf(rm, 0.f);
        const float f = S.first ? 1.f : __builtin_amdgcn_exp2f(-d);
        S.m += d; S.first = 0; S.l *= f; S.o0 *= f; S.o1 *= f;
#pragma unroll
        for (int r = 0; r < 16; ++r) { p0[r] -= d; p1[r] -= d; }
    }
    float ls = 0.f;
#pragma unroll
    for (int r = 0; r < 16; ++r) { p0[r] = __builtin_amdgcn_exp2f(p0[r]); p1[r] = __builtin_amdgcn_exp2f(p1[r]); ls += p0[r] + p1[r]; }
    S.l += ls;
    pa[0] = pack_p(p0, 0); pa[1] = pack_p(p0, 1); pa[2] = pack_p(p1, 0); pa[3] = pack_p(p1, 1);
}
__device__ __forceinline__ void attn_pv(WState& S, const LAS unsigned char* buf, const bf16x8 (&pa)[4], int hi, int lane) {
    const LAS unsigned char* vb = buf + 8192 + ((lane >> 4) & 1) * 32 + (lane & 3) * 8 + (4 * hi + ((lane & 15) >> 2)) * 64;
#pragma unroll
    for (int s4 = 0; s4 < 4; ++s4) {
        const bf16x8 v0 = vfrag(vb + s4 * 1024), v1 = vfrag(vb + 4096 + s4 * 1024);
        S.o0 = MFMA32(v0, pa[s4], S.o0, 0, 0, 0); S.o1 = MFMA32(v1, pa[s4], S.o1, 0, 0, 0);
    }
}
#ifndef PROBE_CMP
#define PROBE_CMP 1
#endif
#ifndef PROBE_BAR
#define PROBE_BAR 0
#endif
#define STAG_LOOP(NS, ISSUE, QKBLOCK) do { bf16x8 pa[4]; int have = 0; (void)grpB; \
    _Pragma("unroll 1") for (int j = 0; j < (NS); ++j) { \
        RING_STEP_SYNC(j, NS); if (PROBE_BAR) { __builtin_amdgcn_s_barrier(); } \
        if (j + 2 < (NS)) { ISSUE(j + 2); } \
        { QKBLOCK(j); } \
        if (have) attn_pv(S, kvb + (j % 3) * 16384, pa, hi, lane); have = 0; \
    } } while (0)

__device__ __forceinline__ void store_ot(bf16* op  , const f32x16& o0, const f32x16& o1) {
#pragma unroll
    for (int k4 = 0; k4 < 4; ++k4) {
        u32x2 w0, w1; w0.x = pk2(o0[4 * k4 + 0], o0[4 * k4 + 1]); w0.y = pk2(o0[4 * k4 + 2], o0[4 * k4 + 3]); w1.x = pk2(o1[4 * k4 + 0], o1[4 * k4 + 1]); w1.y = pk2(o1[4 * k4 + 2], o1[4 * k4 + 3]);
        *(u32x2*)(op + 8 * k4) = w0; *(u32x2*)(op + 32 + 8 * k4) = w1;
    }
}
__device__ __forceinline__ void attn_tables(LAS unsigned char* lds, const float* rel_bias, int tid) {
    LAS float* tab = (LAS float*)(lds + A_TAB);
    for (int e = tid; e < 20 * TABN; e += 512) { const int t = e / TABN, i = e % TABN, dist = i - 96, head = t < 8 ? t : t - 8; const bool win = t >= 8 && t < 16;
        float v = NEGB; if (dist >= 0 && !(win && dist >= 256)) { const int bk = dist >= 128 ? 31 : t5_bucket(dist); v = rel_bias[bk * 12 + head] * LOG2E; }
        tab[e] = v; }
    LAS float* ct = (LAS float*)(lds + A_CTAB);
    for (int e = tid; e < 8 * CTABN; e += 512) { const int hd = e / CTABN, i = e % CTABN; float v = NEGB;
        if (i >= 1 && i <= 129) { const int dist = i - 1; const int bk = dist >= 128 ? 31 : t5_bucket(dist); v = rel_bias[bk * 12 + hd] * LOG2E; }
        ct[e] = v; }
    __syncthreads();
}

__device__ __forceinline__ void nsa_unit(int b, int g, int qb, LAS unsigned char* lds, const bf16* PA, const bf16* KC, const bf16* VC, bf16* OC, int tid) {
    const int lane = tid & 63, wid = __builtin_amdgcn_readfirstlane(tid >> 6), r32 = lane & 31, hi = lane >> 5;
    const int hh = wid & 3, wq = wid >> 2, head = g * 4 + hh, tq0 = 64 * qb + 32 * wq;
    const size_t row = (size_t)b * SEQ + tq0 + r32;
    bf16x8 q[4];
    { const bf16* qp = PA + row * NPA + PA_QN + head * 64 + 8 * hi;
#pragma unroll
      for (int ks = 0; ks < 4; ++ks) q[ks] = *(const bf16x8*)(qp + 16 * ks); }
    const bf16* gp = PA + row * NPA + PA_GN + head * 3;
    const float g0 = bflo(gp[0]), g1 = bflo(gp[1]), g2 = bflo(gp[2]);
    const bf16* Kc = KC + (size_t)((b * 2 + g) * 128) * 64; const bf16* Vc = VC + (size_t)((b * 2 + g) * 128) * 64;
    const bf16* Ks = PA + (size_t)b * SEQ * NPA + PA_KS + g * 64; const bf16* Vs = PA + (size_t)b * SEQ * NPA + PA_VS + g * 64;
    const bf16* Kw = PA + (size_t)b * SEQ * NPA + PA_KW + g * 64; const bf16* Vw = PA + (size_t)b * SEQ * NPA + PA_VW + g * 64;
    LAS unsigned char* kvb = lds + A_KV; LAS unsigned char* cmpb = lds + A_CMP;
    const int nsel = qb + 1, nwin = qb + 1 < 5 ? qb + 1 : 5, ns = nsel + nwin;
#define NSA_ISSUE(j) do { const int j_ = (j); const bool w_ = j_ >= nsel; const int n_ = w_ ? qb - (j_ - nsel) : qb - j_; \
        stage_kv(kvb + (j_ % 3) * 16384, (w_ ? Kw : Ks) + (size_t)(64 * n_) * NPA, (w_ ? Vw : Vs) + (size_t)(64 * n_) * NPA, NPA, wid, lane); } while (0)
    stage_kv(cmpb, Kc, Vc, 64, wid, lane); stage_kv(cmpb + 16384, Kc + 64 * 64, Vc + 64 * 64, 64, wid, lane);
    NSA_ISSUE(0);
    if (ns > 1) { NSA_ISSUE(1); if (PROBE_DMA) RING_WAIT_BAR(8); else RING_WAIT_BAR(4); } else RING_WAIT_BAR(2);
    OtPk ot;
    for (int prb_ = 0; prb_ < PROBE_CMP; ++prb_) {
    {
        f32x16 sc[4];
#pragma unroll
        for (int ph = 0; ph < 4; ++ph) sc[ph] = f32x16{};
#pragma unroll
        for (int t = 0; t < 2; ++t) { const LAS unsigned char* kb = cmpb + t * 16384 + r32 * 128; const int ksw = (r32 >> 1) & 7;
#pragma unroll
            for (int ks = 0; ks < 4; ++ks) { const int ko = ((2 * ks + hi) ^ ksw) * 16; const bf16x8 k0f = *(const LAS bf16x8*)(kb + ko), k1f = *(const LAS bf16x8*)(kb + ko + 4096);
                sc[2 * t] = MFMA32(k0f, q[ks], sc[2 * t], 0, 0, 0); sc[2 * t + 1] = MFMA32(k1f, q[ks], sc[2 * t + 1], 0, 0, 0); } }
        __builtin_amdgcn_sched_barrier(0);
        const LAS float* ct = (const LAS float*)(lds + A_CTAB) + head * CTABN;
        const int E0 = tq0 + r32 - 31 - 64 * hi;
        float m = NEGB;
#pragma unroll
        for (int ph = 0; ph < 4; ++ph)
#pragma unroll
            for (int k4 = 0; k4 < 4; ++k4) { int base = E0 - 16 * (32 * ph + 8 * k4); asm volatile("" : "+v"(base));
#pragma unroll
                for (int i = 0; i < 4; ++i) { int dist = base - 16 * i; dist = dist < -1 ? -1 : (dist > 128 ? 128 : dist);
                    sc[ph][4 * k4 + i] += ct[dist + 1]; m = fmaxf(m, sc[ph][4 * k4 + i]); } }
        m = swap_max(m);
        const bool valid = m > -1e29f;
        float l = 0.f;
#pragma unroll
        for (int ph = 0; ph < 4; ++ph)
#pragma unroll
            for (int r = 0; r < 16; ++r) { const float e = valid ? __builtin_amdgcn_exp2f(sc[ph][r] - m) : 0.f; sc[ph][r] = e; l += e; }
        l = swap_sum(l);
        const float inv = valid ? 1.0f / l : 0.f;
#pragma unroll
        for (int ph = 0; ph < 4; ++ph) sc[ph] *= inv;
        {
            LAS float* impw = (LAS float*)(lds + A_IMP) + (hh * 64 + 32 * wq + r32) * 33;
            float prevhi = 0.f;
#pragma unroll
            for (int i = 0; i < 16; ++i) { const int ph = i >> 2, k = i & 3;
                const float av = sc[ph][4 * k] + sc[ph][4 * k + 1] + sc[ph][4 * k + 2] + 0.5f * sc[ph][4 * k + 3], bv = 0.5f * sc[ph][4 * k + 3];
                auto rr = __builtin_amdgcn_permlane32_swap(__float_as_uint(bv), __float_as_uint(bv), false, false);
                const float lo_i = __uint_as_float(rr[0]), hi_i = __uint_as_float(rr[1]);
                impw[2 * k + hi + 8 * ph] = av + (hi ? lo_i : prevhi); prevhi = hi_i; }
        }
        __builtin_amdgcn_sched_barrier(0);
        f32x16 o0 = f32x16{}, o1 = f32x16{};
#pragma unroll
        for (int ph = 0; ph < 4; ++ph)
#pragma unroll
            for (int s = 0; s < 2; ++s) { const bf16x8 pa = pack_p(sc[ph], s);
                const LAS unsigned char* vb = cmpb + (ph >> 1) * 16384 + 8192 + ((lane >> 4) & 1) * 32 + (lane & 3) * 8 + (4 * hi + ((lane & 15) >> 2)) * 64 + (2 * (ph & 1) + s) * 1024;
                const bf16x8 v0 = vfrag(vb), v1 = vfrag(vb + 4096);
                o0 = MFMA32(v0, pa, o0, 0, 0, 0); o1 = MFMA32(v1, pa, o1, 0, 0, 0); }
        ot_set(ot, o0, o1, g0);
    }
    __syncthreads();
    {
        const LAS float* impb = (const LAS float*)(lds + A_IMP); LAS float* scb = (LAS float*)(lds + A_SC); LAS unsigned* selb = (LAS unsigned*)(lds + A_SEL);
#pragma unroll 1
        for (int it = 0; it < 4; ++it) { const int e = tid + 512 * it, tok = e >> 5, n = e & 31;
            float s = (impb[(0 * 64 + tok) * 33 + n] + impb[(1 * 64 + tok) * 33 + n]) + (impb[(2 * 64 + tok) * 33 + n] + impb[(3 * 64 + tok) * 33 + n]);
            const bool forced = (n == 0) | (n == qb) | (n == qb - 1);
            s = forced ? 1e4f : (n <= qb ? s : NEGB);
            scb[tok * 33 + n] = s;
            LDS_WAIT();
            int rank = 0;
#pragma unroll 8
            for (int mm = 0; mm < 32; ++mm) { const float sm = scb[tok * 33 + mm]; rank += ((sm > s) | ((sm == s) & (mm < n))) ? 1 : 0; }
            const bool sel = (rank < 8) && (s > -5e29f);
            const unsigned long long bal = __ballot(sel);
            if ((lane & 31) == 0) selb[tok] = (unsigned)(bal >> (lane & 32));
        }
    }
    __syncthreads();
    }
    const unsigned mymask = ((const LAS unsigned*)(lds + A_SEL))[32 * wq + r32];
    const LAS float* tabC = (const LAS float*)(lds + A_TAB) + head * TABN; const LAS float* tabW = (const LAS float*)(lds + A_TAB) + (8 + head) * TABN;
    const float cfar = tabC[96 + 128];
    WState S; ws_reset(S);
    LOADED4(q); LOADED1(g1); LOADED1(g2);
    const int grpB = wq;
#define NSA_QK(j) do { \
        if ((j) == nsel) { const float lt = swap_sum(S.l); ot_add(ot, S.o0, S.o1, g1 / lt); ws_reset(S); } \
        const bool win = (j) >= nsel; const int n = win ? qb - ((j) - nsel) : qb - (j); const int a = (tq0 - 64 * n) >> 5; \
        const LAS unsigned char* buf = kvb + ((j) % 3) * 16384; const int D0 = tq0 + r32 - 64 * n - 4 * hi; \
        if (!win) { const bool near = a < 6; const float cadd = (((mymask >> n) & 1u) ? 0.f : NEGB) + (near ? 0.f : cfar); attn_qk(S, q, buf, cadd, near, tabC + (D0 + 33), r32, hi, pa); have = 1; } \
        else if (a < 10) { const bool far = (a == 6) | (a == 7); attn_qk(S, q, buf, far ? cfar : 0.f, !far, tabW + (D0 + 33), r32, hi, pa); have = 1; } } while (0)
    STAG_LOOP(ns, NSA_ISSUE, NSA_QK);
#undef NSA_QK
    { const float lt = swap_sum(S.l); ot_add(ot, S.o0, S.o1, g2 / lt); }
    ot_store(OC + row * DM + head * 64 + 4 * hi, ot);
    __syncthreads();
#undef NSA_ISSUE
}

__device__ __forceinline__ void moba_unit(int b, int h, int ob, LAS unsigned char* lds, const bf16* PA, const float* KMEAN, bf16* OC, int tid) {
    const int lane = tid & 63, wid = __builtin_amdgcn_readfirstlane(tid >> 6), r32 = lane & 31, hi = lane >> 5;
    const int tq0 = 256 * ob + 32 * wid;
    const size_t row = (size_t)b * SEQ + tq0 + r32;
    bf16x8 q[4];
    { const bf16* qp = PA + row * NPA + PA_QM + h * 64 + 8 * hi;
#pragma unroll
      for (int ks = 0; ks < 4; ++ks) q[ks] = *(const bf16x8*)(qp + 16 * ks); }
    const bf16* Km = PA + (size_t)b * SEQ * NPA + PA_KM + h * 64; const bf16* Vm = PA + (size_t)b * SEQ * NPA + PA_VM + h * 64;
    LAS unsigned char* kvb = lds + A_KV;
    const int ns = 4 * (ob + 1);
#define MOBA_ISSUE(j) do { const int j_ = (j); const int n_ = ns - 1 - j_; stage_kv(kvb + (j_ % 3) * 16384, Km + (size_t)(64 * n_) * NPA, Vm + (size_t)(64 * n_) * NPA, NPA, wid, lane); } while (0)
    MOBA_ISSUE(0); MOBA_ISSUE(1);
    LAS float* km = (LAS float*)(lds + A_KMEAN); LAS float* mg = (LAS float*)(lds + A_MG);
    km[tid] = KMEAN[(size_t)(b * 4 + h) * 512 + tid];
    __syncthreads();
    {
        const int tok = tid >> 1, hf = tid & 1; const bf16* qrow = PA + ((size_t)b * SEQ + 256 * ob + tok) * NPA + PA_QM + h * 64;
        f32x4 acc = {0.f, 0.f, 0.f, 0.f};
#pragma unroll 1
        for (int c8 = 0; c8 < 8; ++c8) { const u32x4 w = *(const u32x4*)(qrow + 8 * c8); f32x4 qa, qb_; pg8::unpack8(w, qa, qb_);
#pragma unroll
            for (int i = 0; i < 4; ++i) { const LAS float* kp = km + (4 * hf + i) * 64 + 8 * c8; const f32x4 ka = *(const LAS f32x4*)kp, kb = *(const LAS f32x4*)(kp + 4);
                acc[i] += (qa.x * ka.x + qa.y * ka.y) + (qa.z * ka.z + qa.w * ka.w) + (qb_.x * kb.x + qb_.y * kb.y) + (qb_.z * kb.z + qb_.w * kb.w); } }
        *(LAS f32x4*)(mg + tok * 8 + 4 * hf) = acc;
    }
    __syncthreads();
    unsigned mymask = 0u;
    { const LAS float* gp = mg + (32 * wid + r32) * 8; const f32x4 ga = *(const LAS f32x4*)gp, gb = *(const LAS f32x4*)(gp + 4);
      const float gt[8] = {ga.x, ga.y, ga.z, ga.w, gb.x, gb.y, gb.z, gb.w};
#pragma unroll
      for (int n = 0; n < 8; ++n) { int rank = 0;
#pragma unroll
          for (int mm = 0; mm < 8; ++mm) rank += ((mm < ob) & ((gt[mm] > gt[n]) | ((gt[mm] == gt[n]) & (mm < n)))) ? 1 : 0;
          if ((n < ob) & (rank < 3)) mymask |= 1u << n; } }
    const LAS float* tabM = (const LAS float*)(lds + A_TAB) + (16 + h) * TABN;
    const float cfar = tabM[96 + 128];
    WState S; ws_reset(S);
    LOADED4(q);
    const int grpB = wid >> 2;
#define MOBA_QK(j) do { const int n = ns - 1 - (j), blk = n >> 2; \
        if (tq0 + 31 - 64 * n >= 0) { const int a = (tq0 - 64 * n) >> 5; const bool near = a < 6; float cadd = near ? 0.f : cfar; \
            if (blk < ob) cadd += ((mymask >> blk) & 1u) ? 0.f : NEGB; \
            const int D0 = tq0 + r32 - 64 * n - 4 * hi; \
            attn_qk(S, q, kvb + ((j) % 3) * 16384, cadd, near, tabM + (D0 + 33), r32, hi, pa); have = 1; } } while (0)
    STAG_LOOP(ns, MOBA_ISSUE, MOBA_QK);
#undef MOBA_QK
    { const float lt = swap_sum(S.l); const float scl = 1.0f / lt; S.o0 *= scl; S.o1 *= scl; }
    store_ot(OC + row * DM + 512 + h * 64 + 4 * hi, S.o0, S.o1);
    __syncthreads();
#undef MOBA_ISSUE
}

__device__ __forceinline__ void mem_unit(int b, int h, int tb, LAS unsigned char* lds, const bf16* PA, const bf16* MKV, bf16* OC, int tid) {
    const int lane = tid & 63, wid = __builtin_amdgcn_readfirstlane(tid >> 6), r32 = lane & 31, hi = lane >> 5;
    const int tq0 = 256 * tb + 32 * wid;
    const size_t row = (size_t)b * SEQ + tq0 + r32;
    bf16x8 q[4];
    { const bf16* qp = PA + row * NPA + PA_QX + h * 64 + 8 * hi;
#pragma unroll
      for (int ks = 0; ks < 4; ++ks) q[ks] = *(const bf16x8*)(qp + 16 * ks); }
    const bf16* Kx = MKV + (size_t)b * MEML * 1024 + h * 64; const bf16* Vx = Kx + 256;
    LAS unsigned char* kvb = lds + A_KV;
    stage_kv(kvb, Kx, Vx, 1024, wid, lane); stage_kv(kvb + 16384, Kx + (size_t)64 * 1024, Vx + (size_t)64 * 1024, 1024, wid, lane);
    WState S; ws_reset(S);
    LOADED4(q);
    const int grpB = wid >> 2;
#define MEM_ISSUE(j) stage_kv(kvb + ((j) % 3) * 16384, Kx + (size_t)(64 * (j)) * 1024, Vx + (size_t)(64 * (j)) * 1024, 1024, wid, lane)
#define MEM_QK(j) do { attn_qk(S, q, kvb + ((j) % 3) * 16384, 0.f, false, (const LAS float*)(lds + A_TAB), r32, hi, pa); have = 1; } while (0)
    STAG_LOOP(4, MEM_ISSUE, MEM_QK);
#undef MEM_QK
#undef MEM_ISSUE
    { const float lt = swap_sum(S.l); const float scl = 1.0f / lt; S.o0 *= scl; S.o1 *= scl; }
    store_ot(OC + row * DM + 768 + h * 64 + 4 * hi, S.o0, S.o1);
    __syncthreads();
}

#ifndef MK_MULTI_LAUNCH
#define MK_MULTI_LAUNCH 0
#endif
constexpr int N_PHASES = 20;
__device__ __forceinline__ int lane_now() { unsigned z = 0u; asm volatile("" : "+s"(z)); return (int)__builtin_amdgcn_mbcnt_hi(~0u, __builtin_amdgcn_mbcnt_lo(~0u, z)); }
struct Args { const float* in[23]; float* out; unsigned char* ws; int ph_lo, ph_hi; };

__global__ void __launch_bounds__(512, 2) fwd_kernel(Args args) {
    extern __shared__ __attribute__((aligned(16))) unsigned char lds_raw[];
    LAS unsigned char* lds = (LAS unsigned char*)lds_raw;
    volatile LAS unsigned* MISC = (volatile LAS unsigned*)(lds + MISC_OFF);
    const int wave = __builtin_amdgcn_readfirstlane((int)threadIdx.x >> 6);
#define TID_NOW (wave * 64 + lane_now())
    const int G = gridDim.x, bx_k = blockIdx.x; const int vcu_k = (G % 8 == 0) ? (bx_k % 8) * (G / 8) + bx_k / 8 : bx_k;
    unsigned* ctl = (unsigned*)(args.ws + WS_CTL);
    for (int u = threadIdx.x; u < (LDS_BYTES - MISC_OFF) / 4; u += 512) MISC[u] = 0u;
    __syncthreads();
    const int lo = args.ph_lo, hi = args.ph_hi;
    XcdBarrier bar; bar.bar = ctl + CW_BAR; bar.x = 0; bar.st = nullptr;
    if (hi - lo > 1) bar = xcd_barrier_post(ctl + CW_BAR, MISC + 8);
#ifndef ATT_EN
#define ATT_EN 7
#endif
#ifndef REP_J
#define REP_J -1
#endif
#define NREP(j) ((REP_J) == (j) ? 2 : 1)
#ifndef PHMASK
#define PHMASK 0x3ff
#endif
#define IN(k) (lo <= (k) && (k) < hi)
#define INJ(j) (((PHMASK >> ((j) + 1)) & 1) && IN(pb + (j)))
#ifndef PROBE_SEAM2
#define PROBE_SEAM2 0
#endif
#define SEAM(k) do { if (IN(k) && IN((k) + 1)) { xcd_barrier(bar); if (PROBE_SEAM2) xcd_barrier(bar); } } while (0)
    typedef const __attribute__((address_space(4))) unsigned char* kaptr_t;
#define KA_DECL kaptr_t ka = (kaptr_t)__builtin_amdgcn_kernarg_segment_ptr(); int bx = bx_k, vcu = vcu_k, gw = gw_k; asm volatile("" : "+s"(ka), "+s"(bx), "+s"(vcu), "+s"(gw)); unsigned char* ws = *(unsigned char* const __attribute__((address_space(4)))*)(ka + 192)
#define KIN(i) (*(const float* const __attribute__((address_space(4)))*)(ka + 8 * (i)))
#define KOUT (*(float* const __attribute__((address_space(4)))*)(ka + 184))
    const int gw_k = vcu_k * 8 + wave, NGW = G * 8;

    if ((PHMASK & 1) && IN(0)) for (int rep_ = 0; rep_ < ((REP_J) == 100 ? 2 : 1); ++rep_) {
        const int lane = TID_NOW & 63;
        KA_DECL; const float* x_in = KIN(0); const float* mem_in = KIN(1); const float* pre_mix_g = KIN(3); const float* mem_norm_g = KIN(4); bf16* MEMN = (bf16*)KOUT; unsigned char* H8 = ws + WS_H; float* SA = (float*)(ws + WS_SA); unsigned* CMAX = (unsigned*)(ws + WS_CTL) + CW_CMAX;
        LAS float* scr = (LAS float*)(lds + wave * 16384);
        if ((gw & 7) == 0 && (gw >> 3) < 128) {
            const int t = gw >> 3, kc = t & 15, t8 = t >> 4, l = t8 >> 2, kv = (t8 >> 1) & 1, nh = t8 & 1, n = 64 * nh + lane;
            const float* pos = KIN(kv ? 10 : 7) + (size_t)l * 2048 + 128 * kc; const float* w1 = KIN(kv ? 11 : 8) + (size_t)l * 2048 * 128 + (size_t)(128 * kc) * 128;
            float acc = 0.f;
#pragma unroll 16
            for (int k = 0; k < 128; ++k) acc += pos[k] * w1[(size_t)k * 128 + n];
            ((float*)(ws + WS_POSP))[t * 64 + lane] = acc;
        }
        constexpr int I0 = 0, I1 = I0 + 16 * 176, I2 = I1 + 16 * 176, I3 = I2 + 44 * 32, I4 = I3 + 8 * 32, I5 = I4 + 4 * 32, I6 = I5 + 4 * 32, I7 = I6 + 16 * 32, I8 = I7 + 16 * 16, I9 = I8 + 32 * 4, I10 = I9 + 32 * 4, I11 = I10 + 4, ITOT = I11 + 4;
#pragma unroll 1
        for (int gi = gw; gi < 2 * ITOT; gi += NGW) {
            const int l = gi / ITOT, r = gi % ITOT;
            unsigned char* wl = ws + WS_W + l * WL_STRIDE;
            const int mi = r < I1 ? 0 : r < I2 ? 1 : r < I3 ? 2 : r < I4 ? 3 : r < I5 ? 4 : r < I6 ? 5 : r < I7 ? 6 : r < I8 ? 7 : r < I9 ? 8 : r < I10 ? 9 : r < I11 ? 10 : 11;
            int kind = 0, ldw = 0, Ndst = 0, ldt = 0, kdst = 0, it0 = 0; const float* W = nullptr; const float* W2 = nullptr; bf16* WT = nullptr; const float* kgain = nullptr;
            switch (mi) {
                case 0: kind = 1; W = KIN(6) + (size_t)l * 1024 * INW; ldw = INW; Ndst = NIN; WT = (bf16*)(wl + WL_IN); ldt = 1024; it0 = I0; break;
                case 1: kind = 2; W = KIN(20) + (size_t)l * 1024 * DFF; W2 = KIN(21) + (size_t)l * 1024 * DFF; ldw = DFF; Ndst = NGU; WT = (bf16*)(wl + WL_GU); ldt = 1024; it0 = I1; break;
                case 2: W = KIN(22) + (size_t)l * DFF * 1024; ldw = 1024; Ndst = 1024; WT = (bf16*)(wl + WL_DN); ldt = DFF; it0 = I2; break;
                case 3: W = KIN(14) + (size_t)l * 512 * 1024; ldw = 1024; Ndst = 1024; WT = (bf16*)(wl + WL_BR); ldt = 1024; kdst = 0; it0 = I3; break;
                case 4: W = KIN(15) + (size_t)l * 256 * 1024; ldw = 1024; Ndst = 1024; WT = (bf16*)(wl + WL_BR); ldt = 1024; kdst = 512; it0 = I4; break;
                case 5: W = KIN(16) + (size_t)l * 256 * 1024; ldw = 1024; Ndst = 1024; WT = (bf16*)(wl + WL_BR); ldt = 1024; kdst = 768; it0 = I5; break;
                case 6: W = KIN(17) + (size_t)l * 1024 * 1024; ldw = 1024; Ndst = 1024; WT = (bf16*)(wl + WL_MIX); ldt = 1024; it0 = I6; break;
                case 7: W = KIN(13) + (size_t)l * 1024 * 512; ldw = 512; Ndst = 512; WT = (bf16*)(ws + WS_MKV2) + (size_t)l * 512 * 1024; ldt = 1024; kgain = mem_norm_g + l * DM; it0 = I7; break;
                case 8: W = KIN(8) + (size_t)l * 2048 * 128; ldw = 128; Ndst = 128; WT = (bf16*)(wl + WL_W1K); ldt = 2048; it0 = I8; break;
                case 9: W = KIN(11) + (size_t)l * 2048 * 128; ldw = 128; Ndst = 128; WT = (bf16*)(wl + WL_W1V); ldt = 2048; it0 = I9; break;
                case 10: W = KIN(9) + (size_t)l * 128 * 64; ldw = 64; Ndst = 64; WT = (bf16*)(wl + WL_W2K); ldt = 128; it0 = I10; break;
                default: W = KIN(12) + (size_t)l * 128 * 64; ldw = 64; Ndst = 64; WT = (bf16*)(wl + WL_W2V); ldt = 128; it0 = I11; break;
            }
            tr_one(kind, W, W2, ldw, Ndst, WT, ldt, kdst, scr, r - it0, lane, mi < 2 ? CMAX + (l * 2 + mi) * NIN : (unsigned*)nullptr, kgain);
        }
        for (int m0 = 4 * gw; m0 < NMEM; m0 += 4 * NGW) {
            const float* xr[4] = {mem_in + (size_t)m0 * DM, mem_in + (size_t)(m0 + 1) * DM, mem_in + (size_t)(m0 + 2) * DM, mem_in + (size_t)(m0 + 3) * DM};
            bf16* orow[4] = {MEMN + (size_t)m0 * DM, MEMN + (size_t)(m0 + 1) * DM, MEMN + (size_t)(m0 + 2) * DM, MEMN + (size_t)(m0 + 3) * DM};
            rms_rows_bf16<4>(xr, (const float*)nullptr, orow, lane); }
        for (int m0 = 4 * gw; m0 < NTOK; m0 += 4 * NGW) {
            const float* xr[4] = {x_in + (size_t)m0 * DM, x_in + (size_t)(m0 + 1) * DM, x_in + (size_t)(m0 + 2) * DM, x_in + (size_t)(m0 + 3) * DM};
            unsigned char* orow[4] = {H8 + (size_t)m0 * DM, H8 + (size_t)(m0 + 1) * DM, H8 + (size_t)(m0 + 2) * DM, H8 + (size_t)(m0 + 3) * DM};
            float* sap[4] = {SA + m0, SA + m0 + 1, SA + m0 + 2, SA + m0 + 3};
            rms_rows_i8<4>(xr, pre_mix_g, orow, sap, lane); }
    }
    SEAM(0);
    if ((PHMASK & 1) && IN(1)) {
        const int lane = TID_NOW & 63;
        KA_DECL; const unsigned* CMAX = (const unsigned*)(ws + WS_CTL) + CW_CMAX;
        if ((gw & 7) == 1 && (gw >> 3) < 8) { const int t8 = gw >> 3, l = t8 >> 2, kv = (t8 >> 1) & 1, nh = t8 & 1; float s = 0.f;
#pragma unroll
            for (int kc = 0; kc < 16; ++kc) s += ((const float*)(ws + WS_POSP))[(t8 * 16 + kc) * 64 + lane];
            ((float*)(ws + WS_W + l * WL_STRIDE + (kv ? WL_POSV : WL_POSK)))[64 * nh + lane] = s; }
        for (int r = gw; r < 4 * NIN; r += NGW) { const int lm = r / NIN, n = r % NIN, l = lm >> 1, mat = lm & 1;
            unsigned char* wl = ws + WS_W + l * WL_STRIDE; unsigned char* rowp = wl + (mat ? WL_GU : WL_IN) + (size_t)n * 2048;
            const u32x4 w0 = *((const u32x4*)rowp + 2 * lane), w1 = *((const u32x4*)rowp + 2 * lane + 1);
            const float am = __uint_as_float(CMAX[r]); const float inv = am > 0.f ? 127.f / am : 0.f;
            f32x4 a, b, c, d; pg8::unpack8(w0, a, b); pg8::unpack8(w1, c, d);
            u32x4 o; o.x = q8x4(a, inv); o.y = q8x4(b, inv); o.z = q8x4(c, inv); o.w = q8x4(d, inv);
            asm volatile("" ::: "memory");
            *((u32x4*)rowp + lane) = o;
            if (lane == 0) ((float*)(wl + (mat ? WL_SBGU : WL_SBIN)))[n] = am > 0.f ? am * (1.f / 127.f) : 1.f; }
    }
    SEAM(1);

#pragma unroll 1
    for (int l = 0; l < 2; ++l) {
        const int pb = 2 + 9 * l;
        if (INJ(0)) for (int rep_ = 0; rep_ < NREP(0); ++rep_) {
            KA_DECL; unsigned char* wl = ws + WS_W + l * WL_STRIDE; bf16* H = (bf16*)(ws + WS_H); bf16* PA = (bf16*)(ws + WS_PA); bf16* GT = (bf16*)(ws + WS_GT); bf16* MEMN = (bf16*)KOUT; bf16* MEMKV = (bf16*)(ws + WS_MEMKV);
            { pg8::Gemm g{H, (const bf16*)(wl + WL_IN), NTOK, NIN, 512, 512, 1024}; pg8::StaticOrder S; S.init(NTOK, NIN, G, bx);
              pg8::EpiProj E{PA, GT, (const float*)(ws + WS_SA), (const float*)(wl + WL_SBIN)}; pg8::gemm_phase<pg8::EpiProj, pg8::StaticOrder, true, true, true>(lds, g, S, E, wave); }
        }
        SEAM(pb + 0);
        if (INJ(1)) for (int rep_ = 0; rep_ < NREP(1); ++rep_) {
            int tid_p = TID_NOW; asm volatile("" : "+v"(tid_p));
            KA_DECL; unsigned char* wl = ws + WS_W + l * WL_STRIDE; bf16* PA = (bf16*)(ws + WS_PA); bf16* KC = (bf16*)(ws + WS_KC); bf16* VC = (bf16*)(ws + WS_VC); float* KMEAN = (float*)(ws + WS_KMEAN);
            for (int u = bx; u < 192; u += G) {
                if (u < 64) compress_unit(u, lds, PA, wl, KC, VC, tid_p);
                else kmean_unit((u - 64) >> 3, (u - 64) & 7, lds, PA, KMEAN, tid_p);
            }
            if (l == 0 && (G != 256 || bx >= 192)) {
                pg8::Gemm g{(const bf16*)KOUT, (const bf16*)(ws + WS_MKV2), NMEM, 1024, 1024, 1024, 1024};
                pg8::StaticOrder S; S.init(NMEM, 1024, G == 256 ? 64 : G, G == 256 ? bx - 192 : bx); pg8::EpiPlain E{(bf16*)(ws + WS_MEMKV), 1024};
                pg8::gemm_phase<pg8::EpiPlain, pg8::StaticOrder, true, true>(lds, g, S, E, wave); }
        }
        SEAM(pb + 1);
        if (INJ(2)) for (int rep_ = 0; rep_ < NREP(2); ++rep_) {
            int tid_p = TID_NOW; asm volatile("" : "+v"(tid_p));
            KA_DECL; const float* rel_bias = KIN(2); bf16* H = (bf16*)(ws + WS_H); bf16* PA = (bf16*)(ws + WS_PA); bf16* KC = (bf16*)(ws + WS_KC); bf16* VC = (bf16*)(ws + WS_VC); float* KMEAN = (float*)(ws + WS_KMEAN); bf16* MEMKV = (bf16*)(ws + WS_MEMKV);
            attn_tables(lds, rel_bias, tid_p);
            if (ATT_EN & 1) for (int rp_ = 0; rp_ < ((REP_J) == 20 ? 2 : 1); ++rp_)
#pragma unroll 1
            for (int P = vcu; P < 512; P += G) { const int bg = P >> 4, s = (P >> 8) ? 15 - (P & 15) : (P & 15);
#pragma unroll 1
                for (int k = 0; k < 2; ++k) nsa_unit(bg >> 1, bg & 1, k ? 31 - s : s, lds, PA, KC, VC, H, tid_p); }
            if (ATT_EN & 2) for (int rp_ = 0; rp_ < ((REP_J) == 21 ? 2 : 1); ++rp_)
#pragma unroll 1
            for (int M = vcu; M < 256; M += G) { const int bh = M >> 2, s = M & 3;
#pragma unroll 1
                for (int k = 0; k < 2; ++k) moba_unit(bh >> 2, bh & 3, k ? 7 - s : s, lds, PA, KMEAN, H, tid_p); }
            if (ATT_EN & 4) for (int rp_ = 0; rp_ < ((REP_J) == 22 ? 2 : 1); ++rp_)
#pragma unroll 1
            for (int u = vcu; u < 512; u += G) { const int bh = u >> 3; mem_unit(bh >> 2, bh & 3, u & 7, lds, PA, MEMKV + l * 512, H, tid_p); }
        }
        SEAM(pb + 2);
        if (INJ(3)) for (int rep_ = 0; rep_ < NREP(3); ++rep_) {
            KA_DECL; unsigned char* wl = ws + WS_W + l * WL_STRIDE; bf16* H = (bf16*)(ws + WS_H); bf16* MERGED = (bf16*)(ws + WS_PA); bf16* GT = (bf16*)(ws + WS_GT);
            pg8::Gemm g{H, (const bf16*)(wl + WL_BR), NTOK, 1024, 1024, 1024, 1024}; pg8::StaticOrder S; S.init(NTOK, 1024, G, bx);
            pg8::EpiMerge1P E{MERGED, 1024, (const unsigned char*)GT, NGT, 8, 12};
            pg8::gemm_phase<pg8::EpiMerge1P, pg8::StaticOrder, true, true>(lds, g, S, E, wave);
        }
        SEAM(pb + 3);
        if (INJ(4)) for (int rep_ = 0; rep_ < NREP(4); ++rep_) {
            KA_DECL; unsigned char* wl = ws + WS_W + l * WL_STRIDE; bf16* MERGED = (bf16*)(ws + WS_PA); bf16* YB = (bf16*)(ws + WS_GT);
            pg8::Gemm g{MERGED, (const bf16*)(wl + WL_MIX), NTOK, 1024, 1024, 1024, 1024}; pg8::StaticOrder S; S.init(NTOK, 1024, G, bx);
            pg8::EpiPlain E{YB, 1024}; pg8::gemm_phase<pg8::EpiPlain, pg8::StaticOrder, true, true>(lds, g, S, E, wave);
        }
        SEAM(pb + 4);
        if (INJ(5)) for (int rep_ = 0; rep_ < (((REP_J) == 5 && l == 0) ? 2 : 1); ++rep_) {
            int lane_p = TID_NOW & 63; asm volatile("" : "+v"(lane_p));
            KA_DECL; float* xres = KOUT; const float* post_mix_g = KIN(5); const float* pre_ffn_g = KIN(18); bf16* YB = (bf16*)(ws + WS_GT); unsigned char* H8 = ws + WS_H; float* SA = (float*)(ws + WS_SA);
            unsigned char* XB0 = (unsigned char*)xres; unsigned char* XB1 = ws + WS_PA + 64 * MiB;
            for (int m0 = 2 * gw; m0 < NTOK; m0 += 2 * NGW) {
                const bf16* sr[2] = {YB + (size_t)m0 * DM, YB + (size_t)(m0 + 1) * DM};
                unsigned char* ho[2] = {H8 + (size_t)m0 * DM, H8 + (size_t)(m0 + 1) * DM}; float* sap[2] = {SA + m0, SA + m0 + 1};
                if (l == 0) { const void* xi[2] = {KIN(0) + (size_t)m0 * DM, KIN(0) + (size_t)(m0 + 1) * DM}; void* xo[2] = {XB0 + (size_t)m0 * DM * 2, XB0 + (size_t)(m0 + 1) * DM * 2};
                    norm_res_norm<2, true, false>(sr, post_mix_g + l * DM, xi, xo, pre_ffn_g + l * DM, ho, sap, true, lane_p); }
                else { const void* xi[2] = {XB0 + (size_t)m0 * DM * 2, XB0 + (size_t)(m0 + 1) * DM * 2}; void* xo[2] = {XB1 + (size_t)m0 * DM * 2, XB1 + (size_t)(m0 + 1) * DM * 2};
                    norm_res_norm<2, false, false>(sr, post_mix_g + l * DM, xi, xo, pre_ffn_g + l * DM, ho, sap, true, lane_p); } }
        }
        SEAM(pb + 5);
        if (INJ(6)) for (int rep_ = 0; rep_ < NREP(6); ++rep_) {
            KA_DECL; unsigned char* wl = ws + WS_W + l * WL_STRIDE; bf16* H = (bf16*)(ws + WS_H); bf16* UB = (bf16*)(ws + WS_GT);
            pg8::Gemm g{H, (const bf16*)(wl + WL_GU), NTOK, NGU, 512, 512, 1024}; pg8::StaticOrder S; S.init(NTOK, NGU, G, bx);
            pg8::EpiSwiGLU E{UB, DFF, (const float*)(ws + WS_SA), (const float*)(wl + WL_SBGU)}; pg8::gemm_phase<pg8::EpiSwiGLU, pg8::StaticOrder, true, true, true>(lds, g, S, E, wave);
        }
        SEAM(pb + 6);
        if (INJ(7)) for (int rep_ = 0; rep_ < NREP(7); ++rep_) {
            KA_DECL; unsigned char* wl = ws + WS_W + l * WL_STRIDE; bf16* UB = (bf16*)(ws + WS_GT); bf16* FB = (bf16*)(ws + WS_PA);
            pg8::Gemm g{UB, (const bf16*)(wl + WL_DN), NTOK, 1024, DFF, DFF, DFF}; pg8::StaticOrder S; S.init(NTOK, 1024, G, bx);
            pg8::EpiPlain E{FB, 1024}; pg8::gemm_phase<pg8::EpiPlain, pg8::StaticOrder, true, true>(lds, g, S, E, wave);
        }
        SEAM(pb + 7);
        if (INJ(8)) {
            int lane_p = TID_NOW & 63; asm volatile("" : "+v"(lane_p));
            KA_DECL; float* xres = KOUT; const float* post_ffn_g = KIN(19); const float* pre_mix_g = KIN(3); bf16* FB = (bf16*)(ws + WS_PA); unsigned char* H8 = ws + WS_H; float* SA = (float*)(ws + WS_SA);
            unsigned char* XB0 = (unsigned char*)xres; unsigned char* XB1 = ws + WS_PA + 64 * MiB;
            for (int m0 = 2 * gw; m0 < NTOK; m0 += 2 * NGW) {
                const bf16* sr[2] = {FB + (size_t)m0 * DM, FB + (size_t)(m0 + 1) * DM};
                unsigned char* ho[2] = {H8 + (size_t)m0 * DM, H8 + (size_t)(m0 + 1) * DM}; float* sap[2] = {SA + m0, SA + m0 + 1};
                if (l == 0) { const void* xi[2] = {XB0 + (size_t)m0 * DM * 2, XB0 + (size_t)(m0 + 1) * DM * 2}; void* xo[2] = {XB0 + (size_t)m0 * DM * 2, XB0 + (size_t)(m0 + 1) * DM * 2};
                    norm_res_norm<2, false, false>(sr, post_ffn_g + l * DM, xi, xo, pre_mix_g + DM, ho, sap, true, lane_p); }
                else { const void* xi[2] = {XB1 + (size_t)m0 * DM * 2, XB1 + (size_t)(m0 + 1) * DM * 2}; void* xo[2] = {xres + (size_t)m0 * DM, xres + (size_t)(m0 + 1) * DM};
                    norm_res_norm<2, false, true>(sr, post_ffn_g + l * DM, xi, xo, pre_mix_g + DM, ho, sap, false, lane_p); } }
        }
        SEAM(pb + 8);
    }
#undef IN
#undef INJ
#undef SEAM
}

extern "C" void kernel_launch(void* const* d_in, const int* in_sizes, int n_in, void* d_out, int out_size, void* d_ws, size_t ws_size, hipStream_t stream) {
    static int grid = 0;
    if (grid == 0) {
        if (n_in != 23 || in_sizes[0] != NTOK * DM || out_size != NTOK * DM || ws_size < WS_END) { fprintf(stderr, "kernel_launch: unexpected shapes (n_in %d, in0 %d, out %d, ws %zu); nothing launched\n", n_in, n_in > 0 ? in_sizes[0] : -1, out_size, ws_size); grid = -1; return; }
        int dev = 0, cus = 0, per_cu = 0;
        if (hipGetDevice(&dev) != hipSuccess || hipDeviceGetAttribute(&cus, hipDeviceAttributeMultiprocessorCount, dev) != hipSuccess) { grid = -1; return; }
        if (hipFuncSetAttribute((const void*)fwd_kernel, hipFuncAttributeMaxDynamicSharedMemorySize, LDS_BYTES) != hipSuccess) { fprintf(stderr, "kernel_launch: hipFuncSetAttribute failed\n"); grid = -1; return; }
        if (hipOccupancyMaxActiveBlocksPerMultiprocessor(&per_cu, (const void*)fwd_kernel, 512, LDS_BYTES) != hipSuccess || per_cu < 1) fprintf(stderr, "kernel_launch: occupancy query reports %d\n", per_cu);
        (void)hipGetLastError();
        grid = cus;
    }
    if (grid < 0) return;
    if (hipMemsetAsync((char*)d_ws + WS_CTL, 0, CTL_ZERO_BYTES, stream) != hipSuccess) return;
    Args a{};
    for (int i = 0; i < 23; ++i) a.in[i] = (const float*)d_in[i];
    a.out = (float*)d_out; a.ws = (unsigned char*)d_ws;
#if MK_MULTI_LAUNCH
    for (int p = 0; p < N_PHASES; ++p) { a.ph_lo = p; a.ph_hi = p + 1; hipLaunchKernelGGL(fwd_kernel, dim3(grid), dim3(512), LDS_BYTES, stream, a); }
#else
    a.ph_lo = 0; a.ph_hi = N_PHASES;
    hipLaunchKernelGGL(fwd_kernel, dim3(grid), dim3(512), LDS_BYTES, stream, a);
#endif
    const hipError_t le = hipPeekAtLastError();
    if (le != hipSuccess) fprintf(stderr, "kernel_launch: launch failed: %s\n", hipGetErrorName(le));
}
```
